# Optimizing an MI355X kernel written in HIP

```python
import jax, jax.numpy as jnp
from jax import lax
import numpy as np

D_MODEL = 1024
BATCH = 8
SEQ = 8192
DEPTH = 1

CTX_LEN = 256
GRID_W = 64
N_HEADS = 8
HEAD_DIM = D_MODEL // N_HEADS
HGRN_WIDTH = N_HEADS * HEAD_DIM
CHUNK = 64
POOL_WINDOWS = (2, 4, 8, 16)
POOL_GROUP = 128
POOL_WIDTH = POOL_GROUP * len(POOL_WINDOWS)
N_EXPERTS = 16
CAPACITY_FACTOR = 2
EXPERT_FF = 1024
EPS = 1e-6

Q_OFF = 0
I_OFF = Q_OFF + HGRN_WIDTH
FF_OFF = I_OFF + HGRN_WIDTH
FB_OFF = FF_OFF + HGRN_WIDTH
OG_OFF = FB_OFF + HGRN_WIDTH
P_OFF = OG_OFF + HGRN_WIDTH
GA_OFF = P_OFF + POOL_WIDTH
GB_OFF = GA_OFF + D_MODEL
IN_COLS = GB_OFF + D_MODEL

kernel_name = "hybrid_hgrn2_pool_ec_moe_dit"


def rms_norm(x, g):
    xf = x.astype(jnp.float32)
    y = xf * lax.rsqrt(jnp.mean(xf * xf, axis=-1, keepdims=True) + EPS)
    return y.astype(x.dtype) * g


def modulate(x, shift, scale):
    return x * (1 + scale) + shift


def adaln(cvec, w_mod, b_mod):
    return jnp.split(jax.nn.silu(cvec) @ w_mod + b_mod, 6, axis=-1)


def to_heads(z):
    return z.astype(jnp.float32).reshape(z.shape[0], z.shape[1], N_HEADS, HEAD_DIM)


def hgrn_forget(z, lb):
    f = lb + (1.0 - lb) * jax.nn.sigmoid(z.astype(jnp.float32))
    return to_heads(1.0 - f), to_heads(jnp.log(f))


def flip(a):
    return a[:, ::-1]


def chunked_recurrence(q, k, v, logf, s0):
    bn, length, h, _ = q.shape
    dv = v.shape[-1]
    n = length // CHUNK

    def to_chunks(a):
        return a.reshape(bn, n, CHUNK, h, a.shape[-1]).transpose(1, 0, 3, 2, 4)

    causal = jnp.tril(jnp.ones((CHUNK, CHUNK), dtype=bool))

    def step(state, inp):
        qc, kc, vc, gc = inp
        b = jnp.cumsum(gc, axis=2)
        rel = jnp.where(causal[:, :, None], b[:, :, :, None, :] - b[:, :, None, :, :], -jnp.inf)
        scores = jnp.einsum('bhtd,bhsd,bhtsd->bhts', qc, kc, jnp.exp(rel))
        o = (jnp.einsum('bhts,bhsv->bhtv', scores, vc)
             + jnp.einsum('bhtd,bhdv->bhtv', qc * jnp.exp(b), state))
        b_end = b[:, :, -1:, :]
        state = (jnp.exp(b_end[:, :, 0, :])[..., None] * state
                 + jnp.einsum('bhsd,bhsv->bhdv', kc * jnp.exp(b_end - b), vc))
        return state, o

    s_fin, o = lax.scan(step, s0, (to_chunks(q), to_chunks(k), to_chunks(v), to_chunks(logf)))
    return o.transpose(1, 0, 3, 2, 4).reshape(bn, length, h, dv), s_fin


def final_state(k, v, logf, s0):
    b = jnp.cumsum(logf, axis=1)
    b_end = b[:, -1]
    return (jnp.exp(b_end)[..., None] * s0
            + jnp.einsum('blhd,blhv->bhdv', k * jnp.exp(b_end[:, None] - b), v))


def window_bounds(n, w):
    pos = jnp.arange(n)
    lo = jnp.clip(pos - w // 2, 0, n - 1)
    hi = jnp.clip(pos + w // 2 - 1, 0, n - 1) + 1
    return lo, hi


def centred_pool_residual(p, rows, cols, w):
    bn, length, ch = p.shape
    g = p.astype(jnp.float32).reshape(bn, rows, cols, ch)
    sat = jnp.pad(jnp.cumsum(jnp.cumsum(g, axis=1), axis=2), ((0, 0), (1, 0), (1, 0), (0, 0)))
    r0, r1 = window_bounds(rows, w)
    c0, c1 = window_bounds(cols, w)

    def corner(ri, ci):
        return sat[:, ri][:, :, ci]

    total = corner(r1, c1) - corner(r0, c1) - corner(r1, c0) + corner(r0, c0)
    count = ((r1 - r0)[:, None] * (c1 - c0)[None, :]).astype(jnp.float32)[None, :, :, None]
    return (total / count - g).reshape(bn, length, ch).astype(p.dtype)


def pool_branch(p, rows, cols, w_pool, pool_scale):
    outs = []
    for j, w in enumerate(POOL_WINDOWS):
        pj = p[..., j * POOL_GROUP:(j + 1) * POOL_GROUP]
        outs.append(centred_pool_residual(pj, rows, cols, w) @ w_pool[j])
    return jnp.concatenate(outs, axis=-1) * pool_scale


def merge_branches(o, z, rows, cols, hgrn_norm_g, w_a, w_pool, pool_scale, w_b, w_out):
    bn, length = z.shape[:2]
    o_gated = rms_norm(o, hgrn_norm_g).reshape(bn, length, HGRN_WIDTH).astype(z.dtype) * jax.nn.silu(z[..., OG_OFF:P_OFF])
    y_a = o_gated @ w_a
    y_b = pool_branch(z[..., P_OFF:GA_OFF], rows, cols, w_pool, pool_scale) @ w_b
    y = jax.nn.sigmoid(z[..., GA_OFF:GB_OFF]) * y_a + jax.nn.sigmoid(z[..., GB_OFF:IN_COLS]) * y_b
    return y @ w_out


def expert_choice_moe(u, w_router, w_e_gate, w_e_up, w_e_down):
    bn, n, _ = u.shape
    cap = CAPACITY_FACTOR * n // N_EXPERTS
    probs = jax.nn.softmax((u @ w_router).astype(jnp.float32), axis=-1)
    vals, idx = lax.top_k(jnp.swapaxes(probs, 1, 2), cap)
    bidx = jnp.arange(bn)[:, None, None]
    xg = u[bidx, idx]
    hid = jax.nn.silu(jnp.einsum('becd,edf->becf', xg, w_e_gate)) * jnp.einsum('becd,edf->becf', xg, w_e_up)
    y = jnp.einsum('becf,efd->becd', hid, w_e_down) * vals[..., None].astype(u.dtype)
    return jnp.zeros_like(u).at[bidx, idx].add(y)


def trunk_layer(hx, hc, c, c_ctx, lb_f, lb_b, w_mod, b_mod, norm1_g, w_in, hgrn_norm_g,
                w_a, w_pool, pool_scale, w_b, w_out, norm2_g, w_router, w_e_gate, w_e_up,
                w_e_down, rows, update_ctx):
    sh1x, sc1x, g1x, sh2x, sc2x, g2x = adaln(c[:, None, :], w_mod, b_mod)
    sh1c, sc1c, g1c, sh2c, sc2c, g2c = adaln(c_ctx, w_mod, b_mod)

    ux = modulate(rms_norm(hx, norm1_g), sh1x, sc1x)
    uc = modulate(rms_norm(hc, norm1_g), sh1c, sc1c)
    zx = ux @ w_in
    if update_ctx:
        zc = uc @ w_in
        zc_ifb = zc[..., I_OFF:OG_OFF]
    else:
        zc_ifb = uc @ w_in[:, I_OFF:OG_OFF]

    s0 = jnp.zeros((hc.shape[0], N_HEADS, HEAD_DIM, HEAD_DIM), jnp.float32)
    ic = to_heads(zc_ifb[..., :HGRN_WIDTH])
    kcf, gcf = hgrn_forget(zc_ifb[..., HGRN_WIDTH:2 * HGRN_WIDTH], lb_f)
    kcb, gcb = hgrn_forget(zc_ifb[..., 2 * HGRN_WIDTH:3 * HGRN_WIDTH], lb_b)
    if update_ctx:
        qc = to_heads(jax.nn.silu(zc[..., Q_OFF:I_OFF]))
        oc_f, sc_f = chunked_recurrence(qc, kcf, ic, gcf, s0)
        oc_b, sc_b = chunked_recurrence(flip(qc), flip(kcb), flip(ic), flip(gcb), s0)
        oc = oc_f + flip(oc_b)
    else:
        sc_f = final_state(kcf, ic, gcf, s0)
        sc_b = final_state(flip(kcb), flip(ic), flip(gcb), s0)

    qx = to_heads(jax.nn.silu(zx[..., Q_OFF:I_OFF]))
    ix = to_heads(zx[..., I_OFF:FF_OFF])
    kxf, gxf = hgrn_forget(zx[..., FF_OFF:FB_OFF], lb_f)
    kxb, gxb = hgrn_forget(zx[..., FB_OFF:OG_OFF], lb_b)
    ox_f, _ = chunked_recurrence(qx, kxf, ix, gxf, sc_f)
    ox_b, _ = chunked_recurrence(flip(qx), flip(kxb), flip(ix), flip(gxb), sc_b)
    ox = ox_f + flip(ox_b)

    new_hx = hx + g1x * merge_branches(ox, zx, rows, GRID_W, hgrn_norm_g, w_a, w_pool, pool_scale, w_b, w_out)
    if update_ctx:
        hc = hc + g1c * merge_branches(oc, zc, 1, hc.shape[1], hgrn_norm_g, w_a, w_pool, pool_scale, w_b, w_out)

    vx = modulate(rms_norm(new_hx, norm2_g), sh2x, sc2x)
    new_hx = new_hx + g2x * expert_choice_moe(vx, w_router, w_e_gate, w_e_up, w_e_down)
    if update_ctx:
        vc = modulate(rms_norm(hc, norm2_g), sh2c, sc2c)
        hc = hc + g2c * expert_choice_moe(vc, w_router, w_e_gate, w_e_up, w_e_down)
    return new_hx, hc


def setup_inputs(seed: int = 0) -> dict:
    key = jax.random.key(seed)
    ks = jax.random.split(key, 24)
    nrm = lambda k, shape, s: jax.random.normal(k, shape, jnp.float32) * s
    d = D_MODEL
    return {
        "x": nrm(ks[0], (BATCH, SEQ, d), 1.0),
        "c": nrm(ks[1], (BATCH, d), 1.0),
        "ctx": nrm(ks[2], (BATCH, CTX_LEN, d), 1.0),
        "c_ctx": nrm(ks[3], (d,), 1.0),
        "lb_logits": nrm(ks[4], (2, DEPTH + 1, HGRN_WIDTH), 0.5),
        "w_mod": nrm(ks[5], (DEPTH, d, 6 * d), 0.5 * d ** -0.5),
        "b_mod": nrm(ks[6], (DEPTH, 6 * d), 0.02),
        "norm1_g": 1.0 + nrm(ks[7], (DEPTH, d), 0.02),
        "w_in": nrm(ks[8], (DEPTH, d, IN_COLS), d ** -0.5),
        "hgrn_norm_g": 1.0 + nrm(ks[9], (DEPTH, HEAD_DIM), 0.02),
        "w_a": nrm(ks[10], (DEPTH, HGRN_WIDTH, d), HGRN_WIDTH ** -0.5),
        "w_pool": nrm(ks[11], (DEPTH, len(POOL_WINDOWS), POOL_GROUP, POOL_GROUP), POOL_GROUP ** -0.5),
        "pool_scale": 1.0 + nrm(ks[12], (DEPTH, POOL_WIDTH), 0.1),
        "w_b": nrm(ks[13], (DEPTH, POOL_WIDTH, d), POOL_WIDTH ** -0.5),
        "w_out": nrm(ks[14], (DEPTH, d, d), d ** -0.5),
        "norm2_g": 1.0 + nrm(ks[15], (DEPTH, d), 0.02),
        "w_router": nrm(ks[16], (DEPTH, d, N_EXPERTS), d ** -0.5),
        "w_e_gate": nrm(ks[17], (DEPTH, N_EXPERTS, d, EXPERT_FF), d ** -0.5),
        "w_e_up": nrm(ks[18], (DEPTH, N_EXPERTS, d, EXPERT_FF), d ** -0.5),
        "w_e_down": nrm(ks[19], (DEPTH, N_EXPERTS, EXPERT_FF, d), EXPERT_FF ** -0.5),
        "final_g": 1.0 + nrm(ks[20], (d,), 0.02),
    }


def reference(x, c, ctx, c_ctx, lb_logits, w_mod, b_mod, norm1_g, w_in, hgrn_norm_g, w_a,
              w_pool, pool_scale, w_b, w_out, norm2_g, w_router, w_e_gate, w_e_up, w_e_down,
              final_g):
    rows = x.shape[1] // GRID_W
    lb = jnp.cumsum(jax.nn.softmax(lb_logits.astype(jnp.float32), axis=1), axis=1)
    hx, hc = x, ctx
    for l in range(DEPTH):
        hx, hc = trunk_layer(hx, hc, c, c_ctx, lb[0, l], lb[1, l], w_mod[l], b_mod[l], norm1_g[l],
                             w_in[l], hgrn_norm_g[l], w_a[l], w_pool[l], pool_scale[l], w_b[l],
                             w_out[l], norm2_g[l], w_router[l], w_e_gate[l], w_e_up[l], w_e_down[l],
                             rows, l < DEPTH - 1)
    return rms_norm(hx, final_g)
```

```cpp
#include <hip/hip_runtime.h>
#include <hip/hip_cooperative_groups.h>
#include <cstdio>
namespace cg = cooperative_groups;

#define GAS __attribute__((address_space(1)))
#define LAS __attribute__((address_space(3)))
typedef unsigned short bf16;
typedef unsigned v4u __attribute__((ext_vector_type(4)));
typedef unsigned v2u __attribute__((ext_vector_type(2)));
typedef float f32x4 __attribute__((ext_vector_type(4)));
typedef float f32x2 __attribute__((ext_vector_type(2)));
typedef short bf16x8 __attribute__((ext_vector_type(8)));

#ifndef P4M
#define P4M 63
#endif
#ifndef MK_ONE_LAUNCH
#define MK_ONE_LAUNCH 0
#endif

constexpr int NB = 8, SEQ = 8192, D = 1024, M = NB * SEQ, CTXL = 256, MC = NB * CTXL, MT = M + MC;
constexpr int NIN = 7680, NH = 8, HD = 128, NE = 16, CAP = 1024, FF = 1024, PW = 512;
constexpr int GRID_W = 64, GRID_H = SEQ / GRID_W;
constexpr float EPS = 1e-6f;
constexpr int NWAVES = 8, NTHR = 512;
constexpr int NPHASE = 8;

constexpr size_t MiB = 1u << 20;
constexpr size_t WS_CTL = 0, WS_MOD = 1 * MiB, WS_LB = 2 * MiB, WS_IDX = 3 * MiB, WS_VALS = 3 * MiB + 512 * 1024;
constexpr size_t WS_PROBS = 4 * MiB, WS_INV = 8 * MiB;
constexpr size_t WS_MODP = 4 * MiB;
constexpr size_t WS_WIN = 12 * MiB, WS_WA = 27 * MiB, WS_WP = 29 * MiB, WS_WOUT = 30 * MiB;
constexpr size_t WS_Q = 32 * MiB, WS_V = 160 * MiB, WS_GF = 292 * MiB, WS_GB = 424 * MiB, WS_OG = 556 * MiB, WS_P = 684 * MiB, WS_GA = 748 * MiB, WS_GBT = 876 * MiB, WS_END = 1004 * MiB;
constexpr size_t WS_NEWHX = WS_Q;
constexpr size_t WS_AA = WS_GF;
constexpr size_t WS_VX = WS_GF;
constexpr size_t WS_R = WS_GB;
constexpr size_t WS_HID = WS_GB;
constexpr size_t WS_YB = WS_GA;
constexpr size_t DO_UX = 0, DO_OF = 0, DO_OB = 128 * MiB, DO_WGU = 0, DO_WDN = 64 * MiB;

__device__ __forceinline__ unsigned f2bf(float f) { unsigned u = __builtin_bit_cast(unsigned, f); return (u + 0x7fffu + ((u >> 16) & 1u)) >> 16; }
__device__ __forceinline__ unsigned pk2(float lo, float hi) { return f2bf(lo) | (f2bf(hi) << 16); }
__device__ __forceinline__ float bflo(unsigned w) { return __builtin_bit_cast(float, w << 16); }
__device__ __forceinline__ float bfhi(unsigned w) { return __builtin_bit_cast(float, w & 0xffff0000u); }
__device__ __forceinline__ float bf2f(bf16 b) { return __builtin_bit_cast(float, (unsigned)b << 16); }
__device__ __forceinline__ unsigned pkh2(float lo, float hi) { const _Float16 a = (_Float16)lo, b = (_Float16)hi; return (unsigned)__builtin_bit_cast(unsigned short, a) | ((unsigned)__builtin_bit_cast(unsigned short, b) << 16); }
__device__ __forceinline__ float h2f(unsigned short h) { return (float)__builtin_bit_cast(_Float16, h); }
__device__ __forceinline__ float wave_sum(float v) {
#pragma unroll
    for (int o = 1; o < 64; o <<= 1) v += __shfl_xor(v, o);
    return v;
}
__device__ __forceinline__ float sigmoidf_(float x) { return 1.0f / (1.0f + __expf(-x)); }
__device__ __forceinline__ float siluf_(float x) { return x / (1.0f + __expf(-x)); }
#define LDS_WAIT() asm volatile("s_waitcnt lgkmcnt(0)" ::: "memory")
#define VM_WAIT() asm volatile("s_waitcnt vmcnt(0)" ::: "memory")
__device__ __forceinline__ void wg_fence() {
    asm volatile("s_waitcnt vmcnt(0) lgkmcnt(0)" ::: "memory");
    __syncthreads();
    if (threadIdx.x < 64) { __builtin_amdgcn_fence(__ATOMIC_ACQUIRE, "agent"); asm volatile("s_waitcnt vmcnt(0)" ::: "memory"); }
    __syncthreads();
}

namespace pg8 {
#define PG8_LAS __attribute__((address_space(3)))
typedef unsigned short bf16_t;
typedef unsigned u32x4 __attribute__((ext_vector_type(4)));
constexpr int BM = 256, BK = 64, HALF = 128, HTB = HALF * BK * 2, STAGE_BYTES = 8 * HTB, NXCD = 8, WGM = 8;
__host__ __device__ __forceinline__ int lds_byte(int r, int c) { const int st = (r >> 4) * 2 + (c >> 5), rr = r & 15, cc = c & 31, ob = rr * 64 + cc * 2; return st * 1024 + (ob ^ (((ob >> 9) & 1) << 5)); }
__host__ __device__ __forceinline__ void stage_rc(int b, int& R, int& C) { const int st = b / 1024, sb = b % 1024, swz = sb ^ (((sb >> 9) & 1) << 5); R = (st >> 1) * 16 + swz / 64; C = (st & 1) * 32 + (swz % 64) / 2; }
__host__ __device__ __forceinline__ int perm32(int rho) { const int n = rho >> 4, i = rho & 15; return 8 * (i >> 2) + 4 * n + (i & 3); }
struct Unit { int pm, pn; };
struct Gemm { const bf16_t* A; const bf16_t* Bt; int K; const int* gidx; };
__device__ __forceinline__ unsigned cvt_pk_bf16(float lo, float hi) { unsigned r; asm volatile("v_cvt_pk_bf16_f32 %0, %1, %2" : "=v"(r) : "v"(lo), "v"(hi)); return r; }

template <class Epi, class Sched, bool ALIGN_EPI, bool SP2, bool GATHER>
__device__ __forceinline__ void gemm_phase(PG8_LAS unsigned char* lds, const Gemm g, const Sched& S, const Epi& E, int tid_in) {
    asm volatile("" : "+v"(tid_in));
    const int tid = tid_in, wid = __builtin_amdgcn_readfirstlane(tid >> 6), lane = tid & 63, wr = wid >> 2, wc = wid & 3, fr = lane & 15, fq = lane >> 4;
    const int K = g.K, nt = K / BK;
    unsigned voffA[2], voffA1[2], voffB[2];
#pragma unroll
    for (int i = 0; i < 2; ++i) { int R, C; stage_rc(tid * 16 + i * 8192, R, C); const int Rb = Epi::PERM ? ((R & ~31) + perm32(R & 31)) : R;
        if (GATHER) { voffA[i] = (unsigned)(g.gidx[R] * K + C) * 2u; voffA1[i] = (unsigned)(g.gidx[HALF + R] * K + C) * 2u; }
        else { voffA[i] = (unsigned)(R * K + C) * 2u; voffA1[i] = voffA[i]; }
        voffB[i] = (unsigned)(Rb * K + C) * 2u; }
    const size_t kstep = (size_t)(BK * 2);
    const size_t hstep = (size_t)HALF * K * 2;
    const size_t hstepA = GATHER ? 0 : hstep;
    const size_t tstep = 2 * hstep;
    const unsigned ldsw = (unsigned)wid * 1024u;
    const int aoff = lds_byte(wr * 64 + fr, fq * 8), boff = lds_byte(wc * 32 + fr, fq * 8);
#define PG8_SA(b, h) (((b) * 2 + (h)) * HTB)
#define PG8_SB(b, h) ((4 + (b) * 2 + (h)) * HTB)
#define PG8_STAGE(bufoff, gbase, voff) do { _Pragma("unroll") for (int _i = 0; _i < 2; ++_i) \
        __builtin_amdgcn_global_load_lds((const unsigned*)((const char*)(gbase) + (voff)[_i]), (PG8_LAS unsigned*)(lds + (bufoff) + ldsw + _i * 8192), 16, 0, 0); } while (0)
#define PG8_LDA(dst, b, h) do { _Pragma("unroll") for (int m = 0; m < 4; ++m) _Pragma("unroll") for (int k = 0; k < 2; ++k) dst[m][k] = *(const PG8_LAS bf16x8*)(lds + PG8_SA(b, h) + aoff + m * 2048 + k * 1024); } while (0)
#define PG8_LDB(dst, b, h) do { _Pragma("unroll") for (int n = 0; n < 2; ++n) _Pragma("unroll") for (int k = 0; k < 2; ++k) dst[n][k] = *(const PG8_LAS bf16x8*)(lds + PG8_SB(b, h) + boff + n * 2048 + k * 1024); } while (0)
#define PG8_MMA(ai, bj, At, Bt) do { __builtin_amdgcn_s_setprio(1); _Pragma("unroll") for (int m = 0; m < 4; ++m) _Pragma("unroll") for (int n = 0; n < 2; ++n) _Pragma("unroll") for (int k = 0; k < 2; ++k) \
        acc[ai][bj][m][n] = __builtin_amdgcn_mfma_f32_16x16x32_bf16(Bt[n][k], At[m][k], acc[ai][bj][m][n], 0, 0, 0); __builtin_amdgcn_s_setprio(0); } while (0)
#define PG8_WAIT_V(n) asm volatile("s_waitcnt vmcnt(" #n ")" ::: "memory")
#define PG8_WAIT_L(n) asm volatile("s_waitcnt lgkmcnt(" #n ")" ::: "memory")
#define PG8_BAR __builtin_amdgcn_s_barrier()
#define PG8_SCHED __builtin_amdgcn_sched_barrier(0)
    Unit cur, nxt; int ui = 0;
    if (!S.next(0, cur)) return;
    f32x4 acc[2][2][4][2];
#pragma unroll
    for (int a = 0; a < 2; ++a)
#pragma unroll
        for (int b = 0; b < 2; ++b)
#pragma unroll
            for (int m = 0; m < 4; ++m)
#pragma unroll
                for (int n = 0; n < 2; ++n) acc[a][b][m][n] = (f32x4){0.f, 0.f, 0.f, 0.f};
    bf16x8 At[4][2], B0[2][2], B1[2][2];
    const char* cA = (const char*)g.A + (GATHER ? (size_t)0 : (size_t)cur.pm * tstep); const char* cB = (const char*)g.Bt + (size_t)cur.pn * tstep;
    if constexpr (SP2) {
        PG8_STAGE(PG8_SB(0, 0), cB, voffB); PG8_STAGE(PG8_SB(0, 1), cB + hstep, voffB); PG8_STAGE(PG8_SA(0, 0), cA, voffA); PG8_STAGE(PG8_SA(0, 1), cA + hstepA, voffA1);
        if (wr == 1) PG8_BAR;
        PG8_WAIT_V(2); PG8_BAR;
        PG8_STAGE(PG8_SB(1, 0), cB + kstep, voffB); PG8_STAGE(PG8_SA(1, 0), cA + kstep, voffA); PG8_STAGE(PG8_SB(1, 1), cB + hstep + kstep, voffB);
        PG8_WAIT_V(6); PG8_BAR;
    } else {
        PG8_STAGE(PG8_SB(0, 0), cB, voffB); PG8_STAGE(PG8_SA(0, 0), cA, voffA); PG8_STAGE(PG8_SB(0, 1), cB + hstep, voffB); PG8_STAGE(PG8_SA(0, 1), cA + hstepA, voffA1);
        if (wr == 1) PG8_BAR;
        PG8_WAIT_V(4); PG8_BAR;
        PG8_STAGE(PG8_SB(1, 0), cB + kstep, voffB); PG8_STAGE(PG8_SA(1, 0), cA + kstep, voffA); PG8_STAGE(PG8_SB(1, 1), cB + hstep + kstep, voffB);
        PG8_WAIT_V(6); PG8_BAR;
    }
    for (;;) {
        const bool has_next = S.next(ui + 1, nxt);
        const char* nA = has_next ? (const char*)g.A + (GATHER ? (size_t)0 : (size_t)nxt.pm * tstep) : cA; const char* nB = has_next ? (const char*)g.Bt + (size_t)nxt.pn * tstep : cB;
        for (int t = 0; t < nt; t += 2) {
            const bool last = (t == nt - 2);
            const char* a1 = cA + (size_t)(t + 1) * kstep;
            const char* a2 = last ? nA : cA + (size_t)(t + 2) * kstep; const char* b2 = last ? nB : cB + (size_t)(t + 2) * kstep;
            const char* a3 = a2 + kstep; const char* b3 = b2 + kstep;
            if constexpr (SP2) {
            PG8_LDB(B0, 0, 0); PG8_LDB(B1, 0, 1); PG8_SCHED; PG8_LDA(At, 0, 0); PG8_STAGE(PG8_SA(1, 1), a1 + hstepA, voffA1);
            PG8_WAIT_V(8); PG8_WAIT_L(0); PG8_BAR; PG8_MMA(0, 0, At, B0); PG8_MMA(0, 1, At, B1); PG8_BAR; PG8_SCHED;
            PG8_LDA(At, 0, 1); PG8_STAGE(PG8_SB(0, 0), b2, voffB); PG8_STAGE(PG8_SB(0, 1), b2 + hstep, voffB); PG8_STAGE(PG8_SA(0, 0), a2, voffA);
            PG8_WAIT_V(8); PG8_WAIT_L(0); PG8_BAR; PG8_MMA(1, 0, At, B0); PG8_MMA(1, 1, At, B1); PG8_BAR; PG8_SCHED;
            PG8_LDB(B0, 1, 0); PG8_LDB(B1, 1, 1); PG8_SCHED; PG8_LDA(At, 1, 0); PG8_STAGE(PG8_SA(0, 1), a2 + hstepA, voffA1);
            PG8_WAIT_V(8); PG8_WAIT_L(0); PG8_BAR; PG8_MMA(0, 0, At, B0); PG8_MMA(0, 1, At, B1); PG8_BAR; PG8_SCHED;
            PG8_LDA(At, 1, 1); PG8_STAGE(PG8_SB(1, 0), b3, voffB); PG8_STAGE(PG8_SB(1, 1), b3 + hstep, voffB); PG8_STAGE(PG8_SA(1, 0), a3, voffA);
            PG8_WAIT_V(8); PG8_WAIT_L(0); PG8_BAR; PG8_MMA(1, 0, At, B0); PG8_MMA(1, 1, At, B1); PG8_BAR; PG8_SCHED;
            } else {
            PG8_LDB(B0, 0, 0); PG8_SCHED; PG8_LDA(At, 0, 0); PG8_STAGE(PG8_SA(1, 1), a1 + hstepA, voffA1);
            PG8_WAIT_L(8); PG8_BAR; PG8_WAIT_L(0); PG8_MMA(0, 0, At, B0); PG8_BAR; PG8_SCHED;
            PG8_LDB(B1, 0, 1); PG8_STAGE(PG8_SB(0, 0), b2, voffB);
            PG8_BAR; PG8_WAIT_L(0); PG8_MMA(0, 1, At, B1); PG8_BAR;
            PG8_LDA(At, 0, 1); PG8_STAGE(PG8_SA(0, 0), a2, voffA);
            PG8_BAR; PG8_WAIT_L(0); PG8_MMA(1, 0, At, B0); PG8_BAR; PG8_SCHED;
            PG8_STAGE(PG8_SB(0, 1), b2 + hstep, voffB);
            PG8_WAIT_V(6); PG8_BAR; PG8_MMA(1, 1, At, B1); PG8_BAR;
            PG8_LDB(B0, 1, 0); PG8_SCHED; PG8_LDA(At, 1, 0); PG8_STAGE(PG8_SA(0, 1), a2 + hstepA, voffA1);
            PG8_WAIT_L(8); PG8_BAR; PG8_WAIT_L(0); PG8_MMA(0, 0, At, B0); PG8_BAR; PG8_SCHED;
            PG8_LDB(B1, 1, 1); PG8_STAGE(PG8_SB(1, 0), b3, voffB);
            PG8_BAR; PG8_WAIT_L(0); PG8_MMA(0, 1, At, B1); PG8_BAR;
            PG8_LDA(At, 1, 1); PG8_STAGE(PG8_SA(1, 0), a3, voffA);
            PG8_BAR; PG8_WAIT_L(0); PG8_MMA(1, 0, At, B0); PG8_BAR; PG8_SCHED;
            PG8_STAGE(PG8_SB(1, 1), b3 + hstep, voffB);
            PG8_WAIT_V(6); PG8_BAR; PG8_MMA(1, 1, At, B1); PG8_BAR;
            }
        }
        if constexpr (ALIGN_EPI) { if (wr == 0) PG8_BAR; }
        E(acc, cur, wr, wc, fr, fq);
        if (!has_next) break;
#pragma unroll
        for (int a = 0; a < 2; ++a)
#pragma unroll
            for (int b = 0; b < 2; ++b)
#pragma unroll
                for (int m = 0; m < 4; ++m)
#pragma unroll
                    for (int n = 0; n < 2; ++n) acc[a][b][m][n] = (f32x4){0.f, 0.f, 0.f, 0.f};
        cur = nxt; cA = nA; cB = nB; ++ui;
        if constexpr (ALIGN_EPI) { if (wr == 1) PG8_BAR; }
    }
    PG8_WAIT_V(0);
    if constexpr (!ALIGN_EPI) { if (wr == 0) PG8_BAR; }
    PG8_BAR;
#undef PG8_SA
#undef PG8_SB
#undef PG8_STAGE
#undef PG8_LDA
#undef PG8_LDB
#undef PG8_MMA
#undef PG8_WAIT_V
#undef PG8_WAIT_L
#undef PG8_BAR
#undef PG8_SCHED
}

struct OrderIn {
    int G, c;
    __device__ __forceinline__ bool next(int i, Unit& u) const {
        constexpr int nM = M / BM, nN = NIN / BM, nwg = nM * nN, nctx = (MC / BM) * 12;
        const long L = (long)i * G + c;
        if (L >= nwg + nctx) return false;
        if (L >= nwg) { const int j = (int)L - nwg; u.pm = nM + j / 12; u.pn = 4 + j % 12; return true; }
        int wgid = (int)L; { const int q = nwg / NXCD, r = nwg % NXCD, xcd = wgid % NXCD, off = wgid / NXCD; wgid = (xcd < r ? xcd * (q + 1) : r * (q + 1) + (xcd - r) * q) + off; }
        const int nig = WGM * nN, gid = wgid / nig, fm = gid * WGM, gsz = (nM - fm) < WGM ? (nM - fm) : WGM;
        u.pm = fm + ((wgid % nig) % gsz); u.pn = (wgid % nig) / gsz; return true;
    }
};
struct OrderRow {
    int pm, nN;
    __device__ __forceinline__ bool next(int i, Unit& u) const { if (i >= nN) return false; u.pm = pm; u.pn = i; return true; }
};

struct EpiIn {
    static constexpr bool PERM = true;
    bf16 *Q, *V, *GF, *GB, *OG, *P, *GA, *GBT; const float* lb;
    __device__ __forceinline__ void operator()(const f32x4 (&acc)[2][2][4][2], const Unit& u, int wr, int wc, int fr, int fq) const {
        const int pn = u.pn; int kind, colt, ldc = D; bf16* base; const float* lbp = lb;
        if (pn < 4)       { kind = 1; base = Q;   colt = pn * 256; }
        else if (pn < 8)  { kind = 0; base = V;   colt = (pn - 4) * 256; }
        else if (pn < 12) { kind = 3; base = GF;  colt = (pn - 8) * 256; }
        else if (pn < 16) { kind = 3; base = GB;  colt = (pn - 12) * 256; lbp = lb + 1024; }
        else if (pn < 20) { kind = 1; base = OG;  colt = (pn - 16) * 256; }
        else if (pn < 22) { kind = 0; base = P;   colt = (pn - 20) * 256; ldc = PW; }
        else if (pn < 26) { kind = 2; base = GA;  colt = (pn - 22) * 256; }
        else              { kind = 2; base = GBT; colt = (pn - 26) * 256; }
        const int row0 = u.pm * BM + wr * 64 + fr, col0 = colt + wc * 32 + 8 * fq;
        f32x4 l0[2], l1[2];
        if (kind == 3) {
#pragma unroll
            for (int bj = 0; bj < 2; ++bj) { l0[bj] = *(const f32x4*)(lbp + col0 + bj * HALF); l1[bj] = *(const f32x4*)(lbp + col0 + bj * HALF + 4); }
        }
#pragma unroll
        for (int ai = 0; ai < 2; ++ai)
#pragma unroll
            for (int m = 0; m < 4; ++m) { bf16* rowp = base + (size_t)(row0 + ai * HALF + m * 16) * ldc + col0;
#pragma unroll
                for (int bj = 0; bj < 2; ++bj) { f32x4 v0 = acc[ai][bj][m][0], v1 = acc[ai][bj][m][1]; u32x4 w;
                    if (kind == 3) {
#pragma unroll
                        for (int j = 0; j < 4; ++j) { v0[j] = __logf(l0[bj][j] + (1.0f - l0[bj][j]) * sigmoidf_(v0[j])); v1[j] = __logf(l1[bj][j] + (1.0f - l1[bj][j]) * sigmoidf_(v1[j])); }
                        w.x = pkh2(v0[0], v0[1]); w.y = pkh2(v0[2], v0[3]); w.z = pkh2(v1[0], v1[1]); w.w = pkh2(v1[2], v1[3]);
                    } else {
                        if (kind == 1) {
#pragma unroll
                            for (int j = 0; j < 4; ++j) { v0[j] = siluf_(v0[j]); v1[j] = siluf_(v1[j]); }
                        } else if (kind == 2) {
#pragma unroll
                            for (int j = 0; j < 4; ++j) { v0[j] = sigmoidf_(v0[j]); v1[j] = sigmoidf_(v1[j]); }
                        }
                        w.x = cvt_pk_bf16(v0[0], v0[1]); w.y = cvt_pk_bf16(v0[2], v0[3]); w.z = cvt_pk_bf16(v1[0], v1[1]); w.w = cvt_pk_bf16(v1[2], v1[3]);
                    }
                    *(u32x4*)(rowp + bj * HALF) = w; } }
    }
};
struct EpiGateA {
    static constexpr bool PERM = true;
    bf16* GA;
    __device__ __forceinline__ void operator()(const f32x4 (&acc)[2][2][4][2], const Unit& u, int wr, int wc, int fr, int fq) const {
        const int row0 = u.pm * BM + wr * 64 + fr, col0 = u.pn * BM + wc * 32 + 8 * fq;
#pragma unroll
        for (int ai = 0; ai < 2; ++ai)
#pragma unroll
            for (int m = 0; m < 4; ++m) { bf16* rowp = GA + (size_t)(row0 + ai * HALF + m * 16) * D + col0;
#pragma unroll
                for (int bj = 0; bj < 2; ++bj) { const f32x4 v0 = acc[ai][bj][m][0], v1 = acc[ai][bj][m][1]; const u32x4 gw = *(const u32x4*)(rowp + bj * HALF); u32x4 w;
                    w.x = cvt_pk_bf16(v0[0] * bflo(gw.x), v0[1] * bfhi(gw.x)); w.y = cvt_pk_bf16(v0[2] * bflo(gw.y), v0[3] * bfhi(gw.y));
                    w.z = cvt_pk_bf16(v1[0] * bflo(gw.z), v1[1] * bfhi(gw.z)); w.w = cvt_pk_bf16(v1[2] * bflo(gw.w), v1[3] * bfhi(gw.w));
                    *(u32x4*)(rowp + bj * HALF) = w; }
                if (m & 1) asm volatile("" ::: "memory"); }
    }
};
struct EpiGateB {
    static constexpr bool PERM = true;
    const bf16* T; bf16* GBT;
    __device__ __forceinline__ void operator()(const f32x4 (&acc)[2][2][4][2], const Unit& u, int wr, int wc, int fr, int fq) const {
        const int row0 = u.pm * BM + wr * 64 + fr, col0 = u.pn * BM + wc * 32 + 8 * fq;
#pragma unroll
        for (int ai = 0; ai < 2; ++ai)
#pragma unroll
            for (int m = 0; m < 4; ++m) { const size_t off = (size_t)(row0 + ai * HALF + m * 16) * D + col0;
#pragma unroll
                for (int bj = 0; bj < 2; ++bj) { const f32x4 v0 = acc[ai][bj][m][0], v1 = acc[ai][bj][m][1];
                    const u32x4 gw = *(const u32x4*)(GBT + off + bj * HALF), tw = *(const u32x4*)(T + off + bj * HALF); u32x4 w;
                    w.x = cvt_pk_bf16(bflo(tw.x) + v0[0] * bflo(gw.x), bfhi(tw.x) + v0[1] * bfhi(gw.x)); w.y = cvt_pk_bf16(bflo(tw.y) + v0[2] * bflo(gw.y), bfhi(tw.y) + v0[3] * bfhi(gw.y));
                    w.z = cvt_pk_bf16(bflo(tw.z) + v1[0] * bflo(gw.z), bfhi(tw.z) + v1[1] * bfhi(gw.z)); w.w = cvt_pk_bf16(bflo(tw.w) + v1[2] * bflo(gw.w), bfhi(tw.w) + v1[3] * bfhi(gw.w));
                    *(u32x4*)(GBT + off + bj * HALF) = w; }
                asm volatile("" ::: "memory"); }
    }
};
struct EpiResid {
    static constexpr bool PERM = false;
    const float* X; float* O; const float* g1;
    __device__ __forceinline__ void operator()(const f32x4 (&acc)[2][2][4][2], const Unit& u, int wr, int wc, int fr, int fq) const {
        const int row0 = u.pm * BM + wr * 64 + fr, col0 = u.pn * BM + wc * 32 + 4 * fq;
        f32x4 gv[2][2];
#pragma unroll
        for (int bj = 0; bj < 2; ++bj)
#pragma unroll
            for (int n = 0; n < 2; ++n) gv[bj][n] = *(const f32x4*)(g1 + col0 + bj * HALF + n * 16);
#pragma unroll
        for (int ai = 0; ai < 2; ++ai)
#pragma unroll
            for (int m = 0; m < 4; ++m) { const size_t off = (size_t)(row0 + ai * HALF + m * 16) * D + col0;
#pragma unroll
                for (int bj = 0; bj < 2; ++bj)
#pragma unroll
                    for (int n = 0; n < 2; ++n) { const f32x4 xv = *(const f32x4*)(X + off + bj * HALF + n * 16); *(f32x4*)(O + off + bj * HALF + n * 16) = xv + gv[bj][n] * acc[ai][bj][m][n]; }
                asm volatile("" ::: "memory"); }
    }
};
struct EpiHid {
    static constexpr bool PERM = true;
    bf16* H;
    __device__ __forceinline__ void operator()(const f32x4 (&acc)[2][2][4][2], const Unit& u, int wr, int wc, int fr, int fq) const {
        const int row0 = wr * 64 + fr, col0 = u.pn * HALF + wc * 32 + 8 * fq;
#pragma unroll
        for (int ai = 0; ai < 2; ++ai)
#pragma unroll
            for (int m = 0; m < 4; ++m) { bf16* rowp = H + (size_t)(row0 + ai * HALF + m * 16) * FF + col0;
                const f32x4 g0 = acc[ai][0][m][0], g1 = acc[ai][0][m][1], u0 = acc[ai][1][m][0], u1 = acc[ai][1][m][1]; u32x4 w;
                w.x = cvt_pk_bf16(siluf_(g0[0]) * u0[0], siluf_(g0[1]) * u0[1]); w.y = cvt_pk_bf16(siluf_(g0[2]) * u0[2], siluf_(g0[3]) * u0[3]);
                w.z = cvt_pk_bf16(siluf_(g1[0]) * u1[0], siluf_(g1[1]) * u1[1]); w.w = cvt_pk_bf16(siluf_(g1[2]) * u1[2], siluf_(g1[3]) * u1[3]);
                *(u32x4*)rowp = w; }
    }
};
struct EpiDown {
    static constexpr bool PERM = true;
    bf16* Y; const float* vals;
    __device__ __forceinline__ void operator()(const f32x4 (&acc)[2][2][4][2], const Unit& u, int wr, int wc, int fr, int fq) const {
        const int row0 = wr * 64 + fr, col0 = u.pn * BM + wc * 32 + 8 * fq;
#pragma unroll
        for (int ai = 0; ai < 2; ++ai)
#pragma unroll
            for (int m = 0; m < 4; ++m) { const int r = row0 + ai * HALF + m * 16; const float s = vals[r]; bf16* rowp = Y + (size_t)r * D + col0;
#pragma unroll
                for (int bj = 0; bj < 2; ++bj) { const f32x4 v0 = acc[ai][bj][m][0] * s, v1 = acc[ai][bj][m][1] * s; u32x4 w;
                    w.x = cvt_pk_bf16(v0[0], v0[1]); w.y = cvt_pk_bf16(v0[2], v0[3]); w.z = cvt_pk_bf16(v1[0], v1[1]); w.w = cvt_pk_bf16(v1[2], v1[3]);
                    *(u32x4*)(rowp + bj * HALF) = w; } }
    }
};
}

constexpr int RING_BYTES = 131072;
constexpr int LDS_BYTES = 147456;

struct Args {
    const float* in[21]; float* out; unsigned char* ws; int ph_lo, ph_hi;
};

__device__ __forceinline__ void transpose_item(const float* W, int K, int N, bf16* WT, int k0, int n0, int drow0, LAS float* scr, int lane) {
#pragma unroll 8
    for (int i = 0; i < 32; ++i) { const int kk = 2 * i + (lane >> 5); scr[kk * 33 + (lane & 31)] = W[(size_t)(k0 + kk) * N + n0 + (lane & 31)]; }
    LDS_WAIT(); asm volatile("" ::: "memory");
    const int c = lane & 7;
#pragma unroll
    for (int j = 0; j < 4; ++j) { const int n = (lane >> 3) + 8 * j; const LAS float* s = scr + (8 * c) * 33 + n;
        v4u o; o.x = pk2(s[0 * 33], s[1 * 33]); o.y = pk2(s[2 * 33], s[3 * 33]); o.z = pk2(s[4 * 33], s[5 * 33]); o.w = pk2(s[6 * 33], s[7 * 33]);
        *(v4u*)(WT + (size_t)(drow0 + n) * K + k0 + 8 * c) = o; }
    LDS_WAIT(); asm volatile("" ::: "memory");
}


__device__ __forceinline__ void p4_build_aa(int slab, const bf16* OF, const bf16* OB, const bf16* OG, const float* hgrn_g, bf16* AA, int tid) {
    asm volatile("" : "+v"(tid));
    const int lane = tid & 63, wave = __builtin_amdgcn_readfirstlane(tid >> 6), row0 = slab * 256;
    float hg[16];
#pragma unroll
    for (int i = 0; i < 4; ++i) { const f32x4 t = *(const f32x4*)(hgrn_g + 16 * (lane & 7) + 4 * i); hg[4 * i] = t.x; hg[4 * i + 1] = t.y; hg[4 * i + 2] = t.z; hg[4 * i + 3] = t.w; }
    for (int r = wave * 32; r < wave * 32 + 32; ++r) {
        const size_t off = (size_t)(row0 + r) * D + 16 * lane;
        const v4u f0 = *(const v4u*)(OF + off), f1 = *(const v4u*)(OF + off + 8), b0 = *(const v4u*)(OB + off), b1 = *(const v4u*)(OB + off + 8);
        const v4u g0 = *(const v4u*)(OG + off), g1 = *(const v4u*)(OG + off + 8);
        float o[16], gg[16];
        const unsigned fw[8] = {f0.x, f0.y, f0.z, f0.w, f1.x, f1.y, f1.z, f1.w}, bw[8] = {b0.x, b0.y, b0.z, b0.w, b1.x, b1.y, b1.z, b1.w}, gw8[8] = {g0.x, g0.y, g0.z, g0.w, g1.x, g1.y, g1.z, g1.w};
        float ss = 0.f;
#pragma unroll
        for (int i = 0; i < 8; ++i) { o[2 * i] = bflo(fw[i]) + bflo(bw[i]); o[2 * i + 1] = bfhi(fw[i]) + bfhi(bw[i]); gg[2 * i] = bflo(gw8[i]); gg[2 * i + 1] = bfhi(gw8[i]); ss += o[2 * i] * o[2 * i] + o[2 * i + 1] * o[2 * i + 1]; }
        ss += __shfl_xor(ss, 1); ss += __shfl_xor(ss, 2); ss += __shfl_xor(ss, 4);
        const float rstd = rsqrtf(ss * (1.0f / HD) + EPS);
        unsigned w[8];
#pragma unroll
        for (int i = 0; i < 8; ++i) w[i] = pk2((o[2 * i] * rstd * hg[2 * i]) * gg[2 * i], (o[2 * i + 1] * rstd * hg[2 * i + 1]) * gg[2 * i + 1]);
        *(v4u*)(AA + off) = (v4u){w[0], w[1], w[2], w[3]}; *(v4u*)(AA + off + 8) = (v4u){w[4], w[5], w[6], w[7]};
    }
}
__device__ __forceinline__ void p4_pool(LAS unsigned char* lds, int slab, const bf16* PB, bf16* RB, int tid) {
    asm volatile("" : "+v"(tid));
    LAS float* T = (LAS float*)lds; constexpr int TP = 68;
    const int b = slab / 32, row0 = slab * 256, gr0 = 4 * (slab % 32);
#pragma unroll 1
    for (int jh = 0; jh < 8; ++jh) {
        const int j = jh >> 1, hh = jh & 1, w = 2 << j, chb = j * 128 + hh * 64;
        { const int q = tid & 1, cc = (tid >> 1) & 63, r = tid >> 7; const int R = gr0 + r;
          int R0 = R - w / 2; R0 = R0 < 0 ? 0 : R0; int R1 = R + w / 2 - 1; R1 = (R1 > GRID_H - 1 ? GRID_H - 1 : R1) + 1;
          float a[32];
#pragma unroll
          for (int i = 0; i < 32; ++i) a[i] = 0.f;
#pragma unroll 1
          for (int rr = R0; rr < R1; ++rr) { const bf16* src = PB + ((size_t)b * SEQ + rr * GRID_W + cc) * PW + chb + q * 32;
#pragma unroll
              for (int k = 0; k < 4; ++k) { const v4u u = *(const v4u*)(src + 8 * k); a[8 * k + 0] += bflo(u.x); a[8 * k + 1] += bfhi(u.x); a[8 * k + 2] += bflo(u.y); a[8 * k + 3] += bfhi(u.y);
                  a[8 * k + 4] += bflo(u.z); a[8 * k + 5] += bfhi(u.z); a[8 * k + 6] += bflo(u.w); a[8 * k + 7] += bfhi(u.w); } }
          LAS float* dst = T + (r * 64 + cc) * TP + q * 32;
#pragma unroll
          for (int k = 0; k < 8; ++k) *(LAS f32x4*)(dst + 4 * k) = (f32x4){a[4 * k], a[4 * k + 1], a[4 * k + 2], a[4 * k + 3]}; }
        __syncthreads();
        { const int q = tid & 1, tl = tid >> 1, r = tl >> 6, cc = tl & 63; const int R = gr0 + r;
          int R0 = R - w / 2; R0 = R0 < 0 ? 0 : R0; int R1 = R + w / 2 - 1; R1 = (R1 > GRID_H - 1 ? GRID_H - 1 : R1) + 1;
          int C0 = cc - w / 2; C0 = C0 < 0 ? 0 : C0; int C1 = cc + w / 2 - 1; C1 = (C1 > GRID_W - 1 ? GRID_W - 1 : C1) + 1;
          const float inv = 1.0f / (float)((R1 - R0) * (C1 - C0));
          float s[32];
#pragma unroll
          for (int i = 0; i < 32; ++i) s[i] = 0.f;
#pragma unroll 1
          for (int c2 = C0; c2 < C1; ++c2) { const LAS float* src = T + (r * 64 + c2) * TP + q * 32;
#pragma unroll
              for (int k = 0; k < 8; ++k) { const f32x4 t4 = *(const LAS f32x4*)(src + 4 * k); s[4 * k] += t4.x; s[4 * k + 1] += t4.y; s[4 * k + 2] += t4.z; s[4 * k + 3] += t4.w; } }
          const size_t po = (size_t)(row0 + tl) * PW + chb + q * 32;
#pragma unroll
          for (int k = 0; k < 4; ++k) { const v4u u = *(const v4u*)(PB + po + 8 * k); v4u o;
              o.x = pk2(s[8 * k + 0] * inv - bflo(u.x), s[8 * k + 1] * inv - bfhi(u.x)); o.y = pk2(s[8 * k + 2] * inv - bflo(u.y), s[8 * k + 3] * inv - bfhi(u.y));
              o.z = pk2(s[8 * k + 4] * inv - bflo(u.z), s[8 * k + 5] * inv - bfhi(u.z)); o.w = pk2(s[8 * k + 6] * inv - bflo(u.w), s[8 * k + 7] * inv - bfhi(u.w));
              *(v4u*)(RB + po + 8 * k) = o; } }
        __syncthreads();
    }
}
__device__ __forceinline__ void p4_rows(LAS unsigned char* lds, int slab, const float* NEWHX, const float* modb, const float* norm2_g, const float* w_router, bf16* VX, float* PROBS, int tid) {
    asm volatile("" : "+v"(tid));
    const int lane = tid & 63, wave = __builtin_amdgcn_readfirstlane(tid >> 6), row0 = slab * 256;
    LAS float* W2 = (LAS float*)lds;
    LAS float* rstd_s = W2 + D * NE;
    LAS float* bias_s = rstd_s + 256;
    const float* sh2 = modb + 3 * D; const float* sc2 = modb + 4 * D;
    for (int e4 = tid; e4 < D * NE; e4 += NTHR) { const int c = e4 >> 4, e = e4 & 15;
        W2[(((c >> 4) * 4 + ((c >> 2) & 3)) * 16 + e) * 4 + (c & 3)] = norm2_g[c] * (1.0f + sc2[c]) * w_router[e4]; }
    { const int e = tid & 15, part = tid >> 4; float a = 0.f;
      for (int c = part * 32; c < part * 32 + 32; ++c) a += sh2[c] * w_router[c * NE + e];
      bias_s[e * 32 + part] = a; }
#pragma unroll 1
    for (int r = wave * 32; r < wave * 32 + 32; ++r) {
        const int row = row0 + r; const float* src = NEWHX + (size_t)row * D;
        f32x4 v[4]; float ss = 0.f;
#pragma unroll
        for (int j = 0; j < 4; ++j) { v[j] = *(const f32x4*)(src + 4 * lane + 256 * j); ss += (v[j].x * v[j].x + v[j].y * v[j].y) + (v[j].z * v[j].z + v[j].w * v[j].w); }
        const float rstd = rsqrtf(wave_sum(ss) * (1.0f / D) + EPS);
        if (lane == 0) rstd_s[r] = rstd;
#pragma unroll
        for (int j = 0; j < 4; ++j) { const int c = 4 * lane + 256 * j; const f32x4 g = *(const f32x4*)(norm2_g + c), sc = *(const f32x4*)(sc2 + c), sh = *(const f32x4*)(sh2 + c);
            const f32x4 o = (v[j] * rstd * g) * (sc + 1.0f) + sh;
            v2u w; w.x = pk2(o.x, o.y); w.y = pk2(o.z, o.w); *(v2u*)(VX + (size_t)row * D + c) = w; }
    }
    __syncthreads();
    if (tid < 16) { float a = 0.f; for (int p = 0; p < 32; ++p) a += bias_s[tid * 32 + p]; bias_s[512 + tid] = a; }
    __syncthreads();
    const int fr = lane & 15, fq = lane >> 4;
#pragma unroll 1
    for (int grp = wave * 2; grp < wave * 2 + 2; ++grp) {
        const float* arow = NEWHX + (size_t)(row0 + grp * 16 + fr) * D + 4 * fq;
        f32x4 acc = (f32x4){0.f, 0.f, 0.f, 0.f};
#pragma unroll 4
        for (int s = 0; s < 64; ++s) { const f32x4 a = *(const f32x4*)(arow + 16 * s); const f32x4 w = *(const LAS f32x4*)(W2 + ((s * 4 + fq) * 16 + fr) * 4);
            acc = __builtin_amdgcn_mfma_f32_16x16x4f32(a.x, w.x, acc, 0, 0, 0); acc = __builtin_amdgcn_mfma_f32_16x16x4f32(a.y, w.y, acc, 0, 0, 0);
            acc = __builtin_amdgcn_mfma_f32_16x16x4f32(a.z, w.z, acc, 0, 0, 0); acc = __builtin_amdgcn_mfma_f32_16x16x4f32(a.w, w.w, acc, 0, 0, 0); }
        const float be = bias_s[512 + fr];
#pragma unroll
        for (int i = 0; i < 4; ++i) { const int r = grp * 16 + 4 * fq + i; float lg = acc[i] * rstd_s[r] + be;
            float mx = lg; mx = fmaxf(mx, __shfl_xor(mx, 1)); mx = fmaxf(mx, __shfl_xor(mx, 2)); mx = fmaxf(mx, __shfl_xor(mx, 4)); mx = fmaxf(mx, __shfl_xor(mx, 8));
            const float ex = __expf(lg - mx); float sm = ex; sm += __shfl_xor(sm, 1); sm += __shfl_xor(sm, 2); sm += __shfl_xor(sm, 4); sm += __shfl_xor(sm, 8);
            PROBS[(size_t)(row0 + r) * NE + fr] = ex / sm; }
    }
    __syncthreads();
}

__global__ void __launch_bounds__(NTHR) mega(Args args) {
    extern __shared__ __attribute__((aligned(16))) unsigned char lds_raw[];
    LAS unsigned char* lds = (LAS unsigned char*)lds_raw;
    const int tid = threadIdx.x, lane = tid & 63, wave = __builtin_amdgcn_readfirstlane(tid >> 6);
    const int G = gridDim.x, bx = blockIdx.x;
    const int vcu = (G % 8 == 0) ? (bx % 8) * (G / 8) + bx / 8 : bx;
    const int gw = vcu * NWAVES + wave, NGW = G * NWAVES;
    unsigned char* ws = args.ws; unsigned char* dout = (unsigned char*)args.out;
    const float* x = args.in[0]; const float* cvec = args.in[1]; const float* ctx = args.in[2]; const float* c_ctx = args.in[3];
    const float* lb_logits = args.in[4]; const float* w_mod = args.in[5]; const float* b_mod = args.in[6]; const float* norm1_g = args.in[7];
    const float* w_in = args.in[8]; const float* hgrn_g = args.in[9]; const float* w_a = args.in[10]; const float* w_pool = args.in[11];
    const float* pool_scale = args.in[12]; const float* w_b = args.in[13]; const float* w_out = args.in[14]; const float* norm2_g = args.in[15];
    const float* w_router = args.in[16]; const float* w_e_gate = args.in[17]; const float* w_e_up = args.in[18]; const float* w_e_down = args.in[19];
    const float* final_g = args.in[20];
    float* MOD = (float*)(ws + WS_MOD); float* MODP = (float*)(ws + WS_MODP); float* LB = (float*)(ws + WS_LB);
    int* IDX = (int*)(ws + WS_IDX); float* VALS = (float*)(ws + WS_VALS); float* PROBS = (float*)(ws + WS_PROBS); int* INV = (int*)(ws + WS_INV);
    bf16* WIN = (bf16*)(ws + WS_WIN); bf16* WA = (bf16*)(ws + WS_WA); bf16* WP = (bf16*)(ws + WS_WP); bf16* WOUT = (bf16*)(ws + WS_WOUT);
    bf16* QB = (bf16*)(ws + WS_Q); bf16* VB = (bf16*)(ws + WS_V); bf16* GF = (bf16*)(ws + WS_GF); bf16* GBK = (bf16*)(ws + WS_GB);
    bf16* OG = (bf16*)(ws + WS_OG); bf16* PB = (bf16*)(ws + WS_P); bf16* GA = (bf16*)(ws + WS_GA); bf16* GBT = (bf16*)(ws + WS_GBT);
    float* NEWHX = (float*)(ws + WS_NEWHX); bf16* AA = (bf16*)(ws + WS_AA); bf16* VX = (bf16*)(ws + WS_VX); bf16* RB = (bf16*)(ws + WS_R);
    bf16* HID = (bf16*)(ws + WS_HID); bf16* YB = (bf16*)(ws + WS_YB);
    bf16* UX = (bf16*)(dout + DO_UX); bf16* OF = (bf16*)(dout + DO_OF); bf16* OB = (bf16*)(dout + DO_OB); bf16* WGU = (bf16*)(dout + DO_WGU); bf16* WDN = (bf16*)(dout + DO_WDN);
    const int lo = args.ph_lo, hi = args.ph_hi;
#ifndef PHASE_MASK
#define PHASE_MASK 0xff
#endif
#define IN(k) (((PHASE_MASK >> (k)) & 1) && lo <= (k) && (k) < hi)
#define SEAM(k) do { if (IN(k) && IN((k) + 1)) { cg::this_grid().sync(); } } while (0)

    if (IN(0)) {
        LAS float* scr = (LAS float*)(lds + wave * 16384);
        for (int it = gw; it < 96 * 16; it += NGW) {
            const int cb = it % 96, kp = it / 96, col = cb * 64 + lane, k0 = kp * 64;
            float sv[9];
#pragma unroll
            for (int r = 0; r < 9; ++r) { const float cv = (r < 8) ? cvec[r * D + k0 + lane] : c_ctx[k0 + lane]; sv[r] = siluf_(cv); }
            float acc[9];
#pragma unroll
            for (int r = 0; r < 9; ++r) acc[r] = 0.f;
#pragma unroll 16
            for (int kk = 0; kk < 64; ++kk) { const float w = w_mod[(size_t)(k0 + kk) * (6 * D) + col];
#pragma unroll
                for (int r = 0; r < 9; ++r) acc[r] += __shfl(sv[r], kk) * w; }
#pragma unroll
            for (int r = 0; r < 9; ++r) MODP[((size_t)kp * 9 + r) * (6 * D) + col] = acc[r];
        }
        for (int i = gw * 64 + lane; i < 2 * HD * NH; i += NGW * 64) { const int dir = i >> 10, d = i & 1023; const float l0 = lb_logits[dir * 2048 + d], l1 = lb_logits[dir * 2048 + 1024 + d]; LB[i] = 1.0f / (1.0f + __expf(l1 - l0)); }
        {
            constexpr int I_IN = (D / 64) * (NIN / 32), I_A = (D / 64) * (D / 32), I_OUT = I_A;
            for (int it = gw; it < I_IN + I_A + I_OUT; it += NGW) {
                int r = it;
                if (r < I_IN) { const int nblk = NIN / 32, kb = r / nblk, nb = r % nblk; transpose_item(w_in, D, NIN, WIN, 64 * kb, 32 * nb, 32 * nb, scr, lane); continue; } r -= I_IN;
                if (r < I_A) { const int nblk = D / 32, kb = r / nblk, nb = r % nblk; transpose_item(w_a, D, D, WA, 64 * kb, 32 * nb, 32 * nb, scr, lane); continue; } r -= I_A;
                { const int nblk = D / 32, kb = r / nblk, nb = r % nblk; transpose_item(w_out, D, D, WOUT, 64 * kb, 32 * nb, 32 * nb, scr, lane); }
            }
        }
        for (int it = gw; it < PW * 16; it += NGW) {
            const int k = it >> 4, nb = it & 15, n = nb * 64 + lane, j = k >> 7;
            const float* wp = w_pool + (size_t)k * 128; const float* ps = pool_scale + j * 128; const float* wb = w_b + (size_t)(j * 128) * D + n;
            float a = 0.f;
#pragma unroll 8
            for (int m = 0; m < 128; ++m) a += (wp[m] * ps[m]) * wb[(size_t)m * D];
            WP[(size_t)n * PW + k] = (bf16)f2bf(a);
        }
    }
    SEAM(0);

    if (IN(1)) {
        LAS float* shs = (LAS float*)lds; LAS float* scs = shs + D;
        for (int slab = bx; slab < MT / 256; slab += G) {
            const int mrow = slab < M / 256 ? slab / 32 : 8;
            const bool writer = (slab < M / 256) ? (slab % 32 == 0) : (slab == M / 256);
            for (int c = tid; c < (writer ? 6 * D : 2 * D); c += NTHR) {
                float a = b_mod[c];
#pragma unroll
                for (int kp = 0; kp < 16; ++kp) a += MODP[((size_t)kp * 9 + mrow) * (6 * D) + c];
                if (c < D) shs[c] = a; else if (c < 2 * D) scs[c - D] = a;
                if (writer) MOD[mrow * (6 * D) + c] = a;
            }
            __syncthreads();
            for (int r = wave * 32; r < wave * 32 + 32; ++r) {
                const int row = slab * 256 + r;
                const float* src = (row < M) ? x + (size_t)row * D : ctx + (size_t)(row - M) * D;
                f32x4 v[4]; float ss = 0.f;
#pragma unroll
                for (int j = 0; j < 4; ++j) { v[j] = *(const f32x4*)(src + 4 * lane + 256 * j); ss += (v[j].x * v[j].x + v[j].y * v[j].y) + (v[j].z * v[j].z + v[j].w * v[j].w); }
                const float rstd = rsqrtf(wave_sum(ss) * (1.0f / D) + EPS);
#pragma unroll
                for (int j = 0; j < 4; ++j) { const int c = 4 * lane + 256 * j; const f32x4 g = *(const f32x4*)(norm1_g + c);
                    const f32x4 sc = *(const LAS f32x4*)(scs + c), sh = *(const LAS f32x4*)(shs + c);
                    const f32x4 o = (v[j] * rstd * g) * (sc + 1.0f) + sh;
                    v2u w; w.x = pk2(o.x, o.y); w.y = pk2(o.z, o.w); *(v2u*)(UX + (size_t)row * D + c) = w; }
            }
            __syncthreads();
        }
    }
    SEAM(1);

    if (IN(2)) {
        pg8::Gemm g{UX, WIN, D, nullptr}; pg8::OrderIn S{G, bx};
        pg8::EpiIn E{QB, VB, GF, GBK, OG, PB, GA, GBT, LB};
        pg8::gemm_phase<pg8::EpiIn, pg8::OrderIn, true, true, false>(lds, g, S, E, tid);
    }
    SEAM(2);

    if (IN(3)) {
        constexpr int TB = 16;
        LAS float* fq = (LAS float*)lds;
        LAS float* ff = fq + TB * 128;
        LAS float* fk = ff + TB * 128;
        LAS float* fv = fk + TB * 128;
        LAS float* part = fv + TB * 64;
        for (int unit = bx; unit < NB * NH * 4; unit += G) {
            const int vh = unit & 1, dir = (unit >> 1) & 1, h = (unit >> 2) & 7, b = unit >> 5;
            const bf16* Gp = dir ? GBK : GF; bf16* Op = dir ? OB : OF;
            float Sst[16];
#pragma unroll
            for (int i = 0; i < 16; ++i) Sst[i] = 0.f;
            const int NTOK = CTXL + SEQ;
            for (int p0 = 0; p0 < NTOK; p0 += TB) {
                const bool isx = p0 >= CTXL;
                for (int e = tid; e < TB * 128; e += NTHR) { const int tt = e >> 7, d = e & 127; const int p = p0 + tt;
                    size_t row; if (!isx) { const int tc = dir ? (CTXL - 1 - p) : p; row = (size_t)M + b * CTXL + tc; } else { const int tx = dir ? (SEQ - 1 - (p - CTXL)) : (p - CTXL); row = (size_t)b * SEQ + tx; }
                    const float gl = h2f(Gp[row * D + h * HD + d]); const float f = __expf(gl);
                    ff[e] = f; fk[e] = 1.0f - f; fq[e] = isx ? bf2f(QB[row * D + h * HD + d]) : 0.f;
                    if (d < 64) fv[tt * 64 + d] = bf2f(VB[row * D + h * HD + vh * 64 + d]); }
                __syncthreads();
#pragma unroll 1
                for (int tt = 0; tt < TB; ++tt) {
                    const float vv = fv[tt * 64 + lane]; float po = 0.f;
#pragma unroll
                    for (int i = 0; i < 16; ++i) { const int d = wave * 16 + i; Sst[i] = ff[tt * 128 + d] * Sst[i] + fk[tt * 128 + d] * vv; po += Sst[i] * fq[tt * 128 + d]; }
                    part[(tt * 8 + wave) * 64 + lane] = po;
                }
                __syncthreads();
                if (isx) {
                    for (int e = tid; e < TB * 64; e += NTHR) { const int tt = e >> 6, v = e & 63; float o = 0.f;
#pragma unroll
                        for (int w = 0; w < 8; ++w) o += part[(tt * 8 + w) * 64 + v];
                        const int p = p0 + tt; const int tx = dir ? (SEQ - 1 - (p - CTXL)) : (p - CTXL);
                        Op[((size_t)b * SEQ + tx) * D + h * HD + vh * 64 + v] = (bf16)f2bf(o); }
                }
                __syncthreads();
            }
        }
    }
    SEAM(3);

    if (IN(4)) {
        for (int slab = bx; slab < M / 256; slab += G) {
            const int b = slab / 32;
            if (P4M & 1) p4_build_aa(slab, OF, OB, OG, hgrn_g, AA, tid);
            if (P4M & 2) p4_pool(lds, slab, PB, RB, tid);
            wg_fence();
            if (P4M & 4) { const bf16* wb_ = WA; asm volatile("" : "+s"(wb_)); pg8::Gemm g{AA, wb_, D, nullptr}; pg8::OrderRow S{slab, 4}; pg8::EpiGateA E{GA};
              pg8::gemm_phase<pg8::EpiGateA, pg8::OrderRow, true, true, false>(lds, g, S, E, tid); }
            wg_fence();
            if (P4M & 8) { const bf16* wb_ = WP; asm volatile("" : "+s"(wb_)); pg8::Gemm g{RB, wb_, PW, nullptr}; pg8::OrderRow S{slab, 4}; pg8::EpiGateB E{GA, GBT};
              pg8::gemm_phase<pg8::EpiGateB, pg8::OrderRow, true, true, false>(lds, g, S, E, tid); }
            wg_fence();
            if (P4M & 16) { const bf16* wb_ = WOUT; asm volatile("" : "+s"(wb_)); pg8::Gemm g{GBT, wb_, D, nullptr}; pg8::OrderRow S{slab, 4}; pg8::EpiResid E{x, NEWHX, MOD + b * (6 * D) + 2 * D};
              pg8::gemm_phase<pg8::EpiResid, pg8::OrderRow, true, true, false>(lds, g, S, E, tid); }
            wg_fence();
            if (P4M & 32) p4_rows(lds, slab, NEWHX, MOD + b * (6 * D), norm2_g, w_router, VX, PROBS, tid);
        }
    }
    SEAM(4);

    if (IN(5)) {
        {
            LAS float* scr = (LAS float*)(lds + wave * 16384);
            constexpr int I_E = (D / 64) * (FF / 32);
            for (int it = gw; it < NE * 3 * I_E; it += NGW) {
                const int e = it / (3 * I_E), r = it % (3 * I_E), which = r / I_E, q = r % I_E, kb = q / (FF / 32), nb = q % (FF / 32), n0 = 32 * nb;
                if (which < 2) transpose_item((which ? w_e_up : w_e_gate) + (size_t)e * D * FF, D, FF, WGU + (size_t)e * 2 * FF * D, 64 * kb, n0, n0 + 128 * (n0 / 128) + 128 * which, scr, lane);
                else transpose_item(w_e_down + (size_t)e * FF * D, FF, D, WDN + (size_t)e * D * FF, 64 * kb, n0, n0, scr, lane);
            }
        }
        __syncthreads();
        {
            LAS unsigned* keys = (LAS unsigned*)lds;
            LAS unsigned* hist = keys + SEQ;
            LAS unsigned* sc = hist + 256;
            LAS unsigned* wsum = sc + 16;
            for (int be = bx; be < NB * NE; be += G) {
                const int b = be / NE, e = be % NE;
                for (int t = tid; t < SEQ; t += NTHR) keys[t] = __builtin_bit_cast(unsigned, PROBS[((size_t)b * SEQ + t) * NE + e]);
                unsigned prefix = 0, mask = 0, kk = CAP;
                for (int pass = 0; pass < 4; ++pass) {
                    const int shift = 24 - 8 * pass;
                    if (tid < 256) hist[tid] = 0;
                    __syncthreads();
                    for (int t = tid; t < SEQ; t += NTHR) { const unsigned k = keys[t]; if ((k & mask) == prefix) __hip_atomic_fetch_add(hist + ((k >> shift) & 255u), 1u, __ATOMIC_RELAXED, __HIP_MEMORY_SCOPE_WORKGROUP); }
                    __syncthreads();
                    if (tid == 0) { unsigned cum = 0; int dsel = 0; unsigned knew = kk;
                        for (int d = 255; d >= 0; --d) { const unsigned hc = hist[d]; if (cum + hc >= kk) { dsel = d; knew = kk - cum; break; } cum += hc; }
                        sc[0] = prefix | ((unsigned)dsel << shift); sc[1] = knew; }
                    __syncthreads();
                    prefix = sc[0]; kk = sc[1]; mask |= (255u << shift);
                    __syncthreads();
                }
                const unsigned thr = prefix, need = kk;
                unsigned cgt = 0, ceq = 0;
#pragma unroll
                for (int i = 0; i < 16; ++i) { const unsigned k = keys[tid * 16 + i]; cgt += (k > thr); ceq += (k == thr); }
                unsigned igt = cgt, ieq = ceq;
#pragma unroll
                for (int o = 1; o < 64; o <<= 1) { const unsigned a = __shfl_up(igt, o), c2 = __shfl_up(ieq, o); if (lane >= o) { igt += a; ieq += c2; } }
                if (lane == 63) { wsum[wave] = igt; wsum[8 + wave] = ieq; }
                __syncthreads();
                unsigned bgt = 0, beq = 0, totgt = 0;
#pragma unroll
                for (int w = 0; w < 8; ++w) { const unsigned a = wsum[w], c2 = wsum[8 + w]; if (w < wave) { bgt += a; beq += c2; } totgt += a; }
                unsigned pgt = bgt + igt - cgt, peq = beq + ieq - ceq;
#pragma unroll
                for (int i = 0; i < 16; ++i) { const int t = tid * 16 + i; const unsigned k = keys[t]; int slot = -1;
                    if (k > thr) { slot = (int)pgt; ++pgt; } else if (k == thr) { if (peq < need) slot = (int)(totgt + peq); ++peq; }
                    INV[((size_t)b * SEQ + t) * NE + e] = slot;
                    if (slot >= 0) { IDX[be * CAP + slot] = b * SEQ + t; VALS[be * CAP + slot] = __builtin_bit_cast(float, k); } }
                __syncthreads();
            }
        }
    }
    SEAM(5);

    if (IN(6)) {
        for (int rnd = 0;; ++rnd) {
            int e, b, rt;
            if (G == 256) { if (rnd >= 2) break; const int xcd = bx & 7, loc = bx >> 3; e = 2 * xcd + rnd; b = loc >> 2; rt = loc & 3; }
            else { const int it = bx + rnd * G; if (it >= NB * NE * 4) break; e = it >> 5; b = (it >> 2) & 7; rt = it & 3; }
            const int be = b * NE + e; const size_t r0 = (size_t)be * CAP + rt * 256;
            { pg8::Gemm g{VX, WGU + (size_t)e * 2 * FF * D, D, IDX + r0}; pg8::OrderRow S{0, 8}; pg8::EpiHid E{HID + r0 * FF};
              pg8::gemm_phase<pg8::EpiHid, pg8::OrderRow, true, true, true>(lds, g, S, E, tid); }
            wg_fence();
            { pg8::Gemm g{HID + r0 * FF, WDN + (size_t)e * D * FF, FF, nullptr}; pg8::OrderRow S{0, 4}; pg8::EpiDown E{YB + r0 * D, VALS + r0};
              pg8::gemm_phase<pg8::EpiDown, pg8::OrderRow, true, true, false>(lds, g, S, E, tid); }
        }
    }
    SEAM(6);

    if (IN(7)) {
        float* out = args.out;
        for (int row = gw; row < M; row += NGW) {
            const int b = row / SEQ; const float* g2 = MOD + b * (6 * D) + 5 * D;
            f32x4 a[4];
#pragma unroll
            for (int j = 0; j < 4; ++j) a[j] = (f32x4){0.f, 0.f, 0.f, 0.f};
            const int sl = (lane < NE) ? INV[(size_t)row * NE + lane] : -1;
            for (int e = 0; e < NE; ++e) { const int s = __shfl(sl, e);
                if (s >= 0) { const bf16* yr = YB + ((size_t)(b * NE + e) * CAP + s) * D + 4 * lane;
#pragma unroll
                    for (int j = 0; j < 4; ++j) { const v2u u = *(const v2u*)(yr + 256 * j); a[j].x += bflo(u.x); a[j].y += bfhi(u.x); a[j].z += bflo(u.y); a[j].w += bfhi(u.y); } } }
            f32x4 hv[4]; float ss = 0.f;
#pragma unroll
            for (int j = 0; j < 4; ++j) { const int c = 4 * lane + 256 * j; hv[j] = *(const f32x4*)(NEWHX + (size_t)row * D + c) + *(const f32x4*)(g2 + c) * a[j];
                ss += (hv[j].x * hv[j].x + hv[j].y * hv[j].y) + (hv[j].z * hv[j].z + hv[j].w * hv[j].w); }
            const float rstd = rsqrtf(wave_sum(ss) * (1.0f / D) + EPS);
#pragma unroll
            for (int j = 0; j < 4; ++j) { const int c = 4 * lane + 256 * j; *(f32x4*)(out + (size_t)row * D + c) = hv[j] * rstd * *(const f32x4*)(final_g + c); }
        }
    }
#undef IN
#undef SEAM
}

extern "C" void kernel_launch(void* const* d_in, const int* in_sizes, int n_in, void* d_out, int out_size, void* d_ws, size_t ws_size, hipStream_t stream) {
    static int grid = 0;
    if (grid == 0) {
        if (n_in != 21 || in_sizes[0] != M * D || in_sizes[8] != D * NIN || out_size != M * D || ws_size < WS_END) {
            fprintf(stderr, "kernel_launch: unexpected shapes: n_in %d in0 %d in8 %d out %d ws %zu; nothing launched\n", n_in, n_in > 0 ? in_sizes[0] : -1, n_in > 8 ? in_sizes[8] : -1, out_size, ws_size); grid = -1; return; }
        int dev = 0, cus = 0, per_cu = 0;
        if (hipGetDevice(&dev) != hipSuccess || hipDeviceGetAttribute(&cus, hipDeviceAttributeMultiprocessorCount, dev) != hipSuccess) { grid = -1; return; }
        if (hipFuncSetAttribute((const void*)mega, hipFuncAttributeMaxDynamicSharedMemorySize, LDS_BYTES) != hipSuccess) { fprintf(stderr, "kernel_launch: hipFuncSetAttribute failed\n"); grid = -1; return; }
        if (hipOccupancyMaxActiveBlocksPerMultiprocessor(&per_cu, (const void*)mega, NTHR, LDS_BYTES) != hipSuccess || per_cu < 1) { fprintf(stderr, "kernel_launch: occupancy query says %d\n", per_cu); per_cu = 1; }
        (void)hipGetLastError();
        grid = cus;
        fprintf(stderr, "kernel_launch: grid %d (occupancy query %d per CU)\n", grid, per_cu);
    }
    if (grid < 0) return;
    Args a{};
    for (int i = 0; i < 21; ++i) a.in[i] = (const float*)d_in[i];
    a.out = (float*)d_out; a.ws = (unsigned char*)d_ws;
#if MK_ONE_LAUNCH
    a.ph_lo = 0; a.ph_hi = NPHASE;
    void* kargs[] = {&a};
    hipError_t e = hipLaunchCooperativeKernel((const void*)mega, dim3(grid), dim3(NTHR), kargs, LDS_BYTES, stream);
    if (e != hipSuccess) fprintf(stderr, "kernel_launch: cooperative launch failed: %s\n", hipGetErrorString(e));
#else
    for (int p = 0; p < NPHASE; ++p) {
        a.ph_lo = p; a.ph_hi = p + 1;
        hipLaunchKernelGGL(mega, dim3(grid), dim3(NTHR), LDS_BYTES, stream, a);
    }
#endif
}
```

```cpp
#include <hip/hip_runtime.h>
#include <hip/hip_cooperative_groups.h>
#include <cstdio>
namespace cg = cooperative_groups;

#define GAS __attribute__((address_space(1)))
#define LAS __attribute__((address_space(3)))
typedef unsigned short bf16;
typedef unsigned v4u __attribute__((ext_vector_type(4)));
typedef unsigned v2u __attribute__((ext_vector_type(2)));
typedef float f32x4 __attribute__((ext_vector_type(4)));
typedef float f32x2 __attribute__((ext_vector_type(2)));
typedef short bf16x8 __attribute__((ext_vector_type(8)));

#ifndef P4M
#define P4M 63
#endif
#ifndef MK_ONE_LAUNCH
#define MK_ONE_LAUNCH 1
#endif

constexpr int NB = 8, SEQ = 8192, D = 1024, M = NB * SEQ, CTXL = 256, MC = NB * CTXL, MT = M + MC;
constexpr int NIN = 7680, NH = 8, HD = 128, NE = 16, CAP = 1024, FF = 1024, PW = 512;
constexpr int GRID_W = 64, GRID_H = SEQ / GRID_W;
constexpr float EPS = 1e-6f;
constexpr int NWAVES = 8, NTHR = 512;
constexpr int NPHASE = 8;

constexpr size_t MiB = 1u << 20;
constexpr size_t WS_CTL = 0, WS_MOD = 1 * MiB, WS_LB = 2 * MiB, WS_IDX = 3 * MiB, WS_VALS = 3 * MiB + 512 * 1024;
constexpr size_t WS_PROBS = 4 * MiB, WS_INV = 8 * MiB;
constexpr size_t WS_MODP = 4 * MiB;
constexpr size_t WS_WIN = 12 * MiB, WS_WA = 27 * MiB, WS_WP = 29 * MiB, WS_WOUT = 30 * MiB;
constexpr size_t WS_Q = 32 * MiB, WS_V = 160 * MiB, WS_GF = 292 * MiB, WS_GB = 424 * MiB, WS_OG = 556 * MiB, WS_P = 684 * MiB, WS_GA = 748 * MiB, WS_GBT = 876 * MiB, WS_END = 1004 * MiB;
constexpr size_t WS_NEWHX = WS_Q;
constexpr size_t WS_AA = WS_GF;
constexpr size_t WS_VX = WS_GF;
constexpr size_t WS_R = WS_GB;
constexpr size_t WS_HID = WS_GB;
constexpr size_t WS_YB = WS_GA;
constexpr size_t DO_UX = 0, DO_OF = 0, DO_OB = 128 * MiB, DO_WGU = 0, DO_WDN = 64 * MiB;

__device__ __forceinline__ unsigned f2bf(float f) { unsigned u = __builtin_bit_cast(unsigned, f); return (u + 0x7fffu + ((u >> 16) & 1u)) >> 16; }
__device__ __forceinline__ unsigned pk2(float lo, float hi) { return f2bf(lo) | (f2bf(hi) << 16); }
__device__ __forceinline__ float bflo(unsigned w) { return __builtin_bit_cast(float, w << 16); }
__device__ __forceinline__ float bfhi(unsigned w) { return __builtin_bit_cast(float, w & 0xffff0000u); }
__device__ __forceinline__ float bf2f(bf16 b) { return __builtin_bit_cast(float, (unsigned)b << 16); }
__device__ __forceinline__ unsigned pkh2(float lo, float hi) { const _Float16 a = (_Float16)lo, b = (_Float16)hi; return (unsigned)__builtin_bit_cast(unsigned short, a) | ((unsigned)__builtin_bit_cast(unsigned short, b) << 16); }
__device__ __forceinline__ float h2f(unsigned short h) { return (float)__builtin_bit_cast(_Float16, h); }
__device__ __forceinline__ float wave_sum(float v) {
#pragma unroll
    for (int o = 1; o < 64; o <<= 1) v += __shfl_xor(v, o);
    return v;
}
__device__ __forceinline__ float sigmoidf_(float x) { return 1.0f / (1.0f + __expf(-x)); }
__device__ __forceinline__ float siluf_(float x) { return x / (1.0f + __expf(-x)); }
#define LDS_WAIT() asm volatile("s_waitcnt lgkmcnt(0)" ::: "memory")
#define VM_WAIT() asm volatile("s_waitcnt vmcnt(0)" ::: "memory")
__device__ __forceinline__ void wg_fence() {
    asm volatile("s_waitcnt vmcnt(0) lgkmcnt(0)" ::: "memory");
    __syncthreads();
    if (threadIdx.x < 64) { __builtin_amdgcn_fence(__ATOMIC_ACQUIRE, "agent"); asm volatile("s_waitcnt vmcnt(0)" ::: "memory"); }
    __syncthreads();
}

namespace pg8 {
#define PG8_LAS __attribute__((address_space(3)))
typedef unsigned short bf16_t;
typedef unsigned u32x4 __attribute__((ext_vector_type(4)));
constexpr int BM = 256, BK = 64, HALF = 128, HTB = HALF * BK * 2, STAGE_BYTES = 8 * HTB, NXCD = 8, WGM = 8;
__host__ __device__ __forceinline__ int lds_byte(int r, int c) { const int st = (r >> 4) * 2 + (c >> 5), rr = r & 15, cc = c & 31, ob = rr * 64 + cc * 2; return st * 1024 + (ob ^ (((ob >> 9) & 1) << 5)); }
__host__ __device__ __forceinline__ void stage_rc(int b, int& R, int& C) { const int st = b / 1024, sb = b % 1024, swz = sb ^ (((sb >> 9) & 1) << 5); R = (st >> 1) * 16 + swz / 64; C = (st & 1) * 32 + (swz % 64) / 2; }
__host__ __device__ __forceinline__ int perm32(int rho) { const int n = rho >> 4, i = rho & 15; return 8 * (i >> 2) + 4 * n + (i & 3); }
struct Unit { int pm, pn; };
struct Gemm { const bf16_t* A; const bf16_t* Bt; int K; const int* gidx; };
__device__ __forceinline__ unsigned cvt_pk_bf16(float lo, float hi) { unsigned r; asm volatile("v_cvt_pk_bf16_f32 %0, %1, %2" : "=v"(r) : "v"(lo), "v"(hi)); return r; }

template <class Epi, class Sched, bool ALIGN_EPI, bool SP2, bool GATHER>
__device__ __forceinline__ void gemm_phase(PG8_LAS unsigned char* lds, const Gemm g, const Sched& S, const Epi& E, int tid_in) {
    asm volatile("" : "+v"(tid_in));
    const int tid = tid_in, wid = __builtin_amdgcn_readfirstlane(tid >> 6), lane = tid & 63, wr = wid >> 2, wc = wid & 3, fr = lane & 15, fq = lane >> 4;
    const int K = g.K, nt = K / BK;
    unsigned voffA[2], voffA1[2], voffB[2];
#pragma unroll
    for (int i = 0; i < 2; ++i) { int R, C; stage_rc(tid * 16 + i * 8192, R, C); const int Rb = Epi::PERM ? ((R & ~31) + perm32(R & 31)) : R;
        if (GATHER) { voffA[i] = (unsigned)(g.gidx[R] * K + C) * 2u; voffA1[i] = (unsigned)(g.gidx[HALF + R] * K + C) * 2u; }
        else { voffA[i] = (unsigned)(R * K + C) * 2u; voffA1[i] = voffA[i]; }
        voffB[i] = (unsigned)(Rb * K + C) * 2u; }
    const size_t kstep = (size_t)(BK * 2);
    const size_t hstep = (size_t)HALF * K * 2;
    const size_t hstepA = GATHER ? 0 : hstep;
    const size_t tstep = 2 * hstep;
    const unsigned ldsw = (unsigned)wid * 1024u;
    const int aoff = lds_byte(wr * 64 + fr, fq * 8), boff = lds_byte(wc * 32 + fr, fq * 8);
#define PG8_SA(b, h) (((b) * 2 + (h)) * HTB)
#define PG8_SB(b, h) ((4 + (b) * 2 + (h)) * HTB)
#define PG8_STAGE(bufoff, gbase, voff) do { _Pragma("unroll") for (int _i = 0; _i < 2; ++_i) \
        __builtin_amdgcn_global_load_lds((const unsigned*)((const char*)(gbase) + (voff)[_i]), (PG8_LAS unsigned*)(lds + (bufoff) + ldsw + _i * 8192), 16, 0, 0); } while (0)
#define PG8_LDA(dst, b, h) do { _Pragma("unroll") for (int m = 0; m < 4; ++m) _Pragma("unroll") for (int k = 0; k < 2; ++k) dst[m][k] = *(const PG8_LAS bf16x8*)(lds + PG8_SA(b, h) + aoff + m * 2048 + k * 1024); } while (0)
#define PG8_LDB(dst, b, h) do { _Pragma("unroll") for (int n = 0; n < 2; ++n) _Pragma("unroll") for (int k = 0; k < 2; ++k) dst[n][k] = *(const PG8_LAS bf16x8*)(lds + PG8_SB(b, h) + boff + n * 2048 + k * 1024); } while (0)
#define PG8_MMA(ai, bj, At, Bt) do { __builtin_amdgcn_s_setprio(1); _Pragma("unroll") for (int m = 0; m < 4; ++m) _Pragma("unroll") for (int n = 0; n < 2; ++n) _Pragma("unroll") for (int k = 0; k < 2; ++k) \
        acc[ai][bj][m][n] = __builtin_amdgcn_mfma_f32_16x16x32_bf16(Bt[n][k], At[m][k], acc[ai][bj][m][n], 0, 0, 0); __builtin_amdgcn_s_setprio(0); } while (0)
#define PG8_WAIT_V(n) asm volatile("s_waitcnt vmcnt(" #n ")" ::: "memory")
#define PG8_WAIT_L(n) asm volatile("s_waitcnt lgkmcnt(" #n ")" ::: "memory")
#define PG8_BAR __builtin_amdgcn_s_barrier()
#define PG8_SCHED __builtin_amdgcn_sched_barrier(0)
    Unit cur, nxt; int ui = 0;
    if (!S.next(0, cur)) return;
    f32x4 acc[2][2][4][2];
#pragma unroll
    for (int a = 0; a < 2; ++a)
#pragma unroll
        for (int b = 0; b < 2; ++b)
#pragma unroll
            for (int m = 0; m < 4; ++m)
#pragma unroll
                for (int n = 0; n < 2; ++n) acc[a][b][m][n] = (f32x4){0.f, 0.f, 0.f, 0.f};
    bf16x8 At[4][2], B0[2][2], B1[2][2];
    const char* cA = (const char*)g.A + (GATHER ? (size_t)0 : (size_t)cur.pm * tstep); const char* cB = (const char*)g.Bt + (size_t)cur.pn * tstep;
    if constexpr (SP2) {
        PG8_STAGE(PG8_SB(0, 0), cB, voffB); PG8_STAGE(PG8_SB(0, 1), cB + hstep, voffB); PG8_STAGE(PG8_SA(0, 0), cA, voffA); PG8_STAGE(PG8_SA(0, 1), cA + hstepA, voffA1);
        if (wr == 1) PG8_BAR;
        PG8_WAIT_V(2); PG8_BAR;
        PG8_STAGE(PG8_SB(1, 0), cB + kstep, voffB); PG8_STAGE(PG8_SA(1, 0), cA + kstep, voffA); PG8_STAGE(PG8_SB(1, 1), cB + hstep + kstep, voffB);
        PG8_WAIT_V(6); PG8_BAR;
    } else {
        PG8_STAGE(PG8_SB(0, 0), cB, voffB); PG8_STAGE(PG8_SA(0, 0), cA, voffA); PG8_STAGE(PG8_SB(0, 1), cB + hstep, voffB); PG8_STAGE(PG8_SA(0, 1), cA + hstepA, voffA1);
        if (wr == 1) PG8_BAR;
        PG8_WAIT_V(4); PG8_BAR;
        PG8_STAGE(PG8_SB(1, 0), cB + kstep, voffB); PG8_STAGE(PG8_SA(1, 0), cA + kstep, voffA); PG8_STAGE(PG8_SB(1, 1), cB + hstep + kstep, voffB);
        PG8_WAIT_V(6); PG8_BAR;
    }
    for (;;) {
        const bool has_next = S.next(ui + 1, nxt);
        const char* nA = has_next ? (const char*)g.A + (GATHER ? (size_t)0 : (size_t)nxt.pm * tstep) : cA; const char* nB = has_next ? (const char*)g.Bt + (size_t)nxt.pn * tstep : cB;
        for (int t = 0; t < nt; t += 2) {
            const bool last = (t == nt - 2);
            const char* a1 = cA + (size_t)(t + 1) * kstep;
            const char* a2 = last ? nA : cA + (size_t)(t + 2) * kstep; const char* b2 = last ? nB : cB + (size_t)(t + 2) * kstep;
            const char* a3 = a2 + kstep; const char* b3 = b2 + kstep;
            if constexpr (SP2) {
            PG8_LDB(B0, 0, 0); PG8_LDB(B1, 0, 1); PG8_SCHED; PG8_LDA(At, 0, 0); PG8_STAGE(PG8_SA(1, 1), a1 + hstepA, voffA1);
            PG8_WAIT_V(8); PG8_WAIT_L(0); PG8_BAR; PG8_MMA(0, 0, At, B0); PG8_MMA(0, 1, At, B1); PG8_BAR; PG8_SCHED;
            PG8_LDA(At, 0, 1); PG8_STAGE(PG8_SB(0, 0), b2, voffB); PG8_STAGE(PG8_SB(0, 1), b2 + hstep, voffB); PG8_STAGE(PG8_SA(0, 0), a2, voffA);
            PG8_WAIT_V(8); PG8_WAIT_L(0); PG8_BAR; PG8_MMA(1, 0, At, B0); PG8_MMA(1, 1, At, B1); PG8_BAR; PG8_SCHED;
            PG8_LDB(B0, 1, 0); PG8_LDB(B1, 1, 1); PG8_SCHED; PG8_LDA(At, 1, 0); PG8_STAGE(PG8_SA(0, 1), a2 + hstepA, voffA1);
            PG8_WAIT_V(8); PG8_WAIT_L(0); PG8_BAR; PG8_MMA(0, 0, At, B0); PG8_MMA(0, 1, At, B1); PG8_BAR; PG8_SCHED;
            PG8_LDA(At, 1, 1); PG8_STAGE(PG8_SB(1, 0), b3, voffB); PG8_STAGE(PG8_SB(1, 1), b3 + hstep, voffB); PG8_STAGE(PG8_SA(1, 0), a3, voffA);
            PG8_WAIT_V(8); PG8_WAIT_L(0); PG8_BAR; PG8_MMA(1, 0, At, B0); PG8_MMA(1, 1, At, B1); PG8_BAR; PG8_SCHED;
            } else {
            PG8_LDB(B0, 0, 0); PG8_SCHED; PG8_LDA(At, 0, 0); PG8_STAGE(PG8_SA(1, 1), a1 + hstepA, voffA1);
            PG8_WAIT_L(8); PG8_BAR; PG8_WAIT_L(0); PG8_MMA(0, 0, At, B0); PG8_BAR; PG8_SCHED;
            PG8_LDB(B1, 0, 1); PG8_STAGE(PG8_SB(0, 0), b2, voffB);
            PG8_BAR; PG8_WAIT_L(0); PG8_MMA(0, 1, At, B1); PG8_BAR;
            PG8_LDA(At, 0, 1); PG8_STAGE(PG8_SA(0, 0), a2, voffA);
            PG8_BAR; PG8_WAIT_L(0); PG8_MMA(1, 0, At, B0); PG8_BAR; PG8_SCHED;
            PG8_STAGE(PG8_SB(0, 1), b2 + hstep, voffB);
            PG8_WAIT_V(6); PG8_BAR; PG8_MMA(1, 1, At, B1); PG8_BAR;
            PG8_LDB(B0, 1, 0); PG8_SCHED; PG8_LDA(At, 1, 0); PG8_STAGE(PG8_SA(0, 1), a2 + hstepA, voffA1);
            PG8_WAIT_L(8); PG8_BAR; PG8_WAIT_L(0); PG8_MMA(0, 0, At, B0); PG8_BAR; PG8_SCHED;
            PG8_LDB(B1, 1, 1); PG8_STAGE(PG8_SB(1, 0), b3, voffB);
            PG8_BAR; PG8_WAIT_L(0); PG8_MMA(0, 1, At, B1); PG8_BAR;
            PG8_LDA(At, 1, 1); PG8_STAGE(PG8_SA(1, 0), a3, voffA);
            PG8_BAR; PG8_WAIT_L(0); PG8_MMA(1, 0, At, B0); PG8_BAR; PG8_SCHED;
            PG8_STAGE(PG8_SB(1, 1), b3 + hstep, voffB);
            PG8_WAIT_V(6); PG8_BAR; PG8_MMA(1, 1, At, B1); PG8_BAR;
            }
        }
        if constexpr (ALIGN_EPI) { if (wr == 0) PG8_BAR; }
        E(acc, cur, wr, wc, fr, fq);
        if (!has_next) break;
#pragma unroll
        for (int a = 0; a < 2; ++a)
#pragma unroll
            for (int b = 0; b < 2; ++b)
#pragma unroll
                for (int m = 0; m < 4; ++m)
#pragma unroll
                    for (int n = 0; n < 2; ++n) acc[a][b][m][n] = (f32x4){0.f, 0.f, 0.f, 0.f};
        cur = nxt; cA = nA; cB = nB; ++ui;
        if constexpr (ALIGN_EPI) { if (wr == 1) PG8_BAR; }
    }
    PG8_WAIT_V(0);
    if constexpr (!ALIGN_EPI) { if (wr == 0) PG8_BAR; }
    PG8_BAR;
#undef PG8_SA
#undef PG8_SB
#undef PG8_STAGE
#undef PG8_LDA
#undef PG8_LDB
#undef PG8_MMA
#undef PG8_WAIT_V
#undef PG8_WAIT_L
#undef PG8_BAR
#undef PG8_SCHED
}

struct OrderIn {
    int G, c;
    __device__ __forceinline__ bool next(int i, Unit& u) const {
        constexpr int nM = M / BM, nN = NIN / BM, nwg = nM * nN, nctx = (MC / BM) * 12;
        const long L = (long)i * G + c;
        if (L >= nwg + nctx) return false;
        if (L >= nwg) { const int j = (int)L - nwg; u.pm = nM + j / 12; u.pn = 4 + j % 12; return true; }
        int wgid = (int)L; { const int q = nwg / NXCD, r = nwg % NXCD, xcd = wgid % NXCD, off = wgid / NXCD; wgid = (xcd < r ? xcd * (q + 1) : r * (q + 1) + (xcd - r) * q) + off; }
        const int nig = WGM * nN, gid = wgid / nig, fm = gid * WGM, gsz = (nM - fm) < WGM ? (nM - fm) : WGM;
        u.pm = fm + ((wgid % nig) % gsz); u.pn = (wgid % nig) / gsz; return true;
    }
};
struct OrderRow {
    int pm, nN;
    __device__ __forceinline__ bool next(int i, Unit& u) const { if (i >= nN) return false; u.pm = pm; u.pn = i; return true; }
};

struct EpiIn {
    static constexpr bool PERM = true;
    bf16 *Q, *V, *GF, *GB, *OG, *P, *GA, *GBT; const float* lb;
    __device__ __forceinline__ void operator()(const f32x4 (&acc)[2][2][4][2], const Unit& u, int wr, int wc, int fr, int fq) const {
        const int pn = u.pn; int kind, colt, ldc = D; bf16* base; const float* lbp = lb;
        if (pn < 4)       { kind = 1; base = Q;   colt = pn * 256; }
        else if (pn < 8)  { kind = 0; base = V;   colt = (pn - 4) * 256; }
        else if (pn < 12) { kind = 3; base = GF;  colt = (pn - 8) * 256; }
        else if (pn < 16) { kind = 3; base = GB;  colt = (pn - 12) * 256; lbp = lb + 1024; }
        else if (pn < 20) { kind = 1; base = OG;  colt = (pn - 16) * 256; }
        else if (pn < 22) { kind = 0; base = P;   colt = (pn - 20) * 256; ldc = PW; }
        else if (pn < 26) { kind = 2; base = GA;  colt = (pn - 22) * 256; }
        else              { kind = 2; base = GBT; colt = (pn - 26) * 256; }
        const int row0 = u.pm * BM + wr * 64 + fr, col0 = colt + wc * 32 + 8 * fq;
        f32x4 l0[2], l1[2];
        if (kind == 3) {
#pragma unroll
            for (int bj = 0; bj < 2; ++bj) { l0[bj] = *(const f32x4*)(lbp + col0 + bj * HALF); l1[bj] = *(const f32x4*)(lbp + col0 + bj * HALF + 4); }
        }
#pragma unroll
        for (int ai = 0; ai < 2; ++ai)
#pragma unroll
            for (int m = 0; m < 4; ++m) { bf16* rowp = base + (size_t)(row0 + ai * HALF + m * 16) * ldc + col0;
#pragma unroll
                for (int bj = 0; bj < 2; ++bj) { f32x4 v0 = acc[ai][bj][m][0], v1 = acc[ai][bj][m][1]; u32x4 w;
                    if (kind == 3) {
#pragma unroll
                        for (int j = 0; j < 4; ++j) { v0[j] = __logf(l0[bj][j] + (1.0f - l0[bj][j]) * sigmoidf_(v0[j])); v1[j] = __logf(l1[bj][j] + (1.0f - l1[bj][j]) * sigmoidf_(v1[j])); }
                        w.x = pkh2(v0[0], v0[1]); w.y = pkh2(v0[2], v0[3]); w.z = pkh2(v1[0], v1[1]); w.w = pkh2(v1[2], v1[3]);
                    } else {
                        if (kind == 1) {
#pragma unroll
                            for (int j = 0; j < 4; ++j) { v0[j] = siluf_(v0[j]); v1[j] = siluf_(v1[j]); }
                        } else if (kind == 2) {
#pragma unroll
                            for (int j = 0; j < 4; ++j) { v0[j] = sigmoidf_(v0[j]); v1[j] = sigmoidf_(v1[j]); }
                        }
                        w.x = cvt_pk_bf16(v0[0], v0[1]); w.y = cvt_pk_bf16(v0[2], v0[3]); w.z = cvt_pk_bf16(v1[0], v1[1]); w.w = cvt_pk_bf16(v1[2], v1[3]);
                    }
                    *(u32x4*)(rowp + bj * HALF) = w; } }
    }
};
struct EpiGateA {
    static constexpr bool PERM = true;
    bf16* GA;
    __device__ __forceinline__ void operator()(const f32x4 (&acc)[2][2][4][2], const Unit& u, int wr, int wc, int fr, int fq) const {
        const int row0 = u.pm * BM + wr * 64 + fr, col0 = u.pn * BM + wc * 32 + 8 * fq;
#pragma unroll
        for (int ai = 0; ai < 2; ++ai)
#pragma unroll
            for (int m = 0; m < 4; ++m) { bf16* rowp = GA + (size_t)(row0 + ai * HALF + m * 16) * D + col0;
#pragma unroll
                for (int bj = 0; bj < 2; ++bj) { const f32x4 v0 = acc[ai][bj][m][0], v1 = acc[ai][bj][m][1]; const u32x4 gw = *(const u32x4*)(rowp + bj * HALF); u32x4 w;
                    w.x = cvt_pk_bf16(v0[0] * bflo(gw.x), v0[1] * bfhi(gw.x)); w.y = cvt_pk_bf16(v0[2] * bflo(gw.y), v0[3] * bfhi(gw.y));
                    w.z = cvt_pk_bf16(v1[0] * bflo(gw.z), v1[1] * bfhi(gw.z)); w.w = cvt_pk_bf16(v1[2] * bflo(gw.w), v1[3] * bfhi(gw.w));
                    *(u32x4*)(rowp + bj * HALF) = w; }
                if (m & 1) asm volatile("" ::: "memory"); }
    }
};
struct EpiGateB {
    static constexpr bool PERM = true;
    const bf16* T; bf16* GBT;
    __device__ __forceinline__ void operator()(const f32x4 (&acc)[2][2][4][2], const Unit& u, int wr, int wc, int fr, int fq) const {
        const int row0 = u.pm * BM + wr * 64 + fr, col0 = u.pn * BM + wc * 32 + 8 * fq;
#pragma unroll
        for (int ai = 0; ai < 2; ++ai)
#pragma unroll
            for (int m = 0; m < 4; ++m) { const size_t off = (size_t)(row0 + ai * HALF + m * 16) * D + col0;
#pragma unroll
                for (int bj = 0; bj < 2; ++bj) { const f32x4 v0 = acc[ai][bj][m][0], v1 = acc[ai][bj][m][1];
                    const u32x4 gw = *(const u32x4*)(GBT + off + bj * HALF), tw = *(const u32x4*)(T + off + bj * HALF); u32x4 w;
                    w.x = cvt_pk_bf16(bflo(tw.x) + v0[0] * bflo(gw.x), bfhi(tw.x) + v0[1] * bfhi(gw.x)); w.y = cvt_pk_bf16(bflo(tw.y) + v0[2] * bflo(gw.y), bfhi(tw.y) + v0[3] * bfhi(gw.y));
                    w.z = cvt_pk_bf16(bflo(tw.z) + v1[0] * bflo(gw.z), bfhi(tw.z) + v1[1] * bfhi(gw.z)); w.w = cvt_pk_bf16(bflo(tw.w) + v1[2] * bflo(gw.w), bfhi(tw.w) + v1[3] * bfhi(gw.w));
                    *(u32x4*)(GBT + off + bj * HALF) = w; }
                asm volatile("" ::: "memory"); }
    }
};
struct EpiResid {
    static constexpr bool PERM = false;
    const float* X; float* O; const float* g1;
    __device__ __forceinline__ void operator()(const f32x4 (&acc)[2][2][4][2], const Unit& u, int wr, int wc, int fr, int fq) const {
        const int row0 = u.pm * BM + wr * 64 + fr, col0 = u.pn * BM + wc * 32 + 4 * fq;
        f32x4 gv[2][2];
#pragma unroll
        for (int bj = 0; bj < 2; ++bj)
#pragma unroll
            for (int n = 0; n < 2; ++n) gv[bj][n] = *(const f32x4*)(g1 + col0 + bj * HALF + n * 16);
#pragma unroll
        for (int ai = 0; ai < 2; ++ai)
#pragma unroll
            for (int m = 0; m < 4; ++m) { const size_t off = (size_t)(row0 + ai * HALF + m * 16) * D + col0;
#pragma unroll
                for (int bj = 0; bj < 2; ++bj)
#pragma unroll
                    for (int n = 0; n < 2; ++n) { const f32x4 xv = *(const f32x4*)(X + off + bj * HALF + n * 16); *(f32x4*)(O + off + bj * HALF + n * 16) = xv + gv[bj][n] * acc[ai][bj][m][n]; }
                asm volatile("" ::: "memory"); }
    }
};
struct EpiHid {
    static constexpr bool PERM = true;
    bf16* H;
    __device__ __forceinline__ void operator()(const f32x4 (&acc)[2][2][4][2], const Unit& u, int wr, int wc, int fr, int fq) const {
        const int row0 = wr * 64 + fr, col0 = u.pn * HALF + wc * 32 + 8 * fq;
#pragma unroll
        for (int ai = 0; ai < 2; ++ai)
#pragma unroll
            for (int m = 0; m < 4; ++m) { bf16* rowp = H + (size_t)(row0 + ai * HALF + m * 16) * FF + col0;
                const f32x4 g0 = acc[ai][0][m][0], g1 = acc[ai][0][m][1], u0 = acc[ai][1][m][0], u1 = acc[ai][1][m][1]; u32x4 w;
                w.x = cvt_pk_bf16(siluf_(g0[0]) * u0[0], siluf_(g0[1]) * u0[1]); w.y = cvt_pk_bf16(siluf_(g0[2]) * u0[2], siluf_(g0[3]) * u0[3]);
                w.z = cvt_pk_bf16(siluf_(g1[0]) * u1[0], siluf_(g1[1]) * u1[1]); w.w = cvt_pk_bf16(siluf_(g1[2]) * u1[2], siluf_(g1[3]) * u1[3]);
                *(u32x4*)rowp = w; }
    }
};
struct EpiDown {
    static constexpr bool PERM = true;
    bf16* Y; const float* vals;
    __device__ __forceinline__ void operator()(const f32x4 (&acc)[2][2][4][2], const Unit& u, int wr, int wc, int fr, int fq) const {
        const int row0 = wr * 64 + fr, col0 = u.pn * BM + wc * 32 + 8 * fq;
#pragma unroll
        for (int ai = 0; ai < 2; ++ai)
#pragma unroll
            for (int m = 0; m < 4; ++m) { const int r = row0 + ai * HALF + m * 16; const float s = vals[r]; bf16* rowp = Y + (size_t)r * D + col0;
#pragma unroll
                for (int bj = 0; bj < 2; ++bj) { const f32x4 v0 = acc[ai][bj][m][0] * s, v1 = acc[ai][bj][m][1] * s; u32x4 w;
                    w.x = cvt_pk_bf16(v0[0], v0[1]); w.y = cvt_pk_bf16(v0[2], v0[3]); w.z = cvt_pk_bf16(v1[0], v1[1]); w.w = cvt_pk_bf16(v1[2], v1[3]);
                    *(u32x4*)(rowp + bj * HALF) = w; } }
    }
};
}

constexpr int RING_BYTES = 131072;
constexpr int LDS_BYTES = 147456;

struct Args {
    const float* in[21]; float* out; unsigned char* ws; int ph_lo, ph_hi;
};

__device__ __forceinline__ void transpose_item(const float* W, int K, int N, bf16* WT, int k0, int n0, int drow0, LAS float* scr, int lane) {
#pragma unroll 8
    for (int i = 0; i < 32; ++i) { const int kk = 2 * i + (lane >> 5); scr[kk * 33 + (lane & 31)] = W[(size_t)(k0 + kk) * N + n0 + (lane & 31)]; }
    LDS_WAIT(); asm volatile("" ::: "memory");
    const int c = lane & 7;
#pragma unroll
    for (int j = 0; j < 4; ++j) { const int n = (lane >> 3) + 8 * j; const LAS float* s = scr + (8 * c) * 33 + n;
        v4u o; o.x = pk2(s[0 * 33], s[1 * 33]); o.y = pk2(s[2 * 33], s[3 * 33]); o.z = pk2(s[4 * 33], s[5 * 33]); o.w = pk2(s[6 * 33], s[7 * 33]);
        *(v4u*)(WT + (size_t)(drow0 + n) * K + k0 + 8 * c) = o; }
    LDS_WAIT(); asm volatile("" ::: "memory");
}


__device__ __forceinline__ void p4_build_aa(int slab, const bf16* OF, const bf16* OB, const bf16* OG, const float* hgrn_g, bf16* AA, int tid) {
    asm volatile("" : "+v"(tid));
    const int lane = tid & 63, wave = __builtin_amdgcn_readfirstlane(tid >> 6), row0 = slab * 256;
    float hg[16];
#pragma unroll
    for (int i = 0; i < 4; ++i) { const f32x4 t = *(const f32x4*)(hgrn_g + 16 * (lane & 7) + 4 * i); hg[4 * i] = t.x; hg[4 * i + 1] = t.y; hg[4 * i + 2] = t.z; hg[4 * i + 3] = t.w; }
    for (int r = wave * 32; r < wave * 32 + 32; ++r) {
        const size_t off = (size_t)(row0 + r) * D + 16 * lane;
        const v4u f0 = *(const v4u*)(OF + off), f1 = *(const v4u*)(OF + off + 8), b0 = *(const v4u*)(OB + off), b1 = *(const v4u*)(OB + off + 8);
        const v4u g0 = *(const v4u*)(OG + off), g1 = *(const v4u*)(OG + off + 8);
        float o[16], gg[16];
        const unsigned fw[8] = {f0.x, f0.y, f0.z, f0.w, f1.x, f1.y, f1.z, f1.w}, bw[8] = {b0.x, b0.y, b0.z, b0.w, b1.x, b1.y, b1.z, b1.w}, gw8[8] = {g0.x, g0.y, g0.z, g0.w, g1.x, g1.y, g1.z, g1.w};
        float ss = 0.f;
#pragma unroll
        for (int i = 0; i < 8; ++i) { o[2 * i] = bflo(fw[i]) + bflo(bw[i]); o[2 * i + 1] = bfhi(fw[i]) + bfhi(bw[i]); gg[2 * i] = bflo(gw8[i]); gg[2 * i + 1] = bfhi(gw8[i]); ss += o[2 * i] * o[2 * i] + o[2 * i + 1] * o[2 * i + 1]; }
        ss += __shfl_xor(ss, 1); ss += __shfl_xor(ss, 2); ss += __shfl_xor(ss, 4);
        const float rstd = rsqrtf(ss * (1.0f / HD) + EPS);
        unsigned w[8];
#pragma unroll
        for (int i = 0; i < 8; ++i) w[i] = pk2((o[2 * i] * rstd * hg[2 * i]) * gg[2 * i], (o[2 * i + 1] * rstd * hg[2 * i + 1]) * gg[2 * i + 1]);
        *(v4u*)(AA + off) = (v4u){w[0], w[1], w[2], w[3]}; *(v4u*)(AA + off + 8) = (v4u){w[4], w[5], w[6], w[7]};
    }
}
__device__ __forceinline__ void p4_pool(LAS unsigned char* lds, int slab, const bf16* PB, bf16* RB, int tid) {
    asm volatile("" : "+v"(tid));
    LAS float* T = (LAS float*)lds; constexpr int TP = 68;
    const int b = slab / 32, row0 = slab * 256, gr0 = 4 * (slab % 32);
#pragma unroll 1
    for (int jh = 0; jh < 8; ++jh) {
        const int j = jh >> 1, hh = jh & 1, w = 2 << j, chb = j * 128 + hh * 64;
        { const int q = tid & 1, cc = (tid >> 1) & 63, r = tid >> 7; const int R = gr0 + r;
          int R0 = R - w / 2; R0 = R0 < 0 ? 0 : R0; int R1 = R + w / 2 - 1; R1 = (R1 > GRID_H - 1 ? GRID_H - 1 : R1) + 1;
          float a[32];
#pragma unroll
          for (int i = 0; i < 32; ++i) a[i] = 0.f;
#pragma unroll 1
          for (int rr = R0; rr < R1; ++rr) { const bf16* src = PB + ((size_t)b * SEQ + rr * GRID_W + cc) * PW + chb + q * 32;
#pragma unroll
              for (int k = 0; k < 4; ++k) { const v4u u = *(const v4u*)(src + 8 * k); a[8 * k + 0] += bflo(u.x); a[8 * k + 1] += bfhi(u.x); a[8 * k + 2] += bflo(u.y); a[8 * k + 3] += bfhi(u.y);
                  a[8 * k + 4] += bflo(u.z); a[8 * k + 5] += bfhi(u.z); a[8 * k + 6] += bflo(u.w); a[8 * k + 7] += bfhi(u.w); } }
          LAS float* dst = T + (r * 64 + cc) * TP + q * 32;
#pragma unroll
          for (int k = 0; k < 8; ++k) *(LAS f32x4*)(dst + 4 * k) = (f32x4){a[4 * k], a[4 * k + 1], a[4 * k + 2], a[4 * k + 3]}; }
        __syncthreads();
        { const int q = tid & 1, tl = tid >> 1, r = tl >> 6, cc = tl & 63; const int R = gr0 + r;
          int R0 = R - w / 2; R0 = R0 < 0 ? 0 : R0; int R1 = R + w / 2 - 1; R1 = (R1 > GRID_H - 1 ? GRID_H - 1 : R1) + 1;
          int C0 = cc - w / 2; C0 = C0 < 0 ? 0 : C0; int C1 = cc + w / 2 - 1; C1 = (C1 > GRID_W - 1 ? GRID_W - 1 : C1) + 1;
          const float inv = 1.0f / (float)((R1 - R0) * (C1 - C0));
          float s[32];
#pragma unroll
          for (int i = 0; i < 32; ++i) s[i] = 0.f;
#pragma unroll 1
          for (int c2 = C0; c2 < C1; ++c2) { const LAS float* src = T + (r * 64 + c2) * TP + q * 32;
#pragma unroll
              for (int k = 0; k < 8; ++k) { const f32x4 t4 = *(const LAS f32x4*)(src + 4 * k); s[4 * k] += t4.x; s[4 * k + 1] += t4.y; s[4 * k + 2] += t4.z; s[4 * k + 3] += t4.w; } }
          const size_t po = (size_t)(row0 + tl) * PW + chb + q * 32;
#pragma unroll
          for (int k = 0; k < 4; ++k) { const v4u u = *(const v4u*)(PB + po + 8 * k); v4u o;
              o.x = pk2(s[8 * k + 0] * inv - bflo(u.x), s[8 * k + 1] * inv - bfhi(u.x)); o.y = pk2(s[8 * k + 2] * inv - bflo(u.y), s[8 * k + 3] * inv - bfhi(u.y));
              o.z = pk2(s[8 * k + 4] * inv - bflo(u.z), s[8 * k + 5] * inv - bfhi(u.z)); o.w = pk2(s[8 * k + 6] * inv - bflo(u.w), s[8 * k + 7] * inv - bfhi(u.w));
              *(v4u*)(RB + po + 8 * k) = o; } }
        __syncthreads();
    }
}
__device__ __forceinline__ void p4_rows(LAS unsigned char* lds, int slab, const float* NEWHX, const float* modb, const float* norm2_g, const float* w_router, bf16* VX, float* PROBS, int tid) {
    asm volatile("" : "+v"(tid));
    const int lane = tid & 63, wave = __builtin_amdgcn_readfirstlane(tid >> 6), row0 = slab * 256;
    LAS float* W2 = (LAS float*)lds;
    LAS float* rstd_s = W2 + D * NE;
    LAS float* bias_s = rstd_s + 256;
    const float* sh2 = modb + 3 * D; const float* sc2 = modb + 4 * D;
    for (int e4 = tid; e4 < D * NE; e4 += NTHR) { const int c = e4 >> 4, e = e4 & 15;
        W2[(((c >> 4) * 4 + ((c >> 2) & 3)) * 16 + e) * 4 + (c & 3)] = norm2_g[c] * (1.0f + sc2[c]) * w_router[e4]; }
    { const int e = tid & 15, part = tid >> 4; float a = 0.f;
      for (int c = part * 32; c < part * 32 + 32; ++c) a += sh2[c] * w_router[c * NE + e];
      bias_s[e * 32 + part] = a; }
#pragma unroll 1
    for (int r = wave * 32; r < wave * 32 + 32; ++r) {
        const int row = row0 + r; const float* src = NEWHX + (size_t)row * D;
        f32x4 v[4]; float ss = 0.f;
#pragma unroll
        for (int j = 0; j < 4; ++j) { v[j] = *(const f32x4*)(src + 4 * lane + 256 * j); ss += (v[j].x * v[j].x + v[j].y * v[j].y) + (v[j].z * v[j].z + v[j].w * v[j].w); }
        const float rstd = rsqrtf(wave_sum(ss) * (1.0f / D) + EPS);
        if (lane == 0) rstd_s[r] = rstd;
#pragma unroll
        for (int j = 0; j < 4; ++j) { const int c = 4 * lane + 256 * j; const f32x4 g = *(const f32x4*)(norm2_g + c), sc = *(const f32x4*)(sc2 + c), sh = *(const f32x4*)(sh2 + c);
            const f32x4 o = (v[j] * rstd * g) * (sc + 1.0f) + sh;
            v2u w; w.x = pk2(o.x, o.y); w.y = pk2(o.z, o.w); *(v2u*)(VX + (size_t)row * D + c) = w; }
    }
    __syncthreads();
    if (tid < 16) { float a = 0.f; for (int p = 0; p < 32; ++p) a += bias_s[tid * 32 + p]; bias_s[512 + tid] = a; }
    __syncthreads();
    const int fr = lane & 15, fq = lane >> 4;
#pragma unroll 1
    for (int grp = wave * 2; grp < wave * 2 + 2; ++grp) {
        const float* arow = NEWHX + (size_t)(row0 + grp * 16 + fr) * D + 4 * fq;
        f32x4 acc = (f32x4){0.f, 0.f, 0.f, 0.f};
#pragma unroll 4
        for (int s = 0; s < 64; ++s) { const f32x4 a = *(const f32x4*)(arow + 16 * s); const f32x4 w = *(const LAS f32x4*)(W2 + ((s * 4 + fq) * 16 + fr) * 4);
            acc = __builtin_amdgcn_mfma_f32_16x16x4f32(a.x, w.x, acc, 0, 0, 0); acc = __builtin_amdgcn_mfma_f32_16x16x4f32(a.y, w.y, acc, 0, 0, 0);
            acc = __builtin_amdgcn_mfma_f32_16x16x4f32(a.z, w.z, acc, 0, 0, 0); acc = __builtin_amdgcn_mfma_f32_16x16x4f32(a.w, w.w, acc, 0, 0, 0); }
        const float be = bias_s[512 + fr];
#pragma unroll
        for (int i = 0; i < 4; ++i) { const int r = grp * 16 + 4 * fq + i; float lg = acc[i] * rstd_s[r] + be;
            float mx = lg; mx = fmaxf(mx, __shfl_xor(mx, 1)); mx = fmaxf(mx, __shfl_xor(mx, 2)); mx = fmaxf(mx, __shfl_xor(mx, 4)); mx = fmaxf(mx, __shfl_xor(mx, 8));
            const float ex = __expf(lg - mx); float sm = ex; sm += __shfl_xor(sm, 1); sm += __shfl_xor(sm, 2); sm += __shfl_xor(sm, 4); sm += __shfl_xor(sm, 8);
            PROBS[(size_t)(row0 + r) * NE + fr] = ex / sm; }
    }
    __syncthreads();
}

__global__ void __launch_bounds__(NTHR) mega(Args args) {
    extern __shared__ __attribute__((aligned(16))) unsigned char lds_raw[];
    LAS unsigned char* lds = (LAS unsigned char*)lds_raw;
    const int tid = threadIdx.x, lane = tid & 63, wave = __builtin_amdgcn_readfirstlane(tid >> 6);
    const int G = gridDim.x, bx = blockIdx.x;
    const int vcu = (G % 8 == 0) ? (bx % 8) * (G / 8) + bx / 8 : bx;
    const int gw = vcu * NWAVES + wave, NGW = G * NWAVES;
    unsigned char* ws = args.ws; unsigned char* dout = (unsigned char*)args.out;
    const float* x = args.in[0]; const float* cvec = args.in[1]; const float* ctx = args.in[2]; const float* c_ctx = args.in[3];
    const float* lb_logits = args.in[4]; const float* w_mod = args.in[5]; const float* b_mod = args.in[6]; const float* norm1_g = args.in[7];
    const float* w_in = args.in[8]; const float* hgrn_g = args.in[9]; const float* w_a = args.in[10]; const float* w_pool = args.in[11];
    const float* pool_scale = args.in[12]; const float* w_b = args.in[13]; const float* w_out = args.in[14]; const float* norm2_g = args.in[15];
    const float* w_router = args.in[16]; const float* w_e_gate = args.in[17]; const float* w_e_up = args.in[18]; const float* w_e_down = args.in[19];
    const float* final_g = args.in[20];
    float* MOD = (float*)(ws + WS_MOD); float* MODP = (float*)(ws + WS_MODP); float* LB = (float*)(ws + WS_LB);
    int* IDX = (int*)(ws + WS_IDX); float* VALS = (float*)(ws + WS_VALS); float* PROBS = (float*)(ws + WS_PROBS); int* INV = (int*)(ws + WS_INV);
    bf16* WIN = (bf16*)(ws + WS_WIN); bf16* WA = (bf16*)(ws + WS_WA); bf16* WP = (bf16*)(ws + WS_WP); bf16* WOUT = (bf16*)(ws + WS_WOUT);
    bf16* QB = (bf16*)(ws + WS_Q); bf16* VB = (bf16*)(ws + WS_V); bf16* GF = (bf16*)(ws + WS_GF); bf16* GBK = (bf16*)(ws + WS_GB);
    bf16* OG = (bf16*)(ws + WS_OG); bf16* PB = (bf16*)(ws + WS_P); bf16* GA = (bf16*)(ws + WS_GA); bf16* GBT = (bf16*)(ws + WS_GBT);
    float* NEWHX = (float*)(ws + WS_NEWHX); bf16* AA = (bf16*)(ws + WS_AA); bf16* VX = (bf16*)(ws + WS_VX); bf16* RB = (bf16*)(ws + WS_R);
    bf16* HID = (bf16*)(ws + WS_HID); bf16* YB = (bf16*)(ws + WS_YB);
    bf16* UX = (bf16*)(dout + DO_UX); bf16* OF = (bf16*)(dout + DO_OF); bf16* OB = (bf16*)(dout + DO_OB); bf16* WGU = (bf16*)(dout + DO_WGU); bf16* WDN = (bf16*)(dout + DO_WDN);
    const int lo = args.ph_lo, hi = args.ph_hi;
#ifndef PHASE_MASK
#define PHASE_MASK 0xff
#endif
#define IN(k) (((PHASE_MASK >> (k)) & 1) && lo <= (k) && (k) < hi)
#define SEAM(k) do { if (IN(k) && IN((k) + 1)) { cg::this_grid().sync(); } } while (0)

    if (IN(0)) {
        LAS float* scr = (LAS float*)(lds + wave * 16384);
        for (int it = gw; it < 96 * 16; it += NGW) {
            const int cb = it % 96, kp = it / 96, col = cb * 64 + lane, k0 = kp * 64;
            float sv[9];
#pragma unroll
            for (int r = 0; r < 9; ++r) { const float cv = (r < 8) ? cvec[r * D + k0 + lane] : c_ctx[k0 + lane]; sv[r] = siluf_(cv); }
            float acc[9];
#pragma unroll
            for (int r = 0; r < 9; ++r) acc[r] = 0.f;
#pragma unroll 16
            for (int kk = 0; kk < 64; ++kk) { const float w = w_mod[(size_t)(k0 + kk) * (6 * D) + col];
#pragma unroll
                for (int r = 0; r < 9; ++r) acc[r] += __shfl(sv[r], kk) * w; }
#pragma unroll
            for (int r = 0; r < 9; ++r) MODP[((size_t)kp * 9 + r) * (6 * D) + col] = acc[r];
        }
        for (int i = gw * 64 + lane; i < 2 * HD * NH; i += NGW * 64) { const int dir = i >> 10, d = i & 1023; const float l0 = lb_logits[dir * 2048 + d], l1 = lb_logits[dir * 2048 + 1024 + d]; LB[i] = 1.0f / (1.0f + __expf(l1 - l0)); }
        {
            constexpr int I_IN = (D / 64) * (NIN / 32), I_A = (D / 64) * (D / 32), I_OUT = I_A;
            for (int it = gw; it < I_IN + I_A + I_OUT; it += NGW) {
                int r = it;
                if (r < I_IN) { const int nblk = NIN / 32, kb = r / nblk, nb = r % nblk; transpose_item(w_in, D, NIN, WIN, 64 * kb, 32 * nb, 32 * nb, scr, lane); continue; } r -= I_IN;
                if (r < I_A) { const int nblk = D / 32, kb = r / nblk, nb = r % nblk; transpose_item(w_a, D, D, WA, 64 * kb, 32 * nb, 32 * nb, scr, lane); continue; } r -= I_A;
                { const int nblk = D / 32, kb = r / nblk, nb = r % nblk; transpose_item(w_out, D, D, WOUT, 64 * kb, 32 * nb, 32 * nb, scr, lane); }
            }
        }
        for (int it = gw; it < PW * 16; it += NGW) {
            const int k = it >> 4, nb = it & 15, n = nb * 64 + lane, j = k >> 7;
            const float* wp = w_pool + (size_t)k * 128; const float* ps = pool_scale + j * 128; const float* wb = w_b + (size_t)(j * 128) * D + n;
            float a = 0.f;
#pragma unroll 8
            for (int m = 0; m < 128; ++m) a += (wp[m] * ps[m]) * wb[(size_t)m * D];
            WP[(size_t)n * PW + k] = (bf16)f2bf(a);
        }
    }
    SEAM(0);

    if (IN(1)) {
        LAS float* shs = (LAS float*)lds; LAS float* scs = shs + D;
        for (int slab = bx; slab < MT / 256; slab += G) {
            const int mrow = slab < M / 256 ? slab / 32 : 8;
            const bool writer = (slab < M / 256) ? (slab % 32 == 0) : (slab == M / 256);
            for (int c = tid; c < (writer ? 6 * D : 2 * D); c += NTHR) {
                float a = b_mod[c];
#pragma unroll
                for (int kp = 0; kp < 16; ++kp) a += MODP[((size_t)kp * 9 + mrow) * (6 * D) + c];
                if (c < D) shs[c] = a; else if (c < 2 * D) scs[c - D] = a;
                if (writer) MOD[mrow * (6 * D) + c] = a;
            }
            __syncthreads();
            for (int r = wave * 32; r < wave * 32 + 32; ++r) {
                const int row = slab * 256 + r;
                const float* src = (row < M) ? x + (size_t)row * D : ctx + (size_t)(row - M) * D;
                f32x4 v[4]; float ss = 0.f;
#pragma unroll
                for (int j = 0; j < 4; ++j) { v[j] = *(const f32x4*)(src + 4 * lane + 256 * j); ss += (v[j].x * v[j].x + v[j].y * v[j].y) + (v[j].z * v[j].z + v[j].w * v[j].w); }
                const float rstd = rsqrtf(wave_sum(ss) * (1.0f / D) + EPS);
#pragma unroll
                for (int j = 0; j < 4; ++j) { const int c = 4 * lane + 256 * j; const f32x4 g = *(const f32x4*)(norm1_g + c);
                    const f32x4 sc = *(const LAS f32x4*)(scs + c), sh = *(const LAS f32x4*)(shs + c);
                    const f32x4 o = (v[j] * rstd * g) * (sc + 1.0f) + sh;
                    v2u w; w.x = pk2(o.x, o.y); w.y = pk2(o.z, o.w); *(v2u*)(UX + (size_t)row * D + c) = w; }
            }
            __syncthreads();
        }
    }
    SEAM(1);

    if (IN(2)) {
        pg8::Gemm g{UX, WIN, D, nullptr}; pg8::OrderIn S{G, bx};
        pg8::EpiIn E{QB, VB, GF, GBK, OG, PB, GA, GBT, LB};
        pg8::gemm_phase<pg8::EpiIn, pg8::OrderIn, true, true, false>(lds, g, S, E, tid);
    }
    SEAM(2);

    if (IN(3)) {
        constexpr int TB = 16;
        LAS float* fq = (LAS float*)lds;
        LAS float* ff = fq + TB * 128;
        LAS float* fk = ff + TB * 128;
        LAS float* fv = fk + TB * 128;
        LAS float* part = fv + TB * 64;
        for (int unit = bx; unit < NB * NH * 4; unit += G) {
            const int vh = unit & 1, dir = (unit >> 1) & 1, h = (unit >> 2) & 7, b = unit >> 5;
            const bf16* Gp = dir ? GBK : GF; bf16* Op = dir ? OB : OF;
            float Sst[16];
#pragma unroll
            for (int i = 0; i < 16; ++i) Sst[i] = 0.f;
            const int NTOK = CTXL + SEQ;
            for (int p0 = 0; p0 < NTOK; p0 += TB) {
                const bool isx = p0 >= CTXL;
                for (int e = tid; e < TB * 128; e += NTHR) { const int tt = e >> 7, d = e & 127; const int p = p0 + tt;
                    size_t row; if (!isx) { const int tc = dir ? (CTXL - 1 - p) : p; row = (size_t)M + b * CTXL + tc; } else { const int tx = dir ? (SEQ - 1 - (p - CTXL)) : (p - CTXL); row = (size_t)b * SEQ + tx; }
                    const float gl = h2f(Gp[row * D + h * HD + d]); const float f = __expf(gl);
                    ff[e] = f; fk[e] = 1.0f - f; fq[e] = isx ? bf2f(QB[row * D + h * HD + d]) : 0.f;
                    if (d < 64) fv[tt * 64 + d] = bf2f(VB[row * D + h * HD + vh * 64 + d]); }
                __syncthreads();
#pragma unroll 1
                for (int tt = 0; tt < TB; ++tt) {
                    const float vv = fv[tt * 64 + lane]; float po = 0.f;
#pragma unroll
                    for (int i = 0; i < 16; ++i) { const int d = wave * 16 + i; Sst[i] = ff[tt * 128 + d] * Sst[i] + fk[tt * 128 + d] * vv; po += Sst[i] * fq[tt * 128 + d]; }
                    part[(tt * 8 + wave) * 64 + lane] = po;
                }
                __syncthreads();
                if (isx) {
                    for (int e = tid; e < TB * 64; e += NTHR) { const int tt = e >> 6, v = e & 63; float o = 0.f;
#pragma unroll
                        for (int w = 0; w < 8; ++w) o += part[(tt * 8 + w) * 64 + v];
                        const int p = p0 + tt; const int tx = dir ? (SEQ - 1 - (p - CTXL)) : (p - CTXL);
                        Op[((size_t)b * SEQ + tx) * D + h * HD + vh * 64 + v] = (bf16)f2bf(o); }
                }
                __syncthreads();
            }
        }
    }
    SEAM(3);

    if (IN(4)) {
        for (int slab = bx; slab < M / 256; slab += G) {
            const int b = slab / 32;
            if (P4M & 1) p4_build_aa(slab, OF, OB, OG, hgrn_g, AA, tid);
            if (P4M & 2) p4_pool(lds, slab, PB, RB, tid);
            wg_fence();
            if (P4M & 4) { const bf16* wb_ = WA; asm volatile("" : "+s"(wb_)); pg8::Gemm g{AA, wb_, D, nullptr}; pg8::OrderRow S{slab, 4}; pg8::EpiGateA E{GA};
              pg8::gemm_phase<pg8::EpiGateA, pg8::OrderRow, true, true, false>(lds, g, S, E, tid); }
            wg_fence();
            if (P4M & 8) { const bf16* wb_ = WP; asm volatile("" : "+s"(wb_)); pg8::Gemm g{RB, wb_, PW, nullptr}; pg8::OrderRow S{slab, 4}; pg8::EpiGateB E{GA, GBT};
              pg8::gemm_phase<pg8::EpiGateB, pg8::OrderRow, true, true, false>(lds, g, S, E, tid); }
            wg_fence();
            if (P4M & 16) { const bf16* wb_ = WOUT; asm volatile("" : "+s"(wb_)); pg8::Gemm g{GBT, wb_, D, nullptr}; pg8::OrderRow S{slab, 4}; pg8::EpiResid E{x, NEWHX, MOD + b * (6 * D) + 2 * D};
              pg8::gemm_phase<pg8::EpiResid, pg8::OrderRow, true, true, false>(lds, g, S, E, tid); }
            wg_fence();
            if (P4M & 32) p4_rows(lds, slab, NEWHX, MOD + b * (6 * D), norm2_g, w_router, VX, PROBS, tid);
        }
    }
    SEAM(4);

    if (IN(5)) {
        {
            LAS float* scr = (LAS float*)(lds + wave * 16384);
            constexpr int I_E = (D / 64) * (FF / 32);
            for (int it = gw; it < NE * 3 * I_E; it += NGW) {
                const int e = it / (3 * I_E), r = it % (3 * I_E), which = r / I_E, q = r % I_E, kb = q / (FF / 32), nb = q % (FF / 32), n0 = 32 * nb;
                if (which < 2) transpose_item((which ? w_e_up : w_e_gate) + (size_t)e * D * FF, D, FF, WGU + (size_t)e * 2 * FF * D, 64 * kb, n0, n0 + 128 * (n0 / 128) + 128 * which, scr, lane);
                else transpose_item(w_e_down + (size_t)e * FF * D, FF, D, WDN + (size_t)e * D * FF, 64 * kb, n0, n0, scr, lane);
            }
        }
        __syncthreads();
        {
            LAS unsigned* keys = (LAS unsigned*)lds;
            LAS unsigned* hist = keys + SEQ;
            LAS unsigned* sc = hist + 256;
            LAS unsigned* wsum = sc + 16;
            for (int be = bx; be < NB * NE; be += G) {
                const int b = be / NE, e = be % NE;
                for (int t = tid; t < SEQ; t += NTHR) keys[t] = __builtin_bit_cast(unsigned, PROBS[((size_t)b * SEQ + t) * NE + e]);
                unsigned prefix = 0, mask = 0, kk = CAP;
                for (int pass = 0; pass < 4; ++pass) {
                    const int shift = 24 - 8 * pass;
                    if (tid < 256) hist[tid] = 0;
                    __syncthreads();
                    for (int t = tid; t < SEQ; t += NTHR) { const unsigned k = keys[t]; if ((k & mask) == prefix) __hip_atomic_fetch_add(hist + ((k >> shift) & 255u), 1u, __ATOMIC_RELAXED, __HIP_MEMORY_SCOPE_WORKGROUP); }
                    __syncthreads();
                    if (tid == 0) { unsigned cum = 0; int dsel = 0; unsigned knew = kk;
                        for (int d = 255; d >= 0; --d) { const unsigned hc = hist[d]; if (cum + hc >= kk) { dsel = d; knew = kk - cum; break; } cum += hc; }
                        sc[0] = prefix | ((unsigned)dsel << shift); sc[1] = knew; }
                    __syncthreads();
                    prefix = sc[0]; kk = sc[1]; mask |= (255u << shift);
                    __syncthreads();
                }
                const unsigned thr = prefix, need = kk;
                unsigned cgt = 0, ceq = 0;
#pragma unroll
                for (int i = 0; i < 16; ++i) { const unsigned k = keys[tid * 16 + i]; cgt += (k > thr); ceq += (k == thr); }
                unsigned igt = cgt, ieq = ceq;
#pragma unroll
                for (int o = 1; o < 64; o <<= 1) { const unsigned a = __shfl_up(igt, o), c2 = __shfl_up(ieq, o); if (lane >= o) { igt += a; ieq += c2; } }
                if (lane == 63) { wsum[wave] = igt; wsum[8 + wave] = ieq; }
                __syncthreads();
                unsigned bgt = 0, beq = 0, totgt = 0;
#pragma unroll
                for (int w = 0; w < 8; ++w) { const unsigned a = wsum[w], c2 = wsum[8 + w]; if (w < wave) { bgt += a; beq += c2; } totgt += a; }
                unsigned pgt = bgt + igt - cgt, peq = beq + ieq - ceq;
#pragma unroll
                for (int i = 0; i < 16; ++i) { const int t = tid * 16 + i; const unsigned k = keys[t]; int slot = -1;
                    if (k > thr) { slot = (int)pgt; ++pgt; } else if (k == thr) { if (peq < need) slot = (int)(totgt + peq); ++peq; }
                    INV[((size_t)b * SEQ + t) * NE + e] = slot;
                    if (slot >= 0) { IDX[be * CAP + slot] = b * SEQ + t; VALS[be * CAP + slot] = __builtin_bit_cast(float, k); } }
                __syncthreads();
            }
        }
    }
    SEAM(5);

    if (IN(6)) {
        for (int rnd = 0;; ++rnd) {
            int e, b, rt;
            if (G == 256) { if (rnd >= 2) break; const int xcd = bx & 7, loc = bx >> 3; e = 2 * xcd + rnd; b = loc >> 2; rt = loc & 3; }
            else { const int it = bx + rnd * G; if (it >= NB * NE * 4) break; e = it >> 5; b = (it >> 2) & 7; rt = it & 3; }
            const int be = b * NE + e; const size_t r0 = (size_t)be * CAP + rt * 256;
            { pg8::Gemm g{VX, WGU + (size_t)e * 2 * FF * D, D, IDX + r0}; pg8::OrderRow S{0, 8}; pg8::EpiHid E{HID + r0 * FF};
              pg8::gemm_phase<pg8::EpiHid, pg8::OrderRow, true, true, true>(lds, g, S, E, tid); }
            wg_fence();
            { pg8::Gemm g{HID + r0 * FF, WDN + (size_t)e * D * FF, FF, nullptr}; pg8::OrderRow S{0, 4}; pg8::EpiDown E{YB + r0 * D, VALS + r0};
              pg8::gemm_phase<pg8::EpiDown, pg8::OrderRow, true, true, false>(lds, g, S, E, tid); }
        }
    }
    SEAM(6);

    if (IN(7)) {
        float* out = args.out;
        for (int row = gw; row < M; row += NGW) {
            const int b = row / SEQ; const float* g2 = MOD + b * (6 * D) + 5 * D;
            f32x4 a[4];
#pragma unroll
            for (int j = 0; j < 4; ++j) a[j] = (f32x4){0.f, 0.f, 0.f, 0.f};
            const int sl = (lane < NE) ? INV[(size_t)row * NE + lane] : -1;
            for (int e = 0; e < NE; ++e) { const int s = __shfl(sl, e);
                if (s >= 0) { const bf16* yr = YB + ((size_t)(b * NE + e) * CAP + s) * D + 4 * lane;
#pragma unroll
                    for (int j = 0; j < 4; ++j) { const v2u u = *(const v2u*)(yr + 256 * j); a[j].x += bflo(u.x); a[j].y += bfhi(u.x); a[j].z += bflo(u.y); a[j].w += bfhi(u.y); } } }
            f32x4 hv[4]; float ss = 0.f;
#pragma unroll
            for (int j = 0; j < 4; ++j) { const int c = 4 * lane + 256 * j; hv[j] = *(const f32x4*)(NEWHX + (size_t)row * D + c) + *(const f32x4*)(g2 + c) * a[j];
                ss += (hv[j].x * hv[j].x + hv[j].y * hv[j].y) + (hv[j].z * hv[j].z + hv[j].w * hv[j].w); }
            const float rstd = rsqrtf(wave_sum(ss) * (1.0f / D) + EPS);
#pragma unroll
            for (int j = 0; j < 4; ++j) { const int c = 4 * lane + 256 * j; *(f32x4*)(out + (size_t)row * D + c) = hv[j] * rstd * *(const f32x4*)(final_g + c); }
        }
    }
#undef IN
#undef SEAM
}

extern "C" void kernel_launch(void* const* d_in, const int* in_sizes, int n_in, void* d_out, int out_size, void* d_ws, size_t ws_size, hipStream_t stream) {
    static int grid = 0;
    if (grid == 0) {
        if (n_in != 21 || in_sizes[0] != M * D || in_sizes[8] != D * NIN || out_size != M * D || ws_size < WS_END) {
            fprintf(stderr, "kernel_launch: unexpected shapes: n_in %d in0 %d in8 %d out %d ws %zu; nothing launched\n", n_in, n_in > 0 ? in_sizes[0] : -1, n_in > 8 ? in_sizes[8] : -1, out_size, ws_size); grid = -1; return; }
        int dev = 0, cus = 0, per_cu = 0;
        if (hipGetDevice(&dev) != hipSuccess || hipDeviceGetAttribute(&cus, hipDeviceAttributeMultiprocessorCount, dev) != hipSuccess) { grid = -1; return; }
        if (hipFuncSetAttribute((const void*)mega, hipFuncAttributeMaxDynamicSharedMemorySize, LDS_BYTES) != hipSuccess) { fprintf(stderr, "kernel_launch: hipFuncSetAttribute failed\n"); grid = -1; return; }
        if (hipOccupancyMaxActiveBlocksPerMultiprocessor(&per_cu, (const void*)mega, NTHR, LDS_BYTES) != hipSuccess || per_cu < 1) { fprintf(stderr, "kernel_launch: occupancy query says %d\n", per_cu); per_cu = 1; }
        (void)hipGetLastError();
        grid = cus;
        fprintf(stderr, "kernel_launch: grid %d (occupancy query %d per CU)\n", grid, per_cu);
    }
    if (grid < 0) return;
    Args a{};
    for (int i = 0; i < 21; ++i) a.in[i] = (const float*)d_in[i];
    a.out = (float*)d_out; a.ws = (unsigned char*)d_ws;
#if MK_ONE_LAUNCH
    a.ph_lo = 0; a.ph_hi = NPHASE;
    void* kargs[] = {&a};
    hipError_t e = hipLaunchCooperativeKernel((const void*)mega, dim3(grid), dim3(NTHR), kargs, LDS_BYTES, stream);
    if (e != hipSuccess) fprintf(stderr, "kernel_launch: cooperative launch failed: %s\n", hipGetErrorString(e));
#else
    for (int p = 0; p < NPHASE; ++p) {
        a.ph_lo = p; a.ph_hi = p + 1;
        hipLaunchKernelGGL(mega, dim3(grid), dim3(NTHR), LDS_BYTES, stream, a);
    }
#endif
}
```

```cpp
#include <hip/hip_runtime.h>
#include <hip/hip_cooperative_groups.h>
#include <cstdio>
namespace cg = cooperative_groups;

#define GAS __attribute__((address_space(1)))
#define LAS __attribute__((address_space(3)))
typedef unsigned short bf16;
typedef unsigned v4u __attribute__((ext_vector_type(4)));
typedef unsigned v2u __attribute__((ext_vector_type(2)));
typedef float f32x4 __attribute__((ext_vector_type(4)));
typedef float f32x2 __attribute__((ext_vector_type(2)));
typedef short bf16x8 __attribute__((ext_vector_type(8)));

#ifndef P4M
#define P4M 63
#endif
#ifndef MK_ONE_LAUNCH
#define MK_ONE_LAUNCH 1
#endif

constexpr int NB = 8, SEQ = 8192, D = 1024, M = NB * SEQ, CTXL = 256, MC = NB * CTXL, MT = M + MC;
constexpr int NIN = 7680, NH = 8, HD = 128, NE = 16, CAP = 1024, FF = 1024, PW = 512;
constexpr int GRID_W = 64, GRID_H = SEQ / GRID_W;
constexpr float EPS = 1e-6f;
constexpr int NWAVES = 8, NTHR = 512;
constexpr int NPHASE = 8;

constexpr size_t MiB = 1u << 20;
constexpr size_t WS_CTL = 0, WS_MOD = 1 * MiB, WS_LB = 2 * MiB, WS_IDX = 3 * MiB, WS_VALS = 3 * MiB + 512 * 1024;
constexpr size_t WS_PROBS = 4 * MiB, WS_INV = 8 * MiB;
constexpr size_t WS_MODP = 4 * MiB;
constexpr size_t WS_WIN = 12 * MiB, WS_WA = 27 * MiB, WS_WP = 29 * MiB, WS_WOUT = 30 * MiB;
constexpr size_t WS_Q = 32 * MiB, WS_V = 160 * MiB, WS_GF = 292 * MiB, WS_GB = 424 * MiB, WS_OG = 556 * MiB, WS_P = 684 * MiB, WS_GA = 748 * MiB, WS_GBT = 876 * MiB, WS_END = 1004 * MiB;
constexpr size_t WS_NEWHX = WS_Q;
constexpr size_t WS_AA = WS_GF;
constexpr size_t WS_VX = WS_GF;
constexpr size_t WS_R = WS_GB;
constexpr size_t WS_HID = WS_GB;
constexpr size_t WS_YB = WS_GA;
constexpr size_t DO_UX = 0, DO_OF = 0, DO_OB = 128 * MiB, DO_WGU = 0, DO_WDN = 64 * MiB;

__device__ __forceinline__ unsigned f2bf(float f) { unsigned u = __builtin_bit_cast(unsigned, f); return (u + 0x7fffu + ((u >> 16) & 1u)) >> 16; }
__device__ __forceinline__ unsigned pk2(float lo, float hi) { return f2bf(lo) | (f2bf(hi) << 16); }
__device__ __forceinline__ float bflo(unsigned w) { return __builtin_bit_cast(float, w << 16); }
__device__ __forceinline__ float bfhi(unsigned w) { return __builtin_bit_cast(float, w & 0xffff0000u); }
__device__ __forceinline__ float bf2f(bf16 b) { return __builtin_bit_cast(float, (unsigned)b << 16); }
__device__ __forceinline__ unsigned pkh2(float lo, float hi) { const _Float16 a = (_Float16)lo, b = (_Float16)hi; return (unsigned)__builtin_bit_cast(unsigned short, a) | ((unsigned)__builtin_bit_cast(unsigned short, b) << 16); }
__device__ __forceinline__ float h2f(unsigned short h) { return (float)__builtin_bit_cast(_Float16, h); }
__device__ __forceinline__ float wave_sum(float v) {
#pragma unroll
    for (int o = 1; o < 64; o <<= 1) v += __shfl_xor(v, o);
    return v;
}
__device__ __forceinline__ float sigmoidf_(float x) { return 1.0f / (1.0f + __expf(-x)); }
__device__ __forceinline__ float siluf_(float x) { return x / (1.0f + __expf(-x)); }
#define LDS_WAIT() asm volatile("s_waitcnt lgkmcnt(0)" ::: "memory")
#define VM_WAIT() asm volatile("s_waitcnt vmcnt(0)" ::: "memory")
__device__ __forceinline__ void wg_fence() {
    asm volatile("s_waitcnt vmcnt(0) lgkmcnt(0)" ::: "memory");
    __syncthreads();
    if (threadIdx.x < 64) { __builtin_amdgcn_fence(__ATOMIC_ACQUIRE, "agent"); asm volatile("s_waitcnt vmcnt(0)" ::: "memory"); }
    __syncthreads();
}

namespace pg8 {
#define PG8_LAS __attribute__((address_space(3)))
typedef unsigned short bf16_t;
typedef unsigned u32x4 __attribute__((ext_vector_type(4)));
constexpr int BM = 256, BK = 64, HALF = 128, HTB = HALF * BK * 2, STAGE_BYTES = 8 * HTB, NXCD = 8, WGM = 8;
__host__ __device__ __forceinline__ int lds_byte(int r, int c) { const int st = (r >> 4) * 2 + (c >> 5), rr = r & 15, cc = c & 31, ob = rr * 64 + cc * 2; return st * 1024 + (ob ^ (((ob >> 9) & 1) << 5)); }
__host__ __device__ __forceinline__ void stage_rc(int b, int& R, int& C) { const int st = b / 1024, sb = b % 1024, swz = sb ^ (((sb >> 9) & 1) << 5); R = (st >> 1) * 16 + swz / 64; C = (st & 1) * 32 + (swz % 64) / 2; }
__host__ __device__ __forceinline__ int perm32(int rho) { const int n = rho >> 4, i = rho & 15; return 8 * (i >> 2) + 4 * n + (i & 3); }
struct Unit { int pm, pn; };
struct Gemm { const bf16_t* A; const bf16_t* Bt; int K; const int* gidx; };
__device__ __forceinline__ unsigned cvt_pk_bf16(float lo, float hi) { unsigned r; asm volatile("v_cvt_pk_bf16_f32 %0, %1, %2" : "=v"(r) : "v"(lo), "v"(hi)); return r; }

template <class Epi, class Sched, bool ALIGN_EPI, bool SP2, bool GATHER>
__device__ __forceinline__ void gemm_phase(PG8_LAS unsigned char* lds, const Gemm g, const Sched& S, const Epi& E, int tid_in) {
    asm volatile("" : "+v"(tid_in));
    const int tid = tid_in, wid = __builtin_amdgcn_readfirstlane(tid >> 6), lane = tid & 63, wr = wid >> 2, wc = wid & 3, fr = lane & 15, fq = lane >> 4;
    const int K = g.K, nt = K / BK;
    unsigned voffA[2], voffA1[2], voffB[2];
#pragma unroll
    for (int i = 0; i < 2; ++i) { int R, C; stage_rc(tid * 16 + i * 8192, R, C); const int Rb = Epi::PERM ? ((R & ~31) + perm32(R & 31)) : R;
        if (GATHER) { voffA[i] = (unsigned)(g.gidx[R] * K + C) * 2u; voffA1[i] = (unsigned)(g.gidx[HALF + R] * K + C) * 2u; }
        else { voffA[i] = (unsigned)(R * K + C) * 2u; voffA1[i] = voffA[i]; }
        voffB[i] = (unsigned)(Rb * K + C) * 2u; }
    const size_t kstep = (size_t)(BK * 2);
    const size_t hstep = (size_t)HALF * K * 2;
    const size_t hstepA = GATHER ? 0 : hstep;
    const size_t tstep = 2 * hstep;
    const unsigned ldsw = (unsigned)wid * 1024u;
    const int aoff = lds_byte(wr * 64 + fr, fq * 8), boff = lds_byte(wc * 32 + fr, fq * 8);
#define PG8_SA(b, h) (((b) * 2 + (h)) * HTB)
#define PG8_SB(b, h) ((4 + (b) * 2 + (h)) * HTB)
#define PG8_STAGE(bufoff, gbase, voff) do { _Pragma("unroll") for (int _i = 0; _i < 2; ++_i) \
        __builtin_amdgcn_global_load_lds((const unsigned*)((const char*)(gbase) + (voff)[_i]), (PG8_LAS unsigned*)(lds + (bufoff) + ldsw + _i * 8192), 16, 0, 0); } while (0)
#define PG8_LDA(dst, b, h) do { _Pragma("unroll") for (int m = 0; m < 4; ++m) _Pragma("unroll") for (int k = 0; k < 2; ++k) dst[m][k] = *(const PG8_LAS bf16x8*)(lds + PG8_SA(b, h) + aoff + m * 2048 + k * 1024); } while (0)
#define PG8_LDB(dst, b, h) do { _Pragma("unroll") for (int n = 0; n < 2; ++n) _Pragma("unroll") for (int k = 0; k < 2; ++k) dst[n][k] = *(const PG8_LAS bf16x8*)(lds + PG8_SB(b, h) + boff + n * 2048 + k * 1024); } while (0)
#define PG8_MMA(ai, bj, At, Bt) do { __builtin_amdgcn_s_setprio(1); _Pragma("unroll") for (int m = 0; m < 4; ++m) _Pragma("unroll") for (int n = 0; n < 2; ++n) _Pragma("unroll") for (int k = 0; k < 2; ++k) \
        acc[ai][bj][m][n] = __builtin_amdgcn_mfma_f32_16x16x32_bf16(Bt[n][k], At[m][k], acc[ai][bj][m][n], 0, 0, 0); __builtin_amdgcn_s_setprio(0); } while (0)
#define PG8_WAIT_V(n) asm volatile("s_waitcnt vmcnt(" #n ")" ::: "memory")
#define PG8_WAIT_L(n) asm volatile("s_waitcnt lgkmcnt(" #n ")" ::: "memory")
#define PG8_BAR __builtin_amdgcn_s_barrier()
#define PG8_SCHED __builtin_amdgcn_sched_barrier(0)
    Unit cur, nxt; int ui = 0;
    if (!S.next(0, cur)) return;
    f32x4 acc[2][2][4][2];
#pragma unroll
    for (int a = 0; a < 2; ++a)
#pragma unroll
        for (int b = 0; b < 2; ++b)
#pragma unroll
            for (int m = 0; m < 4; ++m)
#pragma unroll
                for (int n = 0; n < 2; ++n) acc[a][b][m][n] = (f32x4){0.f, 0.f, 0.f, 0.f};
    bf16x8 At[4][2], B0[2][2], B1[2][2];
    const char* cA = (const char*)g.A + (GATHER ? (size_t)0 : (size_t)cur.pm * tstep); const char* cB = (const char*)g.Bt + (size_t)cur.pn * tstep;
    if constexpr (SP2) {
        PG8_STAGE(PG8_SB(0, 0), cB, voffB); PG8_STAGE(PG8_SB(0, 1), cB + hstep, voffB); PG8_STAGE(PG8_SA(0, 0), cA, voffA); PG8_STAGE(PG8_SA(0, 1), cA + hstepA, voffA1);
        if (wr == 1) PG8_BAR;
        PG8_WAIT_V(2); PG8_BAR;
        PG8_STAGE(PG8_SB(1, 0), cB + kstep, voffB); PG8_STAGE(PG8_SA(1, 0), cA + kstep, voffA); PG8_STAGE(PG8_SB(1, 1), cB + hstep + kstep, voffB);
        PG8_WAIT_V(6); PG8_BAR;
    } else {
        PG8_STAGE(PG8_SB(0, 0), cB, voffB); PG8_STAGE(PG8_SA(0, 0), cA, voffA); PG8_STAGE(PG8_SB(0, 1), cB + hstep, voffB); PG8_STAGE(PG8_SA(0, 1), cA + hstepA, voffA1);
        if (wr == 1) PG8_BAR;
        PG8_WAIT_V(4); PG8_BAR;
        PG8_STAGE(PG8_SB(1, 0), cB + kstep, voffB); PG8_STAGE(PG8_SA(1, 0), cA + kstep, voffA); PG8_STAGE(PG8_SB(1, 1), cB + hstep + kstep, voffB);
        PG8_WAIT_V(6); PG8_BAR;
    }
    for (;;) {
        const bool has_next = S.next(ui + 1, nxt);
        const char* nA = has_next ? (const char*)g.A + (GATHER ? (size_t)0 : (size_t)nxt.pm * tstep) : cA; const char* nB = has_next ? (const char*)g.Bt + (size_t)nxt.pn * tstep : cB;
        for (int t = 0; t < nt; t += 2) {
            const bool last = (t == nt - 2);
            const char* a1 = cA + (size_t)(t + 1) * kstep;
            const char* a2 = last ? nA : cA + (size_t)(t + 2) * kstep; const char* b2 = last ? nB : cB + (size_t)(t + 2) * kstep;
            const char* a3 = a2 + kstep; const char* b3 = b2 + kstep;
            if constexpr (SP2) {
            PG8_LDB(B0, 0, 0); PG8_LDB(B1, 0, 1); PG8_SCHED; PG8_LDA(At, 0, 0); PG8_STAGE(PG8_SA(1, 1), a1 + hstepA, voffA1);
            PG8_WAIT_V(8); PG8_WAIT_L(0); PG8_BAR; PG8_MMA(0, 0, At, B0); PG8_MMA(0, 1, At, B1); PG8_BAR; PG8_SCHED;
            PG8_LDA(At, 0, 1); PG8_STAGE(PG8_SB(0, 0), b2, voffB); PG8_STAGE(PG8_SB(0, 1), b2 + hstep, voffB); PG8_STAGE(PG8_SA(0, 0), a2, voffA);
            PG8_WAIT_V(8); PG8_WAIT_L(0); PG8_BAR; PG8_MMA(1, 0, At, B0); PG8_MMA(1, 1, At, B1); PG8_BAR; PG8_SCHED;
            PG8_LDB(B0, 1, 0); PG8_LDB(B1, 1, 1); PG8_SCHED; PG8_LDA(At, 1, 0); PG8_STAGE(PG8_SA(0, 1), a2 + hstepA, voffA1);
            PG8_WAIT_V(8); PG8_WAIT_L(0); PG8_BAR; PG8_MMA(0, 0, At, B0); PG8_MMA(0, 1, At, B1); PG8_BAR; PG8_SCHED;
            PG8_LDA(At, 1, 1); PG8_STAGE(PG8_SB(1, 0), b3, voffB); PG8_STAGE(PG8_SB(1, 1), b3 + hstep, voffB); PG8_STAGE(PG8_SA(1, 0), a3, voffA);
            PG8_WAIT_V(8); PG8_WAIT_L(0); PG8_BAR; PG8_MMA(1, 0, At, B0); PG8_MMA(1, 1, At, B1); PG8_BAR; PG8_SCHED;
            } else {
            PG8_LDB(B0, 0, 0); PG8_SCHED; PG8_LDA(At, 0, 0); PG8_STAGE(PG8_SA(1, 1), a1 + hstepA, voffA1);
            PG8_WAIT_L(8); PG8_BAR; PG8_WAIT_L(0); PG8_MMA(0, 0, At, B0); PG8_BAR; PG8_SCHED;
            PG8_LDB(B1, 0, 1); PG8_STAGE(PG8_SB(0, 0), b2, voffB);
            PG8_BAR; PG8_WAIT_L(0); PG8_MMA(0, 1, At, B1); PG8_BAR;
            PG8_LDA(At, 0, 1); PG8_STAGE(PG8_SA(0, 0), a2, voffA);
            PG8_BAR; PG8_WAIT_L(0); PG8_MMA(1, 0, At, B0); PG8_BAR; PG8_SCHED;
            PG8_STAGE(PG8_SB(0, 1), b2 + hstep, voffB);
            PG8_WAIT_V(6); PG8_BAR; PG8_MMA(1, 1, At, B1); PG8_BAR;
            PG8_LDB(B0, 1, 0); PG8_SCHED; PG8_LDA(At, 1, 0); PG8_STAGE(PG8_SA(0, 1), a2 + hstepA, voffA1);
            PG8_WAIT_L(8); PG8_BAR; PG8_WAIT_L(0); PG8_MMA(0, 0, At, B0); PG8_BAR; PG8_SCHED;
            PG8_LDB(B1, 1, 1); PG8_STAGE(PG8_SB(1, 0), b3, voffB);
            PG8_BAR; PG8_WAIT_L(0); PG8_MMA(0, 1, At, B1); PG8_BAR;
            PG8_LDA(At, 1, 1); PG8_STAGE(PG8_SA(1, 0), a3, voffA);
            PG8_BAR; PG8_WAIT_L(0); PG8_MMA(1, 0, At, B0); PG8_BAR; PG8_SCHED;
            PG8_STAGE(PG8_SB(1, 1), b3 + hstep, voffB);
            PG8_WAIT_V(6); PG8_BAR; PG8_MMA(1, 1, At, B1); PG8_BAR;
            }
        }
        if constexpr (ALIGN_EPI) { if (wr == 0) PG8_BAR; }
        E(acc, cur, wr, wc, fr, fq);
        if (!has_next) break;
#pragma unroll
        for (int a = 0; a < 2; ++a)
#pragma unroll
            for (int b = 0; b < 2; ++b)
#pragma unroll
                for (int m = 0; m < 4; ++m)
#pragma unroll
                    for (int n = 0; n < 2; ++n) acc[a][b][m][n] = (f32x4){0.f, 0.f, 0.f, 0.f};
        cur = nxt; cA = nA; cB = nB; ++ui;
        if constexpr (ALIGN_EPI) { if (wr == 1) PG8_BAR; }
    }
    PG8_WAIT_V(0);
    if constexpr (!ALIGN_EPI) { if (wr == 0) PG8_BAR; }
    PG8_BAR;
#undef PG8_SA
#undef PG8_SB
#undef PG8_STAGE
#undef PG8_LDA
#undef PG8_LDB
#undef PG8_MMA
#undef PG8_WAIT_V
#undef PG8_WAIT_L
#undef PG8_BAR
#undef PG8_SCHED
}

struct OrderIn {
    int G, c;
    __device__ __forceinline__ bool next(int i, Unit& u) const {
        constexpr int nM = M / BM, nN = NIN / BM, nwg = nM * nN, nctx = (MC / BM) * 12;
        const long L = (long)i * G + c;
        if (L >= nwg + nctx) return false;
        if (L >= nwg) { const int j = (int)L - nwg; u.pm = nM + j / 12; u.pn = 4 + j % 12; return true; }
        int wgid = (int)L; { const int q = nwg / NXCD, r = nwg % NXCD, xcd = wgid % NXCD, off = wgid / NXCD; wgid = (xcd < r ? xcd * (q + 1) : r * (q + 1) + (xcd - r) * q) + off; }
        const int nig = WGM * nN, gid = wgid / nig, fm = gid * WGM, gsz = (nM - fm) < WGM ? (nM - fm) : WGM;
        u.pm = fm + ((wgid % nig) % gsz); u.pn = (wgid % nig) / gsz; return true;
    }
};
struct OrderRow {
    int pm, nN;
    __device__ __forceinline__ bool next(int i, Unit& u) const { if (i >= nN) return false; u.pm = pm; u.pn = i; return true; }
};

struct EpiIn {
    static constexpr bool PERM = true;
    bf16 *Q, *V, *GF, *GB, *OG, *P, *GA, *GBT; const float* lb;
    __device__ __forceinline__ void operator()(const f32x4 (&acc)[2][2][4][2], const Unit& u, int wr, int wc, int fr, int fq) const {
        const int pn = u.pn; int kind, colt, ldc = D; bf16* base; const float* lbp = lb;
        if (pn < 4)       { kind = 1; base = Q;   colt = pn * 256; }
        else if (pn < 8)  { kind = 0; base = V;   colt = (pn - 4) * 256; }
        else if (pn < 12) { kind = 3; base = GF;  colt = (pn - 8) * 256; }
        else if (pn < 16) { kind = 3; base = GB;  colt = (pn - 12) * 256; lbp = lb + 1024; }
        else if (pn < 20) { kind = 1; base = OG;  colt = (pn - 16) * 256; }
        else if (pn < 22) { kind = 0; base = P;   colt = (pn - 20) * 256; ldc = PW; }
        else if (pn < 26) { kind = 2; base = GA;  colt = (pn - 22) * 256; }
        else              { kind = 2; base = GBT; colt = (pn - 26) * 256; }
        const int row0 = u.pm * BM + wr * 64 + fr, col0 = colt + wc * 32 + 8 * fq;
        f32x4 l0[2], l1[2];
        if (kind == 3) {
#pragma unroll
            for (int bj = 0; bj < 2; ++bj) { l0[bj] = *(const f32x4*)(lbp + col0 + bj * HALF); l1[bj] = *(const f32x4*)(lbp + col0 + bj * HALF + 4); }
        }
#pragma unroll
        for (int ai = 0; ai < 2; ++ai)
#pragma unroll
            for (int m = 0; m < 4; ++m) { bf16* rowp = base + (size_t)(row0 + ai * HALF + m * 16) * ldc + col0;
#pragma unroll
                for (int bj = 0; bj < 2; ++bj) { f32x4 v0 = acc[ai][bj][m][0], v1 = acc[ai][bj][m][1]; u32x4 w;
                    if (kind == 3) {
#pragma unroll
                        for (int j = 0; j < 4; ++j) { v0[j] = __log2f(l0[bj][j] + (1.0f - l0[bj][j]) * sigmoidf_(v0[j])); v1[j] = __log2f(l1[bj][j] + (1.0f - l1[bj][j]) * sigmoidf_(v1[j])); }
                        w.x = pkh2(v0[0], v0[1]); w.y = pkh2(v0[2], v0[3]); w.z = pkh2(v1[0], v1[1]); w.w = pkh2(v1[2], v1[3]);
                    } else {
                        if (kind == 1) {
#pragma unroll
                            for (int j = 0; j < 4; ++j) { v0[j] = siluf_(v0[j]); v1[j] = siluf_(v1[j]); }
                        } else if (kind == 2) {
#pragma unroll
                            for (int j = 0; j < 4; ++j) { v0[j] = sigmoidf_(v0[j]); v1[j] = sigmoidf_(v1[j]); }
                        }
                        w.x = cvt_pk_bf16(v0[0], v0[1]); w.y = cvt_pk_bf16(v0[2], v0[3]); w.z = cvt_pk_bf16(v1[0], v1[1]); w.w = cvt_pk_bf16(v1[2], v1[3]);
                    }
                    *(u32x4*)(rowp + bj * HALF) = w; } }
    }
};
struct EpiGateA {
    static constexpr bool PERM = true;
    bf16* GA;
    __device__ __forceinline__ void operator()(const f32x4 (&acc)[2][2][4][2], const Unit& u, int wr, int wc, int fr, int fq) const {
        const int row0 = u.pm * BM + wr * 64 + fr, col0 = u.pn * BM + wc * 32 + 8 * fq;
#pragma unroll
        for (int ai = 0; ai < 2; ++ai)
#pragma unroll
            for (int m = 0; m < 4; ++m) { bf16* rowp = GA + (size_t)(row0 + ai * HALF + m * 16) * D + col0;
#pragma unroll
                for (int bj = 0; bj < 2; ++bj) { const f32x4 v0 = acc[ai][bj][m][0], v1 = acc[ai][bj][m][1]; const u32x4 gw = *(const u32x4*)(rowp + bj * HALF); u32x4 w;
                    w.x = cvt_pk_bf16(v0[0] * bflo(gw.x), v0[1] * bfhi(gw.x)); w.y = cvt_pk_bf16(v0[2] * bflo(gw.y), v0[3] * bfhi(gw.y));
                    w.z = cvt_pk_bf16(v1[0] * bflo(gw.z), v1[1] * bfhi(gw.z)); w.w = cvt_pk_bf16(v1[2] * bflo(gw.w), v1[3] * bfhi(gw.w));
                    *(u32x4*)(rowp + bj * HALF) = w; }
                if (m & 1) asm volatile("" ::: "memory"); }
    }
};
struct EpiGateB {
    static constexpr bool PERM = true;
    const bf16* T; bf16* GBT;
    __device__ __forceinline__ void operator()(const f32x4 (&acc)[2][2][4][2], const Unit& u, int wr, int wc, int fr, int fq) const {
        const int row0 = u.pm * BM + wr * 64 + fr, col0 = u.pn * BM + wc * 32 + 8 * fq;
#pragma unroll
        for (int ai = 0; ai < 2; ++ai)
#pragma unroll
            for (int m = 0; m < 4; ++m) { const size_t off = (size_t)(row0 + ai * HALF + m * 16) * D + col0;
#pragma unroll
                for (int bj = 0; bj < 2; ++bj) { const f32x4 v0 = acc[ai][bj][m][0], v1 = acc[ai][bj][m][1];
                    const u32x4 gw = *(const u32x4*)(GBT + off + bj * HALF), tw = *(const u32x4*)(T + off + bj * HALF); u32x4 w;
                    w.x = cvt_pk_bf16(bflo(tw.x) + v0[0] * bflo(gw.x), bfhi(tw.x) + v0[1] * bfhi(gw.x)); w.y = cvt_pk_bf16(bflo(tw.y) + v0[2] * bflo(gw.y), bfhi(tw.y) + v0[3] * bfhi(gw.y));
                    w.z = cvt_pk_bf16(bflo(tw.z) + v1[0] * bflo(gw.z), bfhi(tw.z) + v1[1] * bfhi(gw.z)); w.w = cvt_pk_bf16(bflo(tw.w) + v1[2] * bflo(gw.w), bfhi(tw.w) + v1[3] * bfhi(gw.w));
                    *(u32x4*)(GBT + off + bj * HALF) = w; }
                asm volatile("" ::: "memory"); }
    }
};
struct EpiResid {
    static constexpr bool PERM = false;
    const float* X; float* O; const float* g1;
    __device__ __forceinline__ void operator()(const f32x4 (&acc)[2][2][4][2], const Unit& u, int wr, int wc, int fr, int fq) const {
        const int row0 = u.pm * BM + wr * 64 + fr, col0 = u.pn * BM + wc * 32 + 4 * fq;
        f32x4 gv[2][2];
#pragma unroll
        for (int bj = 0; bj < 2; ++bj)
#pragma unroll
            for (int n = 0; n < 2; ++n) gv[bj][n] = *(const f32x4*)(g1 + col0 + bj * HALF + n * 16);
#pragma unroll
        for (int ai = 0; ai < 2; ++ai)
#pragma unroll
            for (int m = 0; m < 4; ++m) { const size_t off = (size_t)(row0 + ai * HALF + m * 16) * D + col0;
#pragma unroll
                for (int bj = 0; bj < 2; ++bj)
#pragma unroll
                    for (int n = 0; n < 2; ++n) { const f32x4 xv = *(const f32x4*)(X + off + bj * HALF + n * 16); *(f32x4*)(O + off + bj * HALF + n * 16) = xv + gv[bj][n] * acc[ai][bj][m][n]; }
                asm volatile("" ::: "memory"); }
    }
};
struct EpiHid {
    static constexpr bool PERM = true;
    bf16* H;
    __device__ __forceinline__ void operator()(const f32x4 (&acc)[2][2][4][2], const Unit& u, int wr, int wc, int fr, int fq) const {
        const int row0 = wr * 64 + fr, col0 = u.pn * HALF + wc * 32 + 8 * fq;
#pragma unroll
        for (int ai = 0; ai < 2; ++ai)
#pragma unroll
            for (int m = 0; m < 4; ++m) { bf16* rowp = H + (size_t)(row0 + ai * HALF + m * 16) * FF + col0;
                const f32x4 g0 = acc[ai][0][m][0], g1 = acc[ai][0][m][1], u0 = acc[ai][1][m][0], u1 = acc[ai][1][m][1]; u32x4 w;
                w.x = cvt_pk_bf16(siluf_(g0[0]) * u0[0], siluf_(g0[1]) * u0[1]); w.y = cvt_pk_bf16(siluf_(g0[2]) * u0[2], siluf_(g0[3]) * u0[3]);
                w.z = cvt_pk_bf16(siluf_(g1[0]) * u1[0], siluf_(g1[1]) * u1[1]); w.w = cvt_pk_bf16(siluf_(g1[2]) * u1[2], siluf_(g1[3]) * u1[3]);
                *(u32x4*)rowp = w; }
    }
};
struct EpiDown {
    static constexpr bool PERM = true;
    bf16* Y; const float* vals;
    __device__ __forceinline__ void operator()(const f32x4 (&acc)[2][2][4][2], const Unit& u, int wr, int wc, int fr, int fq) const {
        const int row0 = wr * 64 + fr, col0 = u.pn * BM + wc * 32 + 8 * fq;
#pragma unroll
        for (int ai = 0; ai < 2; ++ai)
#pragma unroll
            for (int m = 0; m < 4; ++m) { const int r = row0 + ai * HALF + m * 16; const float s = vals[r]; bf16* rowp = Y + (size_t)r * D + col0;
#pragma unroll
                for (int bj = 0; bj < 2; ++bj) { const f32x4 v0 = acc[ai][bj][m][0] * s, v1 = acc[ai][bj][m][1] * s; u32x4 w;
                    w.x = cvt_pk_bf16(v0[0], v0[1]); w.y = cvt_pk_bf16(v0[2], v0[3]); w.z = cvt_pk_bf16(v1[0], v1[1]); w.w = cvt_pk_bf16(v1[2], v1[3]);
                    *(u32x4*)(rowp + bj * HALF) = w; } }
    }
};
}

constexpr int RING_BYTES = 131072;
constexpr int LDS_BYTES = 147456;

struct Args {
    const float* in[21]; float* out; unsigned char* ws; int ph_lo, ph_hi;
};

__device__ __forceinline__ void transpose_item(const float* W, int K, int N, bf16* WT, int k0, int n0, int drow0, LAS float* scr, int lane) {
#pragma unroll 8
    for (int i = 0; i < 32; ++i) { const int kk = 2 * i + (lane >> 5); scr[kk * 33 + (lane & 31)] = W[(size_t)(k0 + kk) * N + n0 + (lane & 31)]; }
    LDS_WAIT(); asm volatile("" ::: "memory");
    const int c = lane & 7;
#pragma unroll
    for (int j = 0; j < 4; ++j) { const int n = (lane >> 3) + 8 * j; const LAS float* s = scr + (8 * c) * 33 + n;
        v4u o; o.x = pk2(s[0 * 33], s[1 * 33]); o.y = pk2(s[2 * 33], s[3 * 33]); o.z = pk2(s[4 * 33], s[5 * 33]); o.w = pk2(s[6 * 33], s[7 * 33]);
        *(v4u*)(WT + (size_t)(drow0 + n) * K + k0 + 8 * c) = o; }
    LDS_WAIT(); asm volatile("" ::: "memory");
}


typedef _Float16 half8 __attribute__((ext_vector_type(8)));
struct RawChunk { half8 gA0, gA1; v2u q4[4], g4[4]; v4u v16; };
constexpr int P3_QP = 272, P3_SP = 144;
constexpr int P3_QT = 0, P3_KT = 17408, P3_KTT = 34816, P3_VT = 53248, P3_AM = 62464, P3_SB = 71680;
constexpr int P3_NCH = (CTXL + SEQ) / 64;

__device__ __forceinline__ void p3_load(RawChunk& R, int c, int b, int h, int vh, int dir, int w, int fr, int fq, int lane, const bf16* Qp, const bf16* Vp, const bf16* Gp) {
    if (c >= P3_NCH) return;
    long rbase; const int rstep = dir ? -1 : 1;
    if (c < 4) rbase = (long)M + b * CTXL + (dir ? CTXL - 1 - 64 * c : 64 * c); else rbase = (long)b * SEQ + (dir ? SEQ - 1 - 64 * (c - 4) : 64 * (c - 4));
    const unsigned short* ga = (const unsigned short*)Gp + h * HD + 16 * w + fr;
#pragma unroll
    for (int j = 0; j < 8; ++j) { R.gA0[j] = __builtin_bit_cast(_Float16, ga[(rbase + rstep * (8 * fq + j)) * D]); R.gA1[j] = __builtin_bit_cast(_Float16, ga[(rbase + rstep * (32 + 8 * fq + j)) * D]); }
    const int colq = h * HD + 16 * w + 4 * fq;
#pragma unroll
    for (int tt = 0; tt < 4; ++tt) { const long row = rbase + rstep * (16 * tt + fr);
        R.g4[tt] = *(const v2u*)(Gp + row * D + colq);
        if (c >= 4) R.q4[tt] = *(const v2u*)(Qp + row * D + colq); else R.q4[tt] = (v2u){0u, 0u}; }
    R.v16 = *(const v4u*)(Vp + (rbase + rstep * lane) * D + h * HD + vh * 64 + 8 * w);
}

__device__ __forceinline__ void p3_chunk(LAS unsigned char* lds, const RawChunk& R, int c, f32x4 (&Sacc)[4], float (&bend_prev)[4], const half8& Bm0, const half8& Bm1, const half8& Bone,
                                         int b, int h, int vh, int dir, int w, int fr, int fq, int lane, bf16* Op) {
    const bool isx = c >= 4;
    f32x4 bacc[4]; const f32x4 z4 = (f32x4){0.f, 0.f, 0.f, 0.f};
    bacc[0] = __builtin_amdgcn_mfma_f32_16x16x32_f16(R.gA0, Bm0, z4, 0, 0, 0);
    bacc[1] = __builtin_amdgcn_mfma_f32_16x16x32_f16(R.gA0, Bm1, z4, 0, 0, 0);
    bacc[2] = __builtin_amdgcn_mfma_f32_16x16x32_f16(R.gA0, Bone, z4, 0, 0, 0); bacc[2] = __builtin_amdgcn_mfma_f32_16x16x32_f16(R.gA1, Bm0, bacc[2], 0, 0, 0);
    bacc[3] = __builtin_amdgcn_mfma_f32_16x16x32_f16(R.gA0, Bone, z4, 0, 0, 0); bacc[3] = __builtin_amdgcn_mfma_f32_16x16x32_f16(R.gA1, Bm1, bacc[3], 0, 0, 0);
    const int src15 = (lane & 48) | 15;
    float br[4], scale[4];
#pragma unroll
    for (int i = 0; i < 4; ++i) { br[i] = __shfl(bacc[1][i], src15); const float be = __shfl(bacc[3][i], src15); scale[i] = __builtin_amdgcn_exp2f(bend_prev[i] + br[i]); bend_prev[i] = be - br[i]; }
#pragma unroll
    for (int vt = 0; vt < 4; ++vt) {
#pragma unroll
        for (int i = 0; i < 4; ++i) Sacc[vt][i] *= scale[i];
        if (isx) { v2u o; o.x = pk2(Sacc[vt][0], Sacc[vt][1]); o.y = pk2(Sacc[vt][2], Sacc[vt][3]); *(LAS v2u*)(lds + P3_SB + (16 * vt + fr) * P3_QP + (16 * w + 4 * fq) * 2) = o; }
    }
#pragma unroll
    for (int tt = 0; tt < 4; ++tt) {
        const unsigned gw[2] = {R.g4[tt].x, R.g4[tt].y}, qw[2] = {R.q4[tt].x, R.q4[tt].y};
        float qt[4], kt[4];
#pragma unroll
        for (int i = 0; i < 4; ++i) {
            const float g = h2f((unsigned short)(gw[i >> 1] >> (16 * (i & 1)))), q = (i & 1) ? bfhi(qw[i >> 1]) : bflo(qw[i >> 1]);
            const float f = __builtin_amdgcn_exp2f(g), beta = bacc[tt][i] - br[i];
            qt[i] = q * __builtin_amdgcn_exp2f(beta); kt[i] = (1.0f - f) * __builtin_amdgcn_exp2f(-beta);
        }
        const int t = 16 * tt + fr;
        unsigned short kb[4];
#pragma unroll
        for (int i = 0; i < 4; ++i) kb[i] = (unsigned short)f2bf(kt[i]);
        if (isx) {
            v2u o; o.x = pk2(qt[0], qt[1]); o.y = pk2(qt[2], qt[3]); *(LAS v2u*)(lds + P3_QT + t * P3_QP + (16 * w + 4 * fq) * 2) = o;
            v2u k2; k2.x = (unsigned)kb[0] | ((unsigned)kb[1] << 16); k2.y = (unsigned)kb[2] | ((unsigned)kb[3] << 16); *(LAS v2u*)(lds + P3_KT + t * P3_QP + (16 * w + 4 * fq) * 2) = k2;
        }
#pragma unroll
        for (int i = 0; i < 4; ++i) *(LAS unsigned short*)(lds + P3_KTT + (16 * w + 4 * fq + i) * P3_SP + t * 2) = kb[i];
    }
    {
        const unsigned vw[4] = {R.v16.x, R.v16.y, R.v16.z, R.v16.w};
#pragma unroll
        for (int j = 0; j < 8; ++j) *(LAS unsigned short*)(lds + P3_VT + (8 * w + j) * P3_SP + lane * 2) = (unsigned short)(vw[j >> 1] >> (16 * (j & 1)));
    }
    LDS_WAIT(); __syncthreads();
    if (isx) {
        const int tt = w >> 1;
        bf16x8 qf[4];
#pragma unroll
        for (int ks = 0; ks < 4; ++ks) qf[ks] = *(const LAS bf16x8*)(lds + P3_QT + (16 * tt + fr) * P3_QP + (32 * ks + 8 * fq) * 2);
#pragma unroll
        for (int k2 = 0; k2 < 2; ++k2) {
            const int st = 2 * (w & 1) + k2;
            f32x4 sc = (f32x4){0.f, 0.f, 0.f, 0.f};
            if (st <= tt) {
#pragma unroll
                for (int ks = 0; ks < 4; ++ks) { const bf16x8 kf = *(const LAS bf16x8*)(lds + P3_KT + (16 * st + fr) * P3_QP + (32 * ks + 8 * fq) * 2);
                    sc = __builtin_amdgcn_mfma_f32_16x16x32_bf16(kf, qf[ks], sc, 0, 0, 0); }
                const int tpos = 16 * tt + fr, s0 = 16 * st + 4 * fq;
#pragma unroll
                for (int i = 0; i < 4; ++i) if (s0 + i > tpos) sc[i] = 0.f;
            }
            v2u o; o.x = pk2(sc[0], sc[1]); o.y = pk2(sc[2], sc[3]);
            *(LAS v2u*)(lds + P3_AM + (16 * tt + fr) * P3_SP + (16 * st + 4 * fq) * 2) = o;
        }
    }
    f32x4 oacc[2]; oacc[0] = (f32x4){0.f, 0.f, 0.f, 0.f}; oacc[1] = oacc[0];
    const int vto = w & 3, tt0 = 2 * (w >> 2);
    if (isx) {
#pragma unroll
        for (int ks = 0; ks < 4; ++ks) { const bf16x8 sf = *(const LAS bf16x8*)(lds + P3_SB + (16 * vto + fr) * P3_QP + (32 * ks + 8 * fq) * 2);
#pragma unroll
            for (int k2 = 0; k2 < 2; ++k2) { const bf16x8 qf = *(const LAS bf16x8*)(lds + P3_QT + (16 * (tt0 + k2) + fr) * P3_QP + (32 * ks + 8 * fq) * 2);
                oacc[k2] = __builtin_amdgcn_mfma_f32_16x16x32_bf16(sf, qf, oacc[k2], 0, 0, 0); } }
    }
    {
        bf16x8 kf[2];
#pragma unroll
        for (int ks = 0; ks < 2; ++ks) kf[ks] = *(const LAS bf16x8*)(lds + P3_KTT + (16 * w + fr) * P3_SP + (32 * ks + 8 * fq) * 2);
#pragma unroll
        for (int vt = 0; vt < 4; ++vt)
#pragma unroll
            for (int ks = 0; ks < 2; ++ks) { const bf16x8 vf = *(const LAS bf16x8*)(lds + P3_VT + (16 * vt + fr) * P3_SP + (32 * ks + 8 * fq) * 2);
                Sacc[vt] = __builtin_amdgcn_mfma_f32_16x16x32_bf16(kf[ks], vf, Sacc[vt], 0, 0, 0); }
    }
    if (isx) {
        LDS_WAIT(); __syncthreads();
#pragma unroll
        for (int ks = 0; ks < 2; ++ks) { const bf16x8 vf = *(const LAS bf16x8*)(lds + P3_VT + (16 * vto + fr) * P3_SP + (32 * ks + 8 * fq) * 2);
#pragma unroll
            for (int k2 = 0; k2 < 2; ++k2) { const bf16x8 af = *(const LAS bf16x8*)(lds + P3_AM + (16 * (tt0 + k2) + fr) * P3_SP + (32 * ks + 8 * fq) * 2);
                oacc[k2] = __builtin_amdgcn_mfma_f32_16x16x32_bf16(vf, af, oacc[k2], 0, 0, 0); } }
        const long xb = (long)b * SEQ + (dir ? SEQ - 1 - 64 * (c - 4) : 64 * (c - 4)); const int rstep = dir ? -1 : 1;
#pragma unroll
        for (int k2 = 0; k2 < 2; ++k2) { const long row = xb + rstep * (16 * (tt0 + k2) + fr);
            v2u o; o.x = pk2(oacc[k2][0], oacc[k2][1]); o.y = pk2(oacc[k2][2], oacc[k2][3]);
            *(v2u*)(Op + row * D + h * HD + vh * 64 + 16 * vto + 4 * fq) = o; }
    }
    LDS_WAIT(); __syncthreads();
}

__device__ __forceinline__ void p3_unit(LAS unsigned char* lds, int unit, const bf16* QB, const bf16* VB, const bf16* GF, const bf16* GBK, bf16* OF, bf16* OB, int tid) {
    asm volatile("" : "+v"(tid));
    const int lane = tid & 63, w = __builtin_amdgcn_readfirstlane(tid >> 6), fr = lane & 15, fq = lane >> 4;
    const int vh = unit & 1, dir = (unit >> 1) & 1, h = (unit >> 2) & 7, b = unit >> 5;
    const bf16* Gp = dir ? GBK : GF; bf16* Op = dir ? OB : OF;
    half8 Bm0, Bm1, Bone;
#pragma unroll
    for (int j = 0; j < 8; ++j) { Bm0[j] = (8 * fq + j <= fr) ? (_Float16)1.0f : (_Float16)0.0f; Bm1[j] = (8 * fq + j <= 16 + fr) ? (_Float16)1.0f : (_Float16)0.0f; Bone[j] = (_Float16)1.0f; }
    f32x4 Sacc[4]; float bend_prev[4];
#pragma unroll
    for (int i = 0; i < 4; ++i) { Sacc[i] = (f32x4){0.f, 0.f, 0.f, 0.f}; bend_prev[i] = 0.f; }
    RawChunk RA, RB, RC;
    p3_load(RA, 0, b, h, vh, dir, w, fr, fq, lane, QB, VB, Gp);
    p3_load(RB, 1, b, h, vh, dir, w, fr, fq, lane, QB, VB, Gp);
#pragma unroll 1
    for (int c = 0; c < P3_NCH; c += 3) {
        p3_load(RC, c + 2, b, h, vh, dir, w, fr, fq, lane, QB, VB, Gp);
        p3_chunk(lds, RA, c, Sacc, bend_prev, Bm0, Bm1, Bone, b, h, vh, dir, w, fr, fq, lane, Op);
        p3_load(RA, c + 3, b, h, vh, dir, w, fr, fq, lane, QB, VB, Gp);
        p3_chunk(lds, RB, c + 1, Sacc, bend_prev, Bm0, Bm1, Bone, b, h, vh, dir, w, fr, fq, lane, Op);
        p3_load(RB, c + 4, b, h, vh, dir, w, fr, fq, lane, QB, VB, Gp);
        p3_chunk(lds, RC, c + 2, Sacc, bend_prev, Bm0, Bm1, Bone, b, h, vh, dir, w, fr, fq, lane, Op);
    }
}

__device__ __forceinline__ void p4_build_aa(int slab, const bf16* OF, const bf16* OB, const bf16* OG, const float* hgrn_g, bf16* AA, int tid) {
    asm volatile("" : "+v"(tid));
    const int lane = tid & 63, wave = __builtin_amdgcn_readfirstlane(tid >> 6), row0 = slab * 256;
    float hg[16];
#pragma unroll
    for (int i = 0; i < 4; ++i) { const f32x4 t = *(const f32x4*)(hgrn_g + 16 * (lane & 7) + 4 * i); hg[4 * i] = t.x; hg[4 * i + 1] = t.y; hg[4 * i + 2] = t.z; hg[4 * i + 3] = t.w; }
    for (int r = wave * 32; r < wave * 32 + 32; ++r) {
        const size_t off = (size_t)(row0 + r) * D + 16 * lane;
        const v4u f0 = *(const v4u*)(OF + off), f1 = *(const v4u*)(OF + off + 8), b0 = *(const v4u*)(OB + off), b1 = *(const v4u*)(OB + off + 8);
        const v4u g0 = *(const v4u*)(OG + off), g1 = *(const v4u*)(OG + off + 8);
        float o[16], gg[16];
        const unsigned fw[8] = {f0.x, f0.y, f0.z, f0.w, f1.x, f1.y, f1.z, f1.w}, bw[8] = {b0.x, b0.y, b0.z, b0.w, b1.x, b1.y, b1.z, b1.w}, gw8[8] = {g0.x, g0.y, g0.z, g0.w, g1.x, g1.y, g1.z, g1.w};
        float ss = 0.f;
#pragma unroll
        for (int i = 0; i < 8; ++i) { o[2 * i] = bflo(fw[i]) + bflo(bw[i]); o[2 * i + 1] = bfhi(fw[i]) + bfhi(bw[i]); gg[2 * i] = bflo(gw8[i]); gg[2 * i + 1] = bfhi(gw8[i]); ss += o[2 * i] * o[2 * i] + o[2 * i + 1] * o[2 * i + 1]; }
        ss += __shfl_xor(ss, 1); ss += __shfl_xor(ss, 2); ss += __shfl_xor(ss, 4);
        const float rstd = rsqrtf(ss * (1.0f / HD) + EPS);
        unsigned w[8];
#pragma unroll
        for (int i = 0; i < 8; ++i) w[i] = pk2((o[2 * i] * rstd * hg[2 * i]) * gg[2 * i], (o[2 * i + 1] * rstd * hg[2 * i + 1]) * gg[2 * i + 1]);
        *(v4u*)(AA + off) = (v4u){w[0], w[1], w[2], w[3]}; *(v4u*)(AA + off + 8) = (v4u){w[4], w[5], w[6], w[7]};
    }
}
__device__ __forceinline__ void p4_pool(LAS unsigned char* lds, int slab, const bf16* PB, bf16* RB, int tid) {
    asm volatile("" : "+v"(tid));
    LAS float* T = (LAS float*)lds; constexpr int TP = 68;
    const int b = slab / 32, row0 = slab * 256, gr0 = 4 * (slab % 32);
#pragma unroll 1
    for (int jh = 0; jh < 8; ++jh) {
        const int j = jh >> 1, hh = jh & 1, w = 2 << j, chb = j * 128 + hh * 64;
        { const int q = tid & 1, cc = (tid >> 1) & 63, r = tid >> 7; const int R = gr0 + r;
          int R0 = R - w / 2; R0 = R0 < 0 ? 0 : R0; int R1 = R + w / 2 - 1; R1 = (R1 > GRID_H - 1 ? GRID_H - 1 : R1) + 1;
          float a[32];
#pragma unroll
          for (int i = 0; i < 32; ++i) a[i] = 0.f;
#pragma unroll 1
          for (int rr = R0; rr < R1; ++rr) { const bf16* src = PB + ((size_t)b * SEQ + rr * GRID_W + cc) * PW + chb + q * 32;
#pragma unroll
              for (int k = 0; k < 4; ++k) { const v4u u = *(const v4u*)(src + 8 * k); a[8 * k + 0] += bflo(u.x); a[8 * k + 1] += bfhi(u.x); a[8 * k + 2] += bflo(u.y); a[8 * k + 3] += bfhi(u.y);
                  a[8 * k + 4] += bflo(u.z); a[8 * k + 5] += bfhi(u.z); a[8 * k + 6] += bflo(u.w); a[8 * k + 7] += bfhi(u.w); } }
          LAS float* dst = T + (r * 64 + cc) * TP + q * 32;
#pragma unroll
          for (int k = 0; k < 8; ++k) *(LAS f32x4*)(dst + 4 * k) = (f32x4){a[4 * k], a[4 * k + 1], a[4 * k + 2], a[4 * k + 3]}; }
        __syncthreads();
        { const int q = tid & 1, tl = tid >> 1, r = tl >> 6, cc = tl & 63; const int R = gr0 + r;
          int R0 = R - w / 2; R0 = R0 < 0 ? 0 : R0; int R1 = R + w / 2 - 1; R1 = (R1 > GRID_H - 1 ? GRID_H - 1 : R1) + 1;
          int C0 = cc - w / 2; C0 = C0 < 0 ? 0 : C0; int C1 = cc + w / 2 - 1; C1 = (C1 > GRID_W - 1 ? GRID_W - 1 : C1) + 1;
          const float inv = 1.0f / (float)((R1 - R0) * (C1 - C0));
          float s[32];
#pragma unroll
          for (int i = 0; i < 32; ++i) s[i] = 0.f;
#pragma unroll 1
          for (int c2 = C0; c2 < C1; ++c2) { const LAS float* src = T + (r * 64 + c2) * TP + q * 32;
#pragma unroll
              for (int k = 0; k < 8; ++k) { const f32x4 t4 = *(const LAS f32x4*)(src + 4 * k); s[4 * k] += t4.x; s[4 * k + 1] += t4.y; s[4 * k + 2] += t4.z; s[4 * k + 3] += t4.w; } }
          const size_t po = (size_t)(row0 + tl) * PW + chb + q * 32;
#pragma unroll
          for (int k = 0; k < 4; ++k) { const v4u u = *(const v4u*)(PB + po + 8 * k); v4u o;
              o.x = pk2(s[8 * k + 0] * inv - bflo(u.x), s[8 * k + 1] * inv - bfhi(u.x)); o.y = pk2(s[8 * k + 2] * inv - bflo(u.y), s[8 * k + 3] * inv - bfhi(u.y));
              o.z = pk2(s[8 * k + 4] * inv - bflo(u.z), s[8 * k + 5] * inv - bfhi(u.z)); o.w = pk2(s[8 * k + 6] * inv - bflo(u.w), s[8 * k + 7] * inv - bfhi(u.w));
              *(v4u*)(RB + po + 8 * k) = o; } }
        __syncthreads();
    }
}
__device__ __forceinline__ void p4_rows(LAS unsigned char* lds, int slab, const float* NEWHX, const float* modb, const float* norm2_g, const float* w_router, bf16* VX, float* PROBS, int tid) {
    asm volatile("" : "+v"(tid));
    const int lane = tid & 63, wave = __builtin_amdgcn_readfirstlane(tid >> 6), row0 = slab * 256;
    LAS float* W2 = (LAS float*)lds;
    LAS float* rstd_s = W2 + D * NE;
    LAS float* bias_s = rstd_s + 256;
    const float* sh2 = modb + 3 * D; const float* sc2 = modb + 4 * D;
    for (int e4 = tid; e4 < D * NE; e4 += NTHR) { const int c = e4 >> 4, e = e4 & 15;
        W2[(((c >> 4) * 4 + ((c >> 2) & 3)) * 16 + e) * 4 + (c & 3)] = norm2_g[c] * (1.0f + sc2[c]) * w_router[e4]; }
    { const int e = tid & 15, part = tid >> 4; float a = 0.f;
      for (int c = part * 32; c < part * 32 + 32; ++c) a += sh2[c] * w_router[c * NE + e];
      bias_s[e * 32 + part] = a; }
#pragma unroll 1
    for (int r = wave * 32; r < wave * 32 + 32; ++r) {
        const int row = row0 + r; const float* src = NEWHX + (size_t)row * D;
        f32x4 v[4]; float ss = 0.f;
#pragma unroll
        for (int j = 0; j < 4; ++j) { v[j] = *(const f32x4*)(src + 4 * lane + 256 * j); ss += (v[j].x * v[j].x + v[j].y * v[j].y) + (v[j].z * v[j].z + v[j].w * v[j].w); }
        const float rstd = rsqrtf(wave_sum(ss) * (1.0f / D) + EPS);
        if (lane == 0) rstd_s[r] = rstd;
#pragma unroll
        for (int j = 0; j < 4; ++j) { const int c = 4 * lane + 256 * j; const f32x4 g = *(const f32x4*)(norm2_g + c), sc = *(const f32x4*)(sc2 + c), sh = *(const f32x4*)(sh2 + c);
            const f32x4 o = (v[j] * rstd * g) * (sc + 1.0f) + sh;
            v2u w; w.x = pk2(o.x, o.y); w.y = pk2(o.z, o.w); *(v2u*)(VX + (size_t)row * D + c) = w; }
    }
    __syncthreads();
    if (tid < 16) { float a = 0.f; for (int p = 0; p < 32; ++p) a += bias_s[tid * 32 + p]; bias_s[512 + tid] = a; }
    __syncthreads();
    const int fr = lane & 15, fq = lane >> 4;
#pragma unroll 1
    for (int grp = wave * 2; grp < wave * 2 + 2; ++grp) {
        const float* arow = NEWHX + (size_t)(row0 + grp * 16 + fr) * D + 4 * fq;
        f32x4 acc = (f32x4){0.f, 0.f, 0.f, 0.f};
#pragma unroll 4
        for (int s = 0; s < 64; ++s) { const f32x4 a = *(const f32x4*)(arow + 16 * s); const f32x4 w = *(const LAS f32x4*)(W2 + ((s * 4 + fq) * 16 + fr) * 4);
            acc = __builtin_amdgcn_mfma_f32_16x16x4f32(a.x, w.x, acc, 0, 0, 0); acc = __builtin_amdgcn_mfma_f32_16x16x4f32(a.y, w.y, acc, 0, 0, 0);
            acc = __builtin_amdgcn_mfma_f32_16x16x4f32(a.z, w.z, acc, 0, 0, 0); acc = __builtin_amdgcn_mfma_f32_16x16x4f32(a.w, w.w, acc, 0, 0, 0); }
        const float be = bias_s[512 + fr];
#pragma unroll
        for (int i = 0; i < 4; ++i) { const int r = grp * 16 + 4 * fq + i; float lg = acc[i] * rstd_s[r] + be;
            float mx = lg; mx = fmaxf(mx, __shfl_xor(mx, 1)); mx = fmaxf(mx, __shfl_xor(mx, 2)); mx = fmaxf(mx, __shfl_xor(mx, 4)); mx = fmaxf(mx, __shfl_xor(mx, 8));
            const float ex = __expf(lg - mx); float sm = ex; sm += __shfl_xor(sm, 1); sm += __shfl_xor(sm, 2); sm += __shfl_xor(sm, 4); sm += __shfl_xor(sm, 8);
            PROBS[(size_t)(row0 + r) * NE + fr] = ex / sm; }
    }
    __syncthreads();
}

__global__ void __launch_bounds__(NTHR) mega(Args args) {
    extern __shared__ __attribute__((aligned(16))) unsigned char lds_raw[];
    LAS unsigned char* lds = (LAS unsigned char*)lds_raw;
    const int tid = threadIdx.x, lane = tid & 63, wave = __builtin_amdgcn_readfirstlane(tid >> 6);
    const int G = gridDim.x, bx = blockIdx.x;
    const int vcu = (G % 8 == 0) ? (bx % 8) * (G / 8) + bx / 8 : bx;
    const int gw = vcu * NWAVES + wave, NGW = G * NWAVES;
    unsigned char* ws = args.ws; unsigned char* dout = (unsigned char*)args.out;
    const float* x = args.in[0]; const float* cvec = args.in[1]; const float* ctx = args.in[2]; const float* c_ctx = args.in[3];
    const float* lb_logits = args.in[4]; const float* w_mod = args.in[5]; const float* b_mod = args.in[6]; const float* norm1_g = args.in[7];
    const float* w_in = args.in[8]; const float* hgrn_g = args.in[9]; const float* w_a = args.in[10]; const float* w_pool = args.in[11];
    const float* pool_scale = args.in[12]; const float* w_b = args.in[13]; const float* w_out = args.in[14]; const float* norm2_g = args.in[15];
    const float* w_router = args.in[16]; const float* w_e_gate = args.in[17]; const float* w_e_up = args.in[18]; const float* w_e_down = args.in[19];
    const float* final_g = args.in[20];
    float* MOD = (float*)(ws + WS_MOD); float* MODP = (float*)(ws + WS_MODP); float* LB = (float*)(ws + WS_LB);
    int* IDX = (int*)(ws + WS_IDX); float* VALS = (float*)(ws + WS_VALS); float* PROBS = (float*)(ws + WS_PROBS); int* INV = (int*)(ws + WS_INV);
    bf16* WIN = (bf16*)(ws + WS_WIN); bf16* WA = (bf16*)(ws + WS_WA); bf16* WP = (bf16*)(ws + WS_WP); bf16* WOUT = (bf16*)(ws + WS_WOUT);
    bf16* QB = (bf16*)(ws + WS_Q); bf16* VB = (bf16*)(ws + WS_V); bf16* GF = (bf16*)(ws + WS_GF); bf16* GBK = (bf16*)(ws + WS_GB);
    bf16* OG = (bf16*)(ws + WS_OG); bf16* PB = (bf16*)(ws + WS_P); bf16* GA = (bf16*)(ws + WS_GA); bf16* GBT = (bf16*)(ws + WS_GBT);
    float* NEWHX = (float*)(ws + WS_NEWHX); bf16* AA = (bf16*)(ws + WS_AA); bf16* VX = (bf16*)(ws + WS_VX); bf16* RB = (bf16*)(ws + WS_R);
    bf16* HID = (bf16*)(ws + WS_HID); bf16* YB = (bf16*)(ws + WS_YB);
    bf16* UX = (bf16*)(dout + DO_UX); bf16* OF = (bf16*)(dout + DO_OF); bf16* OB = (bf16*)(dout + DO_OB); bf16* WGU = (bf16*)(dout + DO_WGU); bf16* WDN = (bf16*)(dout + DO_WDN);
    const int lo = args.ph_lo, hi = args.ph_hi;
#ifndef PHASE_MASK
#define PHASE_MASK 0xff
#endif
#define IN(k) (((PHASE_MASK >> (k)) & 1) && lo <= (k) && (k) < hi)
#define SEAM(k) do { if (IN(k) && IN((k) + 1)) { cg::this_grid().sync(); } } while (0)

    if (IN(0)) {
        LAS float* scr = (LAS float*)(lds + wave * 16384);
        for (int it = gw; it < 96 * 16; it += NGW) {
            const int cb = it % 96, kp = it / 96, col = cb * 64 + lane, k0 = kp * 64;
            float sv[9];
#pragma unroll
            for (int r = 0; r < 9; ++r) { const float cv = (r < 8) ? cvec[r * D + k0 + lane] : c_ctx[k0 + lane]; sv[r] = siluf_(cv); }
            float acc[9];
#pragma unroll
            for (int r = 0; r < 9; ++r) acc[r] = 0.f;
#pragma unroll 16
            for (int kk = 0; kk < 64; ++kk) { const float w = w_mod[(size_t)(k0 + kk) * (6 * D) + col];
#pragma unroll
                for (int r = 0; r < 9; ++r) acc[r] += __shfl(sv[r], kk) * w; }
#pragma unroll
            for (int r = 0; r < 9; ++r) MODP[((size_t)kp * 9 + r) * (6 * D) + col] = acc[r];
        }
        for (int i = gw * 64 + lane; i < 2 * HD * NH; i += NGW * 64) { const int dir = i >> 10, d = i & 1023; const float l0 = lb_logits[dir * 2048 + d], l1 = lb_logits[dir * 2048 + 1024 + d]; LB[i] = 1.0f / (1.0f + __expf(l1 - l0)); }
        {
            constexpr int I_IN = (D / 64) * (NIN / 32), I_A = (D / 64) * (D / 32), I_OUT = I_A;
            for (int it = gw; it < I_IN + I_A + I_OUT; it += NGW) {
                int r = it;
                if (r < I_IN) { const int nblk = NIN / 32, kb = r / nblk, nb = r % nblk; transpose_item(w_in, D, NIN, WIN, 64 * kb, 32 * nb, 32 * nb, scr, lane); continue; } r -= I_IN;
                if (r < I_A) { const int nblk = D / 32, kb = r / nblk, nb = r % nblk; transpose_item(w_a, D, D, WA, 64 * kb, 32 * nb, 32 * nb, scr, lane); continue; } r -= I_A;
                { const int nblk = D / 32, kb = r / nblk, nb = r % nblk; transpose_item(w_out, D, D, WOUT, 64 * kb, 32 * nb, 32 * nb, scr, lane); }
            }
        }
        for (int it = gw; it < PW * 16; it += NGW) {
            const int k = it >> 4, nb = it & 15, n = nb * 64 + lane, j = k >> 7;
            const float* wp = w_pool + (size_t)k * 128; const float* ps = pool_scale + j * 128; const float* wb = w_b + (size_t)(j * 128) * D + n;
            float a = 0.f;
#pragma unroll 8
            for (int m = 0; m < 128; ++m) a += (wp[m] * ps[m]) * wb[(size_t)m * D];
            WP[(size_t)n * PW + k] = (bf16)f2bf(a);
        }
    }
    SEAM(0);

    if (IN(1)) {
        LAS float* shs = (LAS float*)lds; LAS float* scs = shs + D;
        for (int slab = bx; slab < MT / 256; slab += G) {
            const int mrow = slab < M / 256 ? slab / 32 : 8;
            const bool writer = (slab < M / 256) ? (slab % 32 == 0) : (slab == M / 256);
            for (int c = tid; c < (writer ? 6 * D : 2 * D); c += NTHR) {
                float a = b_mod[c];
#pragma unroll
                for (int kp = 0; kp < 16; ++kp) a += MODP[((size_t)kp * 9 + mrow) * (6 * D) + c];
                if (c < D) shs[c] = a; else if (c < 2 * D) scs[c - D] = a;
                if (writer) MOD[mrow * (6 * D) + c] = a;
            }
            __syncthreads();
            for (int r = wave * 32; r < wave * 32 + 32; ++r) {
                const int row = slab * 256 + r;
                const float* src = (row < M) ? x + (size_t)row * D : ctx + (size_t)(row - M) * D;
                f32x4 v[4]; float ss = 0.f;
#pragma unroll
                for (int j = 0; j < 4; ++j) { v[j] = *(const f32x4*)(src + 4 * lane + 256 * j); ss += (v[j].x * v[j].x + v[j].y * v[j].y) + (v[j].z * v[j].z + v[j].w * v[j].w); }
                const float rstd = rsqrtf(wave_sum(ss) * (1.0f / D) + EPS);
#pragma unroll
                for (int j = 0; j < 4; ++j) { const int c = 4 * lane + 256 * j; const f32x4 g = *(const f32x4*)(norm1_g + c);
                    const f32x4 sc = *(const LAS f32x4*)(scs + c), sh = *(const LAS f32x4*)(shs + c);
                    const f32x4 o = (v[j] * rstd * g) * (sc + 1.0f) + sh;
                    v2u w; w.x = pk2(o.x, o.y); w.y = pk2(o.z, o.w); *(v2u*)(UX + (size_t)row * D + c) = w; }
            }
            __syncthreads();
        }
    }
    SEAM(1);

    if (IN(2)) {
        pg8::Gemm g{UX, WIN, D, nullptr}; pg8::OrderIn S{G, bx};
        pg8::EpiIn E{QB, VB, GF, GBK, OG, PB, GA, GBT, LB};
        pg8::gemm_phase<pg8::EpiIn, pg8::OrderIn, true, true, false>(lds, g, S, E, tid);
    }
    SEAM(2);

    if (IN(3)) {
        for (int unit = vcu; unit < NB * NH * 4; unit += G) p3_unit(lds, unit, QB, VB, GF, GBK, OF, OB, tid);
    }
    SEAM(3);

    if (IN(4)) {
        for (int slab = bx; slab < M / 256; slab += G) {
            const int b = slab / 32;
            if (P4M & 1) p4_build_aa(slab, OF, OB, OG, hgrn_g, AA, tid);
            if (P4M & 2) p4_pool(lds, slab, PB, RB, tid);
            wg_fence();
            if (P4M & 4) { const bf16* wb_ = WA; asm volatile("" : "+s"(wb_)); pg8::Gemm g{AA, wb_, D, nullptr}; pg8::OrderRow S{slab, 4}; pg8::EpiGateA E{GA};
              pg8::gemm_phase<pg8::EpiGateA, pg8::OrderRow, true, true, false>(lds, g, S, E, tid); }
            wg_fence();
            if (P4M & 8) { const bf16* wb_ = WP; asm volatile("" : "+s"(wb_)); pg8::Gemm g{RB, wb_, PW, nullptr}; pg8::OrderRow S{slab, 4}; pg8::EpiGateB E{GA, GBT};
              pg8::gemm_phase<pg8::EpiGateB, pg8::OrderRow, true, true, false>(lds, g, S, E, tid); }
            wg_fence();
            if (P4M & 16) { const bf16* wb_ = WOUT; asm volatile("" : "+s"(wb_)); pg8::Gemm g{GBT, wb_, D, nullptr}; pg8::OrderRow S{slab, 4}; pg8::EpiResid E{x, NEWHX, MOD + b * (6 * D) + 2 * D};
              pg8::gemm_phase<pg8::EpiResid, pg8::OrderRow, true, true, false>(lds, g, S, E, tid); }
            wg_fence();
            if (P4M & 32) p4_rows(lds, slab, NEWHX, MOD + b * (6 * D), norm2_g, w_router, VX, PROBS, tid);
        }
    }
    SEAM(4);

    if (IN(5)) {
        {
            LAS float* scr = (LAS float*)(lds + wave * 16384);
            constexpr int I_E = (D / 64) * (FF / 32);
            for (int it = gw; it < NE * 3 * I_E; it += NGW) {
                const int e = it / (3 * I_E), r = it % (3 * I_E), which = r / I_E, q = r % I_E, kb = q / (FF / 32), nb = q % (FF / 32), n0 = 32 * nb;
                if (which < 2) transpose_item((which ? w_e_up : w_e_gate) + (size_t)e * D * FF, D, FF, WGU + (size_t)e * 2 * FF * D, 64 * kb, n0, n0 + 128 * (n0 / 128) + 128 * which, scr, lane);
                else transpose_item(w_e_down + (size_t)e * FF * D, FF, D, WDN + (size_t)e * D * FF, 64 * kb, n0, n0, scr, lane);
            }
        }
        __syncthreads();
        {
            LAS unsigned* keys = (LAS unsigned*)lds;
            LAS unsigned* hist = keys + SEQ;
            LAS unsigned* sc = hist + 256;
            LAS unsigned* wsum = sc + 16;
            for (int be = bx; be < NB * NE; be += G) {
                const int b = be / NE, e = be % NE;
                for (int t = tid; t < SEQ; t += NTHR) keys[t] = __builtin_bit_cast(unsigned, PROBS[((size_t)b * SEQ + t) * NE + e]);
                unsigned prefix = 0, mask = 0, kk = CAP;
                for (int pass = 0; pass < 4; ++pass) {
                    const int shift = 24 - 8 * pass;
                    if (tid < 256) hist[tid] = 0;
                    __syncthreads();
                    for (int t = tid; t < SEQ; t += NTHR) { const unsigned k = keys[t]; if ((k & mask) == prefix) __hip_atomic_fetch_add(hist + ((k >> shift) & 255u), 1u, __ATOMIC_RELAXED, __HIP_MEMORY_SCOPE_WORKGROUP); }
                    __syncthreads();
                    if (tid == 0) { unsigned cum = 0; int dsel = 0; unsigned knew = kk;
                        for (int d = 255; d >= 0; --d) { const unsigned hc = hist[d]; if (cum + hc >= kk) { dsel = d; knew = kk - cum; break; } cum += hc; }
                        sc[0] = prefix | ((unsigned)dsel << shift); sc[1] = knew; }
                    __syncthreads();
                    prefix = sc[0]; kk = sc[1]; mask |= (255u << shift);
                    __syncthreads();
                }
                const unsigned thr = prefix, need = kk;
                unsigned cgt = 0, ceq = 0;
#pragma unroll
                for (int i = 0; i < 16; ++i) { const unsigned k = keys[tid * 16 + i]; cgt += (k > thr); ceq += (k == thr); }
                unsigned igt = cgt, ieq = ceq;
#pragma unroll
                for (int o = 1; o < 64; o <<= 1) { const unsigned a = __shfl_up(igt, o), c2 = __shfl_up(ieq, o); if (lane >= o) { igt += a; ieq += c2; } }
                if (lane == 63) { wsum[wave] = igt; wsum[8 + wave] = ieq; }
                __syncthreads();
                unsigned bgt = 0, beq = 0, totgt = 0;
#pragma unroll
                for (int w = 0; w < 8; ++w) { const unsigned a = wsum[w], c2 = wsum[8 + w]; if (w < wave) { bgt += a; beq += c2; } totgt += a; }
                unsigned pgt = bgt + igt - cgt, peq = beq + ieq - ceq;
#pragma unroll
                for (int i = 0; i < 16; ++i) { const int t = tid * 16 + i; const unsigned k = keys[t]; int slot = -1;
                    if (k > thr) { slot = (int)pgt; ++pgt; } else if (k == thr) { if (peq < need) slot = (int)(totgt + peq); ++peq; }
                    INV[((size_t)b * SEQ + t) * NE + e] = slot;
                    if (slot >= 0) { IDX[be * CAP + slot] = b * SEQ + t; VALS[be * CAP + slot] = __builtin_bit_cast(float, k); } }
                __syncthreads();
            }
        }
    }
    SEAM(5);

    if (IN(6)) {
        for (int rnd = 0;; ++rnd) {
            int e, b, rt;
            if (G == 256) { if (rnd >= 2) break; const int xcd = bx & 7, loc = bx >> 3; e = 2 * xcd + rnd; b = loc >> 2; rt = loc & 3; }
            else { const int it = bx + rnd * G; if (it >= NB * NE * 4) break; e = it >> 5; b = (it >> 2) & 7; rt = it & 3; }
            const int be = b * NE + e; const size_t r0 = (size_t)be * CAP + rt * 256;
            { pg8::Gemm g{VX, WGU + (size_t)e * 2 * FF * D, D, IDX + r0}; pg8::OrderRow S{0, 8}; pg8::EpiHid E{HID + r0 * FF};
              pg8::gemm_phase<pg8::EpiHid, pg8::OrderRow, true, true, true>(lds, g, S, E, tid); }
            wg_fence();
            { pg8::Gemm g{HID + r0 * FF, WDN + (size_t)e * D * FF, FF, nullptr}; pg8::OrderRow S{0, 4}; pg8::EpiDown E{YB + r0 * D, VALS + r0};
              pg8::gemm_phase<pg8::EpiDown, pg8::OrderRow, true, true, false>(lds, g, S, E, tid); }
        }
    }
    SEAM(6);

    if (IN(7)) {
        float* out = args.out;
        for (int row = gw; row < M; row += NGW) {
            const int b = row / SEQ; const float* g2 = MOD + b * (6 * D) + 5 * D;
            f32x4 a[4];
#pragma unroll
            for (int j = 0; j < 4; ++j) a[j] = (f32x4){0.f, 0.f, 0.f, 0.f};
            const int sl = (lane < NE) ? INV[(size_t)row * NE + lane] : -1;
            for (int e = 0; e < NE; ++e) { const int s = __shfl(sl, e);
                if (s >= 0) { const bf16* yr = YB + ((size_t)(b * NE + e) * CAP + s) * D + 4 * lane;
#pragma unroll
                    for (int j = 0; j < 4; ++j) { const v2u u = *(const v2u*)(yr + 256 * j); a[j].x += bflo(u.x); a[j].y += bfhi(u.x); a[j].z += bflo(u.y); a[j].w += bfhi(u.y); } } }
            f32x4 hv[4]; float ss = 0.f;
#pragma unroll
            for (int j = 0; j < 4; ++j) { const int c = 4 * lane + 256 * j; hv[j] = *(const f32x4*)(NEWHX + (size_t)row * D + c) + *(const f32x4*)(g2 + c) * a[j];
                ss += (hv[j].x * hv[j].x + hv[j].y * hv[j].y) + (hv[j].z * hv[j].z + hv[j].w * hv[j].w); }
            const float rstd = rsqrtf(wave_sum(ss) * (1.0f / D) + EPS);
#pragma unroll
            for (int j = 0; j < 4; ++j) { const int c = 4 * lane + 256 * j; *(f32x4*)(out + (size_t)row * D + c) = hv[j] * rstd * *(const f32x4*)(final_g + c); }
        }
    }
#undef IN
#undef SEAM
}

extern "C" void kernel_launch(void* const* d_in, const int* in_sizes, int n_in, void* d_out, int out_size, void* d_ws, size_t ws_size, hipStream_t stream) {
    static int grid = 0;
    if (grid == 0) {
        if (n_in != 21 || in_sizes[0] != M * D || in_sizes[8] != D * NIN || out_size != M * D || ws_size < WS_END) {
            fprintf(stderr, "kernel_launch: unexpected shapes: n_in %d in0 %d in8 %d out %d ws %zu; nothing launched\n", n_in, n_in > 0 ? in_sizes[0] : -1, n_in > 8 ? in_sizes[8] : -1, out_size, ws_size); grid = -1; return; }
        int dev = 0, cus = 0, per_cu = 0;
        if (hipGetDevice(&dev) != hipSuccess || hipDeviceGetAttribute(&cus, hipDeviceAttributeMultiprocessorCount, dev) != hipSuccess) { grid = -1; return; }
        if (hipFuncSetAttribute((const void*)mega, hipFuncAttributeMaxDynamicSharedMemorySize, LDS_BYTES) != hipSuccess) { fprintf(stderr, "kernel_launch: hipFuncSetAttribute failed\n"); grid = -1; return; }
        if (hipOccupancyMaxActiveBlocksPerMultiprocessor(&per_cu, (const void*)mega, NTHR, LDS_BYTES) != hipSuccess || per_cu < 1) { fprintf(stderr, "kernel_launch: occupancy query says %d\n", per_cu); per_cu = 1; }
        (void)hipGetLastError();
        grid = cus;
        fprintf(stderr, "kernel_launch: grid %d (occupancy query %d per CU)\n", grid, per_cu);
    }
    if (grid < 0) return;
    Args a{};
    for (int i = 0; i < 21; ++i) a.in[i] = (const float*)d_in[i];
    a.out = (float*)d_out; a.ws = (unsigned char*)d_ws;
#if MK_ONE_LAUNCH
    a.ph_lo = 0; a.ph_hi = NPHASE;
    void* kargs[] = {&a};
    hipError_t e = hipLaunchCooperativeKernel((const void*)mega, dim3(grid), dim3(NTHR), kargs, LDS_BYTES, stream);
    if (e != hipSuccess) fprintf(stderr, "kernel_launch: cooperative launch failed: %s\n", hipGetErrorString(e));
#else
    for (int p = 0; p < NPHASE; ++p) {
        a.ph_lo = p; a.ph_hi = p + 1;
        hipLaunchKernelGGL(mega, dim3(grid), dim3(NTHR), LDS_BYTES, stream, a);
    }
#endif
}
```

```cpp
#include <hip/hip_runtime.h>
#include <hip/hip_cooperative_groups.h>
#include <cstdio>
namespace cg = cooperative_groups;

#define GAS __attribute__((address_space(1)))
#define LAS __attribute__((address_space(3)))
typedef unsigned short bf16;
typedef unsigned v4u __attribute__((ext_vector_type(4)));
typedef unsigned v2u __attribute__((ext_vector_type(2)));
typedef float f32x4 __attribute__((ext_vector_type(4)));
typedef float f32x2 __attribute__((ext_vector_type(2)));
typedef short bf16x8 __attribute__((ext_vector_type(8)));

#ifndef P4M
#define P4M 63
#endif
#ifndef MK_ONE_LAUNCH
#define MK_ONE_LAUNCH 1
#endif

constexpr int NB = 8, SEQ = 8192, D = 1024, M = NB * SEQ, CTXL = 256, MC = NB * CTXL, MT = M + MC;
constexpr int NIN = 7680, NH = 8, HD = 128, NE = 16, CAP = 1024, FF = 1024, PW = 512;
constexpr int GRID_W = 64, GRID_H = SEQ / GRID_W;
constexpr float EPS = 1e-6f;
constexpr int NWAVES = 8, NTHR = 512;
constexpr int NPHASE = 8;

constexpr size_t MiB = 1u << 20;
constexpr size_t WS_CTL = 0, WS_MOD = 1 * MiB, WS_LB = 2 * MiB, WS_IDX = 3 * MiB, WS_VALS = 3 * MiB + 512 * 1024;
constexpr size_t WS_PROBS = 4 * MiB, WS_INV = 8 * MiB;
constexpr size_t WS_MODP = 4 * MiB;
constexpr size_t WS_WIN = 12 * MiB, WS_WA = 27 * MiB, WS_WP = 29 * MiB, WS_WOUT = 30 * MiB;
constexpr size_t WS_Q = 32 * MiB, WS_V = 160 * MiB, WS_GF = 292 * MiB, WS_GB = 424 * MiB, WS_OG = 556 * MiB, WS_P = 684 * MiB, WS_GA = 748 * MiB, WS_GBT = 876 * MiB, WS_END = 1004 * MiB;
constexpr size_t WS_NEWHX = WS_Q;
constexpr size_t WS_AA = WS_GF;
constexpr size_t WS_VX = WS_GF;
constexpr size_t WS_R = WS_GB;
constexpr size_t WS_HID = WS_GB;
constexpr size_t WS_YB = WS_GA;
constexpr size_t DO_UX = 0, DO_OF = 0, DO_OB = 128 * MiB, DO_WGU = 0, DO_WDN = 64 * MiB;

__device__ __forceinline__ unsigned f2bf(float f) { unsigned u = __builtin_bit_cast(unsigned, f); return (u + 0x7fffu + ((u >> 16) & 1u)) >> 16; }
__device__ __forceinline__ unsigned pk2(float lo, float hi) { return f2bf(lo) | (f2bf(hi) << 16); }
__device__ __forceinline__ float bflo(unsigned w) { return __builtin_bit_cast(float, w << 16); }
__device__ __forceinline__ float bfhi(unsigned w) { return __builtin_bit_cast(float, w & 0xffff0000u); }
__device__ __forceinline__ float bf2f(bf16 b) { return __builtin_bit_cast(float, (unsigned)b << 16); }
__device__ __forceinline__ unsigned pkh2(float lo, float hi) { const _Float16 a = (_Float16)lo, b = (_Float16)hi; return (unsigned)__builtin_bit_cast(unsigned short, a) | ((unsigned)__builtin_bit_cast(unsigned short, b) << 16); }
__device__ __forceinline__ float h2f(unsigned short h) { return (float)__builtin_bit_cast(_Float16, h); }
__device__ __forceinline__ float wave_sum(float v) {
#pragma unroll
    for (int o = 1; o < 64; o <<= 1) v += __shfl_xor(v, o);
    return v;
}
__device__ __forceinline__ float sigmoidf_(float x) { return __builtin_amdgcn_rcpf(1.0f + __builtin_amdgcn_exp2f(-1.44269504089f * x)); }
__device__ __forceinline__ float siluf_(float x) { return x * __builtin_amdgcn_rcpf(1.0f + __builtin_amdgcn_exp2f(-1.44269504089f * x)); }
#define LDS_WAIT() asm volatile("s_waitcnt lgkmcnt(0)" ::: "memory")
#define VM_WAIT() asm volatile("s_waitcnt vmcnt(0)" ::: "memory")
__device__ __forceinline__ void wg_fence() {
    asm volatile("s_waitcnt vmcnt(0) lgkmcnt(0)" ::: "memory");
    __syncthreads();
    if (threadIdx.x < 64) { __builtin_amdgcn_fence(__ATOMIC_ACQUIRE, "agent"); asm volatile("s_waitcnt vmcnt(0)" ::: "memory"); }
    __syncthreads();
}

namespace pg8 {
#define PG8_LAS __attribute__((address_space(3)))
typedef unsigned short bf16_t;
typedef unsigned u32x4 __attribute__((ext_vector_type(4)));
constexpr int BM = 256, BK = 64, HALF = 128, HTB = HALF * BK * 2, STAGE_BYTES = 8 * HTB, NXCD = 8, WGM = 8;
__host__ __device__ __forceinline__ int lds_byte(int r, int c) { const int st = (r >> 4) * 2 + (c >> 5), rr = r & 15, cc = c & 31, ob = rr * 64 + cc * 2; return st * 1024 + (ob ^ (((ob >> 9) & 1) << 5)); }
__host__ __device__ __forceinline__ void stage_rc(int b, int& R, int& C) { const int st = b / 1024, sb = b % 1024, swz = sb ^ (((sb >> 9) & 1) << 5); R = (st >> 1) * 16 + swz / 64; C = (st & 1) * 32 + (swz % 64) / 2; }
__host__ __device__ __forceinline__ int perm32(int rho) { const int n = rho >> 4, i = rho & 15; return 8 * (i >> 2) + 4 * n + (i & 3); }
struct Unit { int pm, pn; };
struct Gemm { const bf16_t* A; const bf16_t* Bt; int K; const int* gidx; };
__device__ __forceinline__ unsigned cvt_pk_bf16(float lo, float hi) { unsigned r; asm volatile("v_cvt_pk_bf16_f32 %0, %1, %2" : "=v"(r) : "v"(lo), "v"(hi)); return r; }

template <class Epi, class Sched, bool ALIGN_EPI, bool SP2, bool GATHER>
__device__ __forceinline__ void gemm_phase(PG8_LAS unsigned char* lds, const Gemm g, const Sched& S, const Epi& E, int tid_in) {
    asm volatile("" : "+v"(tid_in));
    const int tid = tid_in, wid = __builtin_amdgcn_readfirstlane(tid >> 6), lane = tid & 63, wr = wid >> 2, wc = wid & 3, fr = lane & 15, fq = lane >> 4;
    const int K = g.K, nt = K / BK;
    unsigned voffA[2], voffA1[2], voffB[2];
#pragma unroll
    for (int i = 0; i < 2; ++i) { int R, C; stage_rc(tid * 16 + i * 8192, R, C); const int Rb = Epi::PERM ? ((R & ~31) + perm32(R & 31)) : R;
        if (GATHER) { voffA[i] = (unsigned)(g.gidx[R] * K + C) * 2u; voffA1[i] = (unsigned)(g.gidx[HALF + R] * K + C) * 2u; }
        else { voffA[i] = (unsigned)(R * K + C) * 2u; voffA1[i] = voffA[i]; }
        voffB[i] = (unsigned)(Rb * K + C) * 2u; }
    const size_t kstep = (size_t)(BK * 2);
    const size_t hstep = (size_t)HALF * K * 2;
    const size_t hstepA = GATHER ? 0 : hstep;
    const size_t tstep = 2 * hstep;
    const unsigned ldsw = (unsigned)wid * 1024u;
    const int aoff = lds_byte(wr * 64 + fr, fq * 8), boff = lds_byte(wc * 32 + fr, fq * 8);
#define PG8_SA(b, h) (((b) * 2 + (h)) * HTB)
#define PG8_SB(b, h) ((4 + (b) * 2 + (h)) * HTB)
#define PG8_STAGE(bufoff, gbase, voff) do { _Pragma("unroll") for (int _i = 0; _i < 2; ++_i) \
        __builtin_amdgcn_global_load_lds((const unsigned*)((const char*)(gbase) + (voff)[_i]), (PG8_LAS unsigned*)(lds + (bufoff) + ldsw + _i * 8192), 16, 0, 0); } while (0)
#define PG8_LDA(dst, b, h) do { _Pragma("unroll") for (int m = 0; m < 4; ++m) _Pragma("unroll") for (int k = 0; k < 2; ++k) dst[m][k] = *(const PG8_LAS bf16x8*)(lds + PG8_SA(b, h) + aoff + m * 2048 + k * 1024); } while (0)
#define PG8_LDB(dst, b, h) do { _Pragma("unroll") for (int n = 0; n < 2; ++n) _Pragma("unroll") for (int k = 0; k < 2; ++k) dst[n][k] = *(const PG8_LAS bf16x8*)(lds + PG8_SB(b, h) + boff + n * 2048 + k * 1024); } while (0)
#define PG8_MMA(ai, bj, At, Bt) do { __builtin_amdgcn_s_setprio(1); _Pragma("unroll") for (int m = 0; m < 4; ++m) _Pragma("unroll") for (int n = 0; n < 2; ++n) _Pragma("unroll") for (int k = 0; k < 2; ++k) \
        acc[ai][bj][m][n] = __builtin_amdgcn_mfma_f32_16x16x32_bf16(Bt[n][k], At[m][k], acc[ai][bj][m][n], 0, 0, 0); __builtin_amdgcn_s_setprio(0); } while (0)
#define PG8_WAIT_V(n) asm volatile("s_waitcnt vmcnt(" #n ")" ::: "memory")
#define PG8_WAIT_L(n) asm volatile("s_waitcnt lgkmcnt(" #n ")" ::: "memory")
#define PG8_BAR __builtin_amdgcn_s_barrier()
#define PG8_SCHED __builtin_amdgcn_sched_barrier(0)
    Unit cur, nxt; int ui = 0;
    if (!S.next(0, cur)) return;
    f32x4 acc[2][2][4][2];
#pragma unroll
    for (int a = 0; a < 2; ++a)
#pragma unroll
        for (int b = 0; b < 2; ++b)
#pragma unroll
            for (int m = 0; m < 4; ++m)
#pragma unroll
                for (int n = 0; n < 2; ++n) acc[a][b][m][n] = (f32x4){0.f, 0.f, 0.f, 0.f};
    bf16x8 At[4][2], B0[2][2], B1[2][2];
    const char* cA = (const char*)g.A + (GATHER ? (size_t)0 : (size_t)cur.pm * tstep); const char* cB = (const char*)g.Bt + (size_t)cur.pn * tstep;
    if constexpr (SP2) {
        PG8_STAGE(PG8_SB(0, 0), cB, voffB); PG8_STAGE(PG8_SB(0, 1), cB + hstep, voffB); PG8_STAGE(PG8_SA(0, 0), cA, voffA); PG8_STAGE(PG8_SA(0, 1), cA + hstepA, voffA1);
        if (wr == 1) PG8_BAR;
        PG8_WAIT_V(2); PG8_BAR;
        PG8_STAGE(PG8_SB(1, 0), cB + kstep, voffB); PG8_STAGE(PG8_SA(1, 0), cA + kstep, voffA); PG8_STAGE(PG8_SB(1, 1), cB + hstep + kstep, voffB);
        PG8_WAIT_V(6); PG8_BAR;
    } else {
        PG8_STAGE(PG8_SB(0, 0), cB, voffB); PG8_STAGE(PG8_SA(0, 0), cA, voffA); PG8_STAGE(PG8_SB(0, 1), cB + hstep, voffB); PG8_STAGE(PG8_SA(0, 1), cA + hstepA, voffA1);
        if (wr == 1) PG8_BAR;
        PG8_WAIT_V(4); PG8_BAR;
        PG8_STAGE(PG8_SB(1, 0), cB + kstep, voffB); PG8_STAGE(PG8_SA(1, 0), cA + kstep, voffA); PG8_STAGE(PG8_SB(1, 1), cB + hstep + kstep, voffB);
        PG8_WAIT_V(6); PG8_BAR;
    }
    for (;;) {
        const bool has_next = S.next(ui + 1, nxt);
        const char* nA = has_next ? (const char*)g.A + (GATHER ? (size_t)0 : (size_t)nxt.pm * tstep) : cA; const char* nB = has_next ? (const char*)g.Bt + (size_t)nxt.pn * tstep : cB;
        for (int t = 0; t < nt; t += 2) {
            const bool last = (t == nt - 2);
            const char* a1 = cA + (size_t)(t + 1) * kstep;
            const char* a2 = last ? nA : cA + (size_t)(t + 2) * kstep; const char* b2 = last ? nB : cB + (size_t)(t + 2) * kstep;
            const char* a3 = a2 + kstep; const char* b3 = b2 + kstep;
            if constexpr (SP2) {
            PG8_LDB(B0, 0, 0); PG8_LDB(B1, 0, 1); PG8_SCHED; PG8_LDA(At, 0, 0); PG8_STAGE(PG8_SA(1, 1), a1 + hstepA, voffA1);
            PG8_WAIT_V(8); PG8_WAIT_L(0); PG8_BAR; PG8_MMA(0, 0, At, B0); PG8_MMA(0, 1, At, B1); PG8_BAR; PG8_SCHED;
            PG8_LDA(At, 0, 1); PG8_STAGE(PG8_SB(0, 0), b2, voffB); PG8_STAGE(PG8_SB(0, 1), b2 + hstep, voffB); PG8_STAGE(PG8_SA(0, 0), a2, voffA);
            PG8_WAIT_V(8); PG8_WAIT_L(0); PG8_BAR; PG8_MMA(1, 0, At, B0); PG8_MMA(1, 1, At, B1); PG8_BAR; PG8_SCHED;
            PG8_LDB(B0, 1, 0); PG8_LDB(B1, 1, 1); PG8_SCHED; PG8_LDA(At, 1, 0); PG8_STAGE(PG8_SA(0, 1), a2 + hstepA, voffA1);
            PG8_WAIT_V(8); PG8_WAIT_L(0); PG8_BAR; PG8_MMA(0, 0, At, B0); PG8_MMA(0, 1, At, B1); PG8_BAR; PG8_SCHED;
            PG8_LDA(At, 1, 1); PG8_STAGE(PG8_SB(1, 0), b3, voffB); PG8_STAGE(PG8_SB(1, 1), b3 + hstep, voffB); PG8_STAGE(PG8_SA(1, 0), a3, voffA);
            PG8_WAIT_V(8); PG8_WAIT_L(0); PG8_BAR; PG8_MMA(1, 0, At, B0); PG8_MMA(1, 1, At, B1); PG8_BAR; PG8_SCHED;
            } else {
            PG8_LDB(B0, 0, 0); PG8_SCHED; PG8_LDA(At, 0, 0); PG8_STAGE(PG8_SA(1, 1), a1 + hstepA, voffA1);
            PG8_WAIT_L(8); PG8_BAR; PG8_WAIT_L(0); PG8_MMA(0, 0, At, B0); PG8_BAR; PG8_SCHED;
            PG8_LDB(B1, 0, 1); PG8_STAGE(PG8_SB(0, 0), b2, voffB);
            PG8_BAR; PG8_WAIT_L(0); PG8_MMA(0, 1, At, B1); PG8_BAR;
            PG8_LDA(At, 0, 1); PG8_STAGE(PG8_SA(0, 0), a2, voffA);
            PG8_BAR; PG8_WAIT_L(0); PG8_MMA(1, 0, At, B0); PG8_BAR; PG8_SCHED;
            PG8_STAGE(PG8_SB(0, 1), b2 + hstep, voffB);
            PG8_WAIT_V(6); PG8_BAR; PG8_MMA(1, 1, At, B1); PG8_BAR;
            PG8_LDB(B0, 1, 0); PG8_SCHED; PG8_LDA(At, 1, 0); PG8_STAGE(PG8_SA(0, 1), a2 + hstepA, voffA1);
            PG8_WAIT_L(8); PG8_BAR; PG8_WAIT_L(0); PG8_MMA(0, 0, At, B0); PG8_BAR; PG8_SCHED;
            PG8_LDB(B1, 1, 1); PG8_STAGE(PG8_SB(1, 0), b3, voffB);
            PG8_BAR; PG8_WAIT_L(0); PG8_MMA(0, 1, At, B1); PG8_BAR;
            PG8_LDA(At, 1, 1); PG8_STAGE(PG8_SA(1, 0), a3, voffA);
            PG8_BAR; PG8_WAIT_L(0); PG8_MMA(1, 0, At, B0); PG8_BAR; PG8_SCHED;
            PG8_STAGE(PG8_SB(1, 1), b3 + hstep, voffB);
            PG8_WAIT_V(6); PG8_BAR; PG8_MMA(1, 1, At, B1); PG8_BAR;
            }
        }
        if constexpr (ALIGN_EPI) { if (wr == 0) PG8_BAR; }
        E(acc, cur, wr, wc, fr, fq);
        if (!has_next) break;
#pragma unroll
        for (int a = 0; a < 2; ++a)
#pragma unroll
            for (int b = 0; b < 2; ++b)
#pragma unroll
                for (int m = 0; m < 4; ++m)
#pragma unroll
                    for (int n = 0; n < 2; ++n) acc[a][b][m][n] = (f32x4){0.f, 0.f, 0.f, 0.f};
        cur = nxt; cA = nA; cB = nB; ++ui;
        if constexpr (ALIGN_EPI) { if (wr == 1) PG8_BAR; }
    }
    PG8_WAIT_V(0);
    if constexpr (!ALIGN_EPI) { if (wr == 0) PG8_BAR; }
    PG8_BAR;
#undef PG8_SA
#undef PG8_SB
#undef PG8_STAGE
#undef PG8_LDA
#undef PG8_LDB
#undef PG8_MMA
#undef PG8_WAIT_V
#undef PG8_WAIT_L
#undef PG8_BAR
#undef PG8_SCHED
}

struct OrderIn {
    int G, c;
    __device__ __forceinline__ bool next(int i, Unit& u) const {
        constexpr int nM = M / BM, nN = NIN / BM, nwg = nM * nN, nctx = (MC / BM) * 12;
        const long L = (long)i * G + c;
        if (L >= nwg + nctx) return false;
        if (L >= nwg) { const int j = (int)L - nwg; u.pm = nM + j / 12; u.pn = 4 + j % 12; return true; }
        int wgid = (int)L; { const int q = nwg / NXCD, r = nwg % NXCD, xcd = wgid % NXCD, off = wgid / NXCD; wgid = (xcd < r ? xcd * (q + 1) : r * (q + 1) + (xcd - r) * q) + off; }
        const int nig = WGM * nN, gid = wgid / nig, fm = gid * WGM, gsz = (nM - fm) < WGM ? (nM - fm) : WGM;
        u.pm = fm + ((wgid % nig) % gsz); u.pn = (wgid % nig) / gsz; return true;
    }
};
struct OrderRow {
    int pm, nN;
    __device__ __forceinline__ bool next(int i, Unit& u) const { if (i >= nN) return false; u.pm = pm; u.pn = i; return true; }
};

struct EpiIn {
    static constexpr bool PERM = true;
    bf16 *Q, *V, *GF, *GB, *OG, *P, *GA, *GBT; const float* lb;
    __device__ __forceinline__ void operator()(const f32x4 (&acc)[2][2][4][2], const Unit& u, int wr, int wc, int fr, int fq) const {
        const int pn = u.pn; int kind, colt, ldc = D; bf16* base; const float* lbp = lb;
        if (pn < 4)       { kind = 1; base = Q;   colt = pn * 256; }
        else if (pn < 8)  { kind = 0; base = V;   colt = (pn - 4) * 256; }
        else if (pn < 12) { kind = 3; base = GF;  colt = (pn - 8) * 256; }
        else if (pn < 16) { kind = 3; base = GB;  colt = (pn - 12) * 256; lbp = lb + 1024; }
        else if (pn < 20) { kind = 1; base = OG;  colt = (pn - 16) * 256; }
        else if (pn < 22) { kind = 0; base = P;   colt = (pn - 20) * 256; ldc = PW; }
        else if (pn < 26) { kind = 2; base = GA;  colt = (pn - 22) * 256; }
        else              { kind = 2; base = GBT; colt = (pn - 26) * 256; }
        const int row0 = u.pm * BM + wr * 64 + fr, col0 = colt + wc * 32 + 8 * fq;
        f32x4 l0[2], l1[2];
        if (kind == 3) {
#pragma unroll
            for (int bj = 0; bj < 2; ++bj) { l0[bj] = *(const f32x4*)(lbp + col0 + bj * HALF); l1[bj] = *(const f32x4*)(lbp + col0 + bj * HALF + 4); }
        }
#pragma unroll
        for (int ai = 0; ai < 2; ++ai)
#pragma unroll
            for (int m = 0; m < 4; ++m) { bf16* rowp = base + (size_t)(row0 + ai * HALF + m * 16) * ldc + col0;
#pragma unroll
                for (int bj = 0; bj < 2; ++bj) { f32x4 v0 = acc[ai][bj][m][0], v1 = acc[ai][bj][m][1]; u32x4 w;
                    if (kind == 3) {
#pragma unroll
                        for (int j = 0; j < 4; ++j) { v0[j] = __builtin_amdgcn_logf(l0[bj][j] + (1.0f - l0[bj][j]) * sigmoidf_(v0[j])); v1[j] = __builtin_amdgcn_logf(l1[bj][j] + (1.0f - l1[bj][j]) * sigmoidf_(v1[j])); }
                        w.x = pkh2(v0[0], v0[1]); w.y = pkh2(v0[2], v0[3]); w.z = pkh2(v1[0], v1[1]); w.w = pkh2(v1[2], v1[3]);
                    } else {
                        if (kind == 1) {
#pragma unroll
                            for (int j = 0; j < 4; ++j) { v0[j] = siluf_(v0[j]); v1[j] = siluf_(v1[j]); }
                        } else if (kind == 2) {
#pragma unroll
                            for (int j = 0; j < 4; ++j) { v0[j] = sigmoidf_(v0[j]); v1[j] = sigmoidf_(v1[j]); }
                        }
                        w.x = cvt_pk_bf16(v0[0], v0[1]); w.y = cvt_pk_bf16(v0[2], v0[3]); w.z = cvt_pk_bf16(v1[0], v1[1]); w.w = cvt_pk_bf16(v1[2], v1[3]);
                    }
                    *(u32x4*)(rowp + bj * HALF) = w; } }
    }
};
struct EpiGateA {
    static constexpr bool PERM = true;
    bf16* GA;
    __device__ __forceinline__ void operator()(const f32x4 (&acc)[2][2][4][2], const Unit& u, int wr, int wc, int fr, int fq) const {
        const int row0 = u.pm * BM + wr * 64 + fr, col0 = u.pn * BM + wc * 32 + 8 * fq;
#pragma unroll
        for (int ai = 0; ai < 2; ++ai)
#pragma unroll
            for (int m = 0; m < 4; ++m) { bf16* rowp = GA + (size_t)(row0 + ai * HALF + m * 16) * D + col0;
#pragma unroll
                for (int bj = 0; bj < 2; ++bj) { const f32x4 v0 = acc[ai][bj][m][0], v1 = acc[ai][bj][m][1]; const u32x4 gw = *(const u32x4*)(rowp + bj * HALF); u32x4 w;
                    w.x = cvt_pk_bf16(v0[0] * bflo(gw.x), v0[1] * bfhi(gw.x)); w.y = cvt_pk_bf16(v0[2] * bflo(gw.y), v0[3] * bfhi(gw.y));
                    w.z = cvt_pk_bf16(v1[0] * bflo(gw.z), v1[1] * bfhi(gw.z)); w.w = cvt_pk_bf16(v1[2] * bflo(gw.w), v1[3] * bfhi(gw.w));
                    *(u32x4*)(rowp + bj * HALF) = w; }
                if (m & 1) asm volatile("" ::: "memory"); }
    }
};
struct EpiGateB {
    static constexpr bool PERM = true;
    const bf16* T; bf16* GBT;
    __device__ __forceinline__ void operator()(const f32x4 (&acc)[2][2][4][2], const Unit& u, int wr, int wc, int fr, int fq) const {
        const int row0 = u.pm * BM + wr * 64 + fr, col0 = u.pn * BM + wc * 32 + 8 * fq;
#pragma unroll
        for (int ai = 0; ai < 2; ++ai)
#pragma unroll
            for (int m = 0; m < 4; ++m) { const size_t off = (size_t)(row0 + ai * HALF + m * 16) * D + col0;
#pragma unroll
                for (int bj = 0; bj < 2; ++bj) { const f32x4 v0 = acc[ai][bj][m][0], v1 = acc[ai][bj][m][1];
                    const u32x4 gw = *(const u32x4*)(GBT + off + bj * HALF), tw = *(const u32x4*)(T + off + bj * HALF); u32x4 w;
                    w.x = cvt_pk_bf16(bflo(tw.x) + v0[0] * bflo(gw.x), bfhi(tw.x) + v0[1] * bfhi(gw.x)); w.y = cvt_pk_bf16(bflo(tw.y) + v0[2] * bflo(gw.y), bfhi(tw.y) + v0[3] * bfhi(gw.y));
                    w.z = cvt_pk_bf16(bflo(tw.z) + v1[0] * bflo(gw.z), bfhi(tw.z) + v1[1] * bfhi(gw.z)); w.w = cvt_pk_bf16(bflo(tw.w) + v1[2] * bflo(gw.w), bfhi(tw.w) + v1[3] * bfhi(gw.w));
                    *(u32x4*)(GBT + off + bj * HALF) = w; }
                asm volatile("" ::: "memory"); }
    }
};
struct EpiResid {
    static constexpr bool PERM = false;
    const float* X; float* O; const float* g1;
    __device__ __forceinline__ void operator()(const f32x4 (&acc)[2][2][4][2], const Unit& u, int wr, int wc, int fr, int fq) const {
        const int row0 = u.pm * BM + wr * 64 + fr, col0 = u.pn * BM + wc * 32 + 4 * fq;
        f32x4 gv[2][2];
#pragma unroll
        for (int bj = 0; bj < 2; ++bj)
#pragma unroll
            for (int n = 0; n < 2; ++n) gv[bj][n] = *(const f32x4*)(g1 + col0 + bj * HALF + n * 16);
#pragma unroll
        for (int ai = 0; ai < 2; ++ai)
#pragma unroll
            for (int m = 0; m < 4; ++m) { const size_t off = (size_t)(row0 + ai * HALF + m * 16) * D + col0;
#pragma unroll
                for (int bj = 0; bj < 2; ++bj)
#pragma unroll
                    for (int n = 0; n < 2; ++n) { const f32x4 xv = *(const f32x4*)(X + off + bj * HALF + n * 16); *(f32x4*)(O + off + bj * HALF + n * 16) = xv + gv[bj][n] * acc[ai][bj][m][n]; }
                asm volatile("" ::: "memory"); }
    }
};
struct EpiHid {
    static constexpr bool PERM = true;
    bf16* H;
    __device__ __forceinline__ void operator()(const f32x4 (&acc)[2][2][4][2], const Unit& u, int wr, int wc, int fr, int fq) const {
        const int row0 = wr * 64 + fr, col0 = u.pn * HALF + wc * 32 + 8 * fq;
#pragma unroll
        for (int ai = 0; ai < 2; ++ai)
#pragma unroll
            for (int m = 0; m < 4; ++m) { bf16* rowp = H + (size_t)(row0 + ai * HALF + m * 16) * FF + col0;
                const f32x4 g0 = acc[ai][0][m][0], g1 = acc[ai][0][m][1], u0 = acc[ai][1][m][0], u1 = acc[ai][1][m][1]; u32x4 w;
                w.x = cvt_pk_bf16(siluf_(g0[0]) * u0[0], siluf_(g0[1]) * u0[1]); w.y = cvt_pk_bf16(siluf_(g0[2]) * u0[2], siluf_(g0[3]) * u0[3]);
                w.z = cvt_pk_bf16(siluf_(g1[0]) * u1[0], siluf_(g1[1]) * u1[1]); w.w = cvt_pk_bf16(siluf_(g1[2]) * u1[2], siluf_(g1[3]) * u1[3]);
                *(u32x4*)rowp = w; }
    }
};
struct EpiDown {
    static constexpr bool PERM = true;
    bf16* Y; const float* vals;
    __device__ __forceinline__ void operator()(const f32x4 (&acc)[2][2][4][2], const Unit& u, int wr, int wc, int fr, int fq) const {
        const int row0 = wr * 64 + fr, col0 = u.pn * BM + wc * 32 + 8 * fq;
#pragma unroll
        for (int ai = 0; ai < 2; ++ai)
#pragma unroll
            for (int m = 0; m < 4; ++m) { const int r = row0 + ai * HALF + m * 16; const float s = vals[r]; bf16* rowp = Y + (size_t)r * D + col0;
#pragma unroll
                for (int bj = 0; bj < 2; ++bj) { const f32x4 v0 = acc[ai][bj][m][0] * s, v1 = acc[ai][bj][m][1] * s; u32x4 w;
                    w.x = cvt_pk_bf16(v0[0], v0[1]); w.y = cvt_pk_bf16(v0[2], v0[3]); w.z = cvt_pk_bf16(v1[0], v1[1]); w.w = cvt_pk_bf16(v1[2], v1[3]);
                    *(u32x4*)(rowp + bj * HALF) = w; } }
    }
};
}

constexpr int RING_BYTES = 131072;
constexpr int LDS_BYTES = 147456;

struct Args {
    const float* in[21]; float* out; unsigned char* ws; int ph_lo, ph_hi;
};

__device__ __forceinline__ void transpose_item(const float* W, int K, int N, bf16* WT, int k0, int n0, int drow0, LAS float* scr, int lane) {
#pragma unroll 8
    for (int i = 0; i < 32; ++i) { const int kk = 2 * i + (lane >> 5); scr[kk * 33 + (lane & 31)] = W[(size_t)(k0 + kk) * N + n0 + (lane & 31)]; }
    LDS_WAIT(); asm volatile("" ::: "memory");
    const int c = lane & 7;
#pragma unroll
    for (int j = 0; j < 4; ++j) { const int n = (lane >> 3) + 8 * j; const LAS float* s = scr + (8 * c) * 33 + n;
        v4u o; o.x = pk2(s[0 * 33], s[1 * 33]); o.y = pk2(s[2 * 33], s[3 * 33]); o.z = pk2(s[4 * 33], s[5 * 33]); o.w = pk2(s[6 * 33], s[7 * 33]);
        *(v4u*)(WT + (size_t)(drow0 + n) * K + k0 + 8 * c) = o; }
    LDS_WAIT(); asm volatile("" ::: "memory");
}


typedef _Float16 half8 __attribute__((ext_vector_type(8)));
struct RawChunk { half8 gA0, gA1; v2u q4[4], g4[4]; v4u v16; };
constexpr int P3_QP = 272, P3_SP = 144;
constexpr int P3_QT = 0, P3_KT = 17408, P3_KTT = 34816, P3_VT = 53248, P3_AM = 62464, P3_SB = 71680;
constexpr int P3_NCH = (CTXL + SEQ) / 64;

__device__ __forceinline__ void p3_load(RawChunk& R, int c, int b, int h, int vh, int dir, int w, int fr, int fq, int lane, const bf16* Qp, const bf16* Vp, const bf16* Gp) {
    c = c < P3_NCH ? c : P3_NCH - 1;
    const int rstep = dir ? -1 : 1;
    const long rbase = (c < 4) ? (long)M + b * CTXL + (dir ? CTXL - 1 - 64 * c : 64 * c) : (long)b * SEQ + (dir ? SEQ - 1 - 64 * (c - 4) : 64 * (c - 4));
    const long qbase = (c < 4) ? (long)b * SEQ + (dir ? 63 : 0) : rbase;
    const unsigned short* ga = (const unsigned short*)Gp + h * HD + 16 * w + fr;
#pragma unroll
    for (int j = 0; j < 8; ++j) { R.gA0[j] = __builtin_bit_cast(_Float16, ga[(rbase + rstep * (8 * fq + j)) * D]); R.gA1[j] = __builtin_bit_cast(_Float16, ga[(rbase + rstep * (32 + 8 * fq + j)) * D]); }
    const int colq = h * HD + 16 * w + 4 * fq;
#pragma unroll
    for (int tt = 0; tt < 4; ++tt) { const int t = 16 * tt + fr;
        R.g4[tt] = *(const v2u*)(Gp + (rbase + rstep * t) * D + colq);
        R.q4[tt] = *(const v2u*)(Qp + (qbase + rstep * t) * D + colq); }
    R.v16 = *(const v4u*)(Vp + (rbase + rstep * lane) * D + h * HD + vh * 64 + 8 * w);
}

__device__ __forceinline__ void p3_chunk(LAS unsigned char* lds, const RawChunk& R, int c, f32x4 (&Sacc)[4], float (&bend_prev)[4], const half8& Bm0, const half8& Bm1, const half8& Bone,
                                         int b, int h, int vh, int dir, int w, int fr, int fq, int lane, bf16* Op) {
    const bool isx = c >= 4;
    f32x4 bacc[4]; const f32x4 z4 = (f32x4){0.f, 0.f, 0.f, 0.f};
    bacc[0] = __builtin_amdgcn_mfma_f32_16x16x32_f16(R.gA0, Bm0, z4, 0, 0, 0);
    bacc[1] = __builtin_amdgcn_mfma_f32_16x16x32_f16(R.gA0, Bm1, z4, 0, 0, 0);
    bacc[2] = __builtin_amdgcn_mfma_f32_16x16x32_f16(R.gA0, Bone, z4, 0, 0, 0); bacc[2] = __builtin_amdgcn_mfma_f32_16x16x32_f16(R.gA1, Bm0, bacc[2], 0, 0, 0);
    bacc[3] = __builtin_amdgcn_mfma_f32_16x16x32_f16(R.gA0, Bone, z4, 0, 0, 0); bacc[3] = __builtin_amdgcn_mfma_f32_16x16x32_f16(R.gA1, Bm1, bacc[3], 0, 0, 0);
    const int src15 = (lane & 48) | 15;
    float br[4], scale[4];
#pragma unroll
    for (int i = 0; i < 4; ++i) { br[i] = __shfl(bacc[1][i], src15); const float be = __shfl(bacc[3][i], src15); scale[i] = __builtin_amdgcn_exp2f(bend_prev[i] + br[i]); bend_prev[i] = be - br[i]; }
#pragma unroll
    for (int vt = 0; vt < 4; ++vt) {
#pragma unroll
        for (int i = 0; i < 4; ++i) Sacc[vt][i] *= scale[i];
        if (isx) { v2u o; o.x = pk2(Sacc[vt][0], Sacc[vt][1]); o.y = pk2(Sacc[vt][2], Sacc[vt][3]); *(LAS v2u*)(lds + P3_SB + (16 * vt + fr) * P3_QP + (16 * w + 4 * fq) * 2) = o; }
    }
#pragma unroll
    for (int tt = 0; tt < 4; ++tt) {
        const unsigned gw[2] = {R.g4[tt].x, R.g4[tt].y}, qw[2] = {R.q4[tt].x, R.q4[tt].y};
        float qt[4], kt[4];
#pragma unroll
        for (int i = 0; i < 4; ++i) {
            const float g = h2f((unsigned short)(gw[i >> 1] >> (16 * (i & 1)))), q = (i & 1) ? bfhi(qw[i >> 1]) : bflo(qw[i >> 1]);
            const float f = __builtin_amdgcn_exp2f(g), beta = bacc[tt][i] - br[i];
            qt[i] = q * __builtin_amdgcn_exp2f(beta); kt[i] = (1.0f - f) * __builtin_amdgcn_exp2f(-beta);
        }
        const int t = 16 * tt + fr;
        unsigned short kb[4];
#pragma unroll
        for (int i = 0; i < 4; ++i) kb[i] = (unsigned short)f2bf(kt[i]);
        if (isx) {
            v2u o; o.x = pk2(qt[0], qt[1]); o.y = pk2(qt[2], qt[3]); *(LAS v2u*)(lds + P3_QT + t * P3_QP + (16 * w + 4 * fq) * 2) = o;
            v2u k2; k2.x = (unsigned)kb[0] | ((unsigned)kb[1] << 16); k2.y = (unsigned)kb[2] | ((unsigned)kb[3] << 16); *(LAS v2u*)(lds + P3_KT + t * P3_QP + (16 * w + 4 * fq) * 2) = k2;
        }
#pragma unroll
        for (int i = 0; i < 4; ++i) *(LAS unsigned short*)(lds + P3_KTT + (16 * w + 4 * fq + i) * P3_SP + t * 2) = kb[i];
    }
    {
        const unsigned vw[4] = {R.v16.x, R.v16.y, R.v16.z, R.v16.w};
#pragma unroll
        for (int j = 0; j < 8; ++j) *(LAS unsigned short*)(lds + P3_VT + (8 * w + j) * P3_SP + lane * 2) = (unsigned short)(vw[j >> 1] >> (16 * (j & 1)));
    }
    LDS_WAIT(); __syncthreads();
    if (isx) {
        const int tt = w >> 1;
        bf16x8 qf[4];
#pragma unroll
        for (int ks = 0; ks < 4; ++ks) qf[ks] = *(const LAS bf16x8*)(lds + P3_QT + (16 * tt + fr) * P3_QP + (32 * ks + 8 * fq) * 2);
#pragma unroll
        for (int k2 = 0; k2 < 2; ++k2) {
            const int st = 2 * (w & 1) + k2;
            f32x4 sc = (f32x4){0.f, 0.f, 0.f, 0.f};
            if (st <= tt) {
#pragma unroll
                for (int ks = 0; ks < 4; ++ks) { const bf16x8 kf = *(const LAS bf16x8*)(lds + P3_KT + (16 * st + fr) * P3_QP + (32 * ks + 8 * fq) * 2);
                    sc = __builtin_amdgcn_mfma_f32_16x16x32_bf16(kf, qf[ks], sc, 0, 0, 0); }
                const int tpos = 16 * tt + fr, s0 = 16 * st + 4 * fq;
#pragma unroll
                for (int i = 0; i < 4; ++i) if (s0 + i > tpos) sc[i] = 0.f;
            }
            v2u o; o.x = pk2(sc[0], sc[1]); o.y = pk2(sc[2], sc[3]);
            *(LAS v2u*)(lds + P3_AM + (16 * tt + fr) * P3_SP + (16 * st + 4 * fq) * 2) = o;
        }
    }
    f32x4 oacc[2]; oacc[0] = (f32x4){0.f, 0.f, 0.f, 0.f}; oacc[1] = oacc[0];
    const int vto = w & 3, tt0 = 2 * (w >> 2);
    if (isx) {
#pragma unroll
        for (int ks = 0; ks < 4; ++ks) { const bf16x8 sf = *(const LAS bf16x8*)(lds + P3_SB + (16 * vto + fr) * P3_QP + (32 * ks + 8 * fq) * 2);
#pragma unroll
            for (int k2 = 0; k2 < 2; ++k2) { const bf16x8 qf = *(const LAS bf16x8*)(lds + P3_QT + (16 * (tt0 + k2) + fr) * P3_QP + (32 * ks + 8 * fq) * 2);
                oacc[k2] = __builtin_amdgcn_mfma_f32_16x16x32_bf16(sf, qf, oacc[k2], 0, 0, 0); } }
    }
    {
        bf16x8 kf[2];
#pragma unroll
        for (int ks = 0; ks < 2; ++ks) kf[ks] = *(const LAS bf16x8*)(lds + P3_KTT + (16 * w + fr) * P3_SP + (32 * ks + 8 * fq) * 2);
#pragma unroll
        for (int vt = 0; vt < 4; ++vt)
#pragma unroll
            for (int ks = 0; ks < 2; ++ks) { const bf16x8 vf = *(const LAS bf16x8*)(lds + P3_VT + (16 * vt + fr) * P3_SP + (32 * ks + 8 * fq) * 2);
                Sacc[vt] = __builtin_amdgcn_mfma_f32_16x16x32_bf16(kf[ks], vf, Sacc[vt], 0, 0, 0); }
    }
    if (isx) {
        LDS_WAIT(); __syncthreads();
#pragma unroll
        for (int ks = 0; ks < 2; ++ks) { const bf16x8 vf = *(const LAS bf16x8*)(lds + P3_VT + (16 * vto + fr) * P3_SP + (32 * ks + 8 * fq) * 2);
#pragma unroll
            for (int k2 = 0; k2 < 2; ++k2) { const bf16x8 af = *(const LAS bf16x8*)(lds + P3_AM + (16 * (tt0 + k2) + fr) * P3_SP + (32 * ks + 8 * fq) * 2);
                oacc[k2] = __builtin_amdgcn_mfma_f32_16x16x32_bf16(vf, af, oacc[k2], 0, 0, 0); } }
        const long xb = (long)b * SEQ + (dir ? SEQ - 1 - 64 * (c - 4) : 64 * (c - 4)); const int rstep = dir ? -1 : 1;
#pragma unroll
        for (int k2 = 0; k2 < 2; ++k2) { const long row = xb + rstep * (16 * (tt0 + k2) + fr);
            v2u o; o.x = pk2(oacc[k2][0], oacc[k2][1]); o.y = pk2(oacc[k2][2], oacc[k2][3]);
            *(v2u*)(Op + row * D + h * HD + vh * 64 + 16 * vto + 4 * fq) = o; }
    }
    LDS_WAIT(); __syncthreads();
}

__device__ __forceinline__ void p3_unit(LAS unsigned char* lds, int unit, const bf16* QB, const bf16* VB, const bf16* GF, const bf16* GBK, bf16* OF, bf16* OB, int tid) {
    asm volatile("" : "+v"(tid));
    const int lane = tid & 63, w = __builtin_amdgcn_readfirstlane(tid >> 6), fr = lane & 15, fq = lane >> 4;
    const int vh = unit & 1, dir = (unit >> 1) & 1, h = (unit >> 2) & 7, b = unit >> 5;
    const bf16* Gp = dir ? GBK : GF; bf16* Op = dir ? OB : OF;
    half8 Bm0, Bm1, Bone;
#pragma unroll
    for (int j = 0; j < 8; ++j) { Bm0[j] = (8 * fq + j <= fr) ? (_Float16)1.0f : (_Float16)0.0f; Bm1[j] = (8 * fq + j <= 16 + fr) ? (_Float16)1.0f : (_Float16)0.0f; Bone[j] = (_Float16)1.0f; }
    f32x4 Sacc[4]; float bend_prev[4];
#pragma unroll
    for (int i = 0; i < 4; ++i) { Sacc[i] = (f32x4){0.f, 0.f, 0.f, 0.f}; bend_prev[i] = 0.f; }
    RawChunk RA, RB;
    p3_load(RA, 0, b, h, vh, dir, w, fr, fq, lane, QB, VB, Gp);
#pragma unroll 1
    for (int c = 0; c < P3_NCH; c += 2) {
        p3_load(RB, c + 1, b, h, vh, dir, w, fr, fq, lane, QB, VB, Gp);
        p3_chunk(lds, RA, c, Sacc, bend_prev, Bm0, Bm1, Bone, b, h, vh, dir, w, fr, fq, lane, Op);
        p3_load(RA, c + 2, b, h, vh, dir, w, fr, fq, lane, QB, VB, Gp);
        p3_chunk(lds, RB, c + 1, Sacc, bend_prev, Bm0, Bm1, Bone, b, h, vh, dir, w, fr, fq, lane, Op);
    }
}

__device__ __forceinline__ void p4_build_aa(int slab, const bf16* OF, const bf16* OB, const bf16* OG, const float* hgrn_g, bf16* AA, int tid) {
    asm volatile("" : "+v"(tid));
    const int lane = tid & 63, wave = __builtin_amdgcn_readfirstlane(tid >> 6), row0 = slab * 256;
    float hg[16];
#pragma unroll
    for (int i = 0; i < 4; ++i) { const f32x4 t = *(const f32x4*)(hgrn_g + 16 * (lane & 7) + 4 * i); hg[4 * i] = t.x; hg[4 * i + 1] = t.y; hg[4 * i + 2] = t.z; hg[4 * i + 3] = t.w; }
    for (int r = wave * 32; r < wave * 32 + 32; ++r) {
        const size_t off = (size_t)(row0 + r) * D + 16 * lane;
        const v4u f0 = *(const v4u*)(OF + off), f1 = *(const v4u*)(OF + off + 8), b0 = *(const v4u*)(OB + off), b1 = *(const v4u*)(OB + off + 8);
        const v4u g0 = *(const v4u*)(OG + off), g1 = *(const v4u*)(OG + off + 8);
        float o[16], gg[16];
        const unsigned fw[8] = {f0.x, f0.y, f0.z, f0.w, f1.x, f1.y, f1.z, f1.w}, bw[8] = {b0.x, b0.y, b0.z, b0.w, b1.x, b1.y, b1.z, b1.w}, gw8[8] = {g0.x, g0.y, g0.z, g0.w, g1.x, g1.y, g1.z, g1.w};
        float ss = 0.f;
#pragma unroll
        for (int i = 0; i < 8; ++i) { o[2 * i] = bflo(fw[i]) + bflo(bw[i]); o[2 * i + 1] = bfhi(fw[i]) + bfhi(bw[i]); gg[2 * i] = bflo(gw8[i]); gg[2 * i + 1] = bfhi(gw8[i]); ss += o[2 * i] * o[2 * i] + o[2 * i + 1] * o[2 * i + 1]; }
        ss += __shfl_xor(ss, 1); ss += __shfl_xor(ss, 2); ss += __shfl_xor(ss, 4);
        const float rstd = rsqrtf(ss * (1.0f / HD) + EPS);
        unsigned w[8];
#pragma unroll
        for (int i = 0; i < 8; ++i) w[i] = pk2((o[2 * i] * rstd * hg[2 * i]) * gg[2 * i], (o[2 * i + 1] * rstd * hg[2 * i + 1]) * gg[2 * i + 1]);
        *(v4u*)(AA + off) = (v4u){w[0], w[1], w[2], w[3]}; *(v4u*)(AA + off + 8) = (v4u){w[4], w[5], w[6], w[7]};
    }
}
__device__ __forceinline__ void p4_pool(LAS unsigned char* lds, int slab, const bf16* PB, bf16* RB, int tid) {
    asm volatile("" : "+v"(tid));
    LAS float* T = (LAS float*)lds; constexpr int TP = 68;
    const int b = slab / 32, row0 = slab * 256, gr0 = 4 * (slab % 32);
#pragma unroll 1
    for (int jh = 0; jh < 8; ++jh) {
        const int j = jh >> 1, hh = jh & 1, w = 2 << j, chb = j * 128 + hh * 64;
        { const int q = tid & 1, cc = (tid >> 1) & 63, r = tid >> 7; const int R = gr0 + r;
          int R0 = R - w / 2; R0 = R0 < 0 ? 0 : R0; int R1 = R + w / 2 - 1; R1 = (R1 > GRID_H - 1 ? GRID_H - 1 : R1) + 1;
          float a[32];
#pragma unroll
          for (int i = 0; i < 32; ++i) a[i] = 0.f;
#pragma unroll 1
          for (int rr = R0; rr < R1; ++rr) { const bf16* src = PB + ((size_t)b * SEQ + rr * GRID_W + cc) * PW + chb + q * 32;
#pragma unroll
              for (int k = 0; k < 4; ++k) { const v4u u = *(const v4u*)(src + 8 * k); a[8 * k + 0] += bflo(u.x); a[8 * k + 1] += bfhi(u.x); a[8 * k + 2] += bflo(u.y); a[8 * k + 3] += bfhi(u.y);
                  a[8 * k + 4] += bflo(u.z); a[8 * k + 5] += bfhi(u.z); a[8 * k + 6] += bflo(u.w); a[8 * k + 7] += bfhi(u.w); } }
          LAS float* dst = T + (r * 64 + cc) * TP + q * 32;
#pragma unroll
          for (int k = 0; k < 8; ++k) *(LAS f32x4*)(dst + 4 * k) = (f32x4){a[4 * k], a[4 * k + 1], a[4 * k + 2], a[4 * k + 3]}; }
        __syncthreads();
        { const int q = tid & 1, tl = tid >> 1, r = tl >> 6, cc = tl & 63; const int R = gr0 + r;
          int R0 = R - w / 2; R0 = R0 < 0 ? 0 : R0; int R1 = R + w / 2 - 1; R1 = (R1 > GRID_H - 1 ? GRID_H - 1 : R1) + 1;
          int C0 = cc - w / 2; C0 = C0 < 0 ? 0 : C0; int C1 = cc + w / 2 - 1; C1 = (C1 > GRID_W - 1 ? GRID_W - 1 : C1) + 1;
          const float inv = 1.0f / (float)((R1 - R0) * (C1 - C0));
          float s[32];
#pragma unroll
          for (int i = 0; i < 32; ++i) s[i] = 0.f;
#pragma unroll 1
          for (int c2 = C0; c2 < C1; ++c2) { const LAS float* src = T + (r * 64 + c2) * TP + q * 32;
#pragma unroll
              for (int k = 0; k < 8; ++k) { const f32x4 t4 = *(const LAS f32x4*)(src + 4 * k); s[4 * k] += t4.x; s[4 * k + 1] += t4.y; s[4 * k + 2] += t4.z; s[4 * k + 3] += t4.w; } }
          const size_t po = (size_t)(row0 + tl) * PW + chb + q * 32;
#pragma unroll
          for (int k = 0; k < 4; ++k) { const v4u u = *(const v4u*)(PB + po + 8 * k); v4u o;
              o.x = pk2(s[8 * k + 0] * inv - bflo(u.x), s[8 * k + 1] * inv - bfhi(u.x)); o.y = pk2(s[8 * k + 2] * inv - bflo(u.y), s[8 * k + 3] * inv - bfhi(u.y));
              o.z = pk2(s[8 * k + 4] * inv - bflo(u.z), s[8 * k + 5] * inv - bfhi(u.z)); o.w = pk2(s[8 * k + 6] * inv - bflo(u.w), s[8 * k + 7] * inv - bfhi(u.w));
              *(v4u*)(RB + po + 8 * k) = o; } }
        __syncthreads();
    }
}
__device__ __forceinline__ void p4_rows(LAS unsigned char* lds, int slab, const float* NEWHX, const float* modb, const float* norm2_g, const float* w_router, bf16* VX, float* PROBS, int tid) {
    asm volatile("" : "+v"(tid));
    const int lane = tid & 63, wave = __builtin_amdgcn_readfirstlane(tid >> 6), row0 = slab * 256;
    LAS float* W2 = (LAS float*)lds;
    LAS float* rstd_s = W2 + D * NE;
    LAS float* bias_s = rstd_s + 256;
    const float* sh2 = modb + 3 * D; const float* sc2 = modb + 4 * D;
    for (int e4 = tid; e4 < D * NE; e4 += NTHR) { const int c = e4 >> 4, e = e4 & 15;
        W2[(((c >> 4) * 4 + ((c >> 2) & 3)) * 16 + e) * 4 + (c & 3)] = norm2_g[c] * (1.0f + sc2[c]) * w_router[e4]; }
    { const int e = tid & 15, part = tid >> 4; float a = 0.f;
      for (int c = part * 32; c < part * 32 + 32; ++c) a += sh2[c] * w_router[c * NE + e];
      bias_s[e * 32 + part] = a; }
#pragma unroll 1
    for (int r = wave * 32; r < wave * 32 + 32; ++r) {
        const int row = row0 + r; const float* src = NEWHX + (size_t)row * D;
        f32x4 v[4]; float ss = 0.f;
#pragma unroll
        for (int j = 0; j < 4; ++j) { v[j] = *(const f32x4*)(src + 4 * lane + 256 * j); ss += (v[j].x * v[j].x + v[j].y * v[j].y) + (v[j].z * v[j].z + v[j].w * v[j].w); }
        const float rstd = rsqrtf(wave_sum(ss) * (1.0f / D) + EPS);
        if (lane == 0) rstd_s[r] = rstd;
#pragma unroll
        for (int j = 0; j < 4; ++j) { const int c = 4 * lane + 256 * j; const f32x4 g = *(const f32x4*)(norm2_g + c), sc = *(const f32x4*)(sc2 + c), sh = *(const f32x4*)(sh2 + c);
            const f32x4 o = (v[j] * rstd * g) * (sc + 1.0f) + sh;
            v2u w; w.x = pk2(o.x, o.y); w.y = pk2(o.z, o.w); *(v2u*)(VX + (size_t)row * D + c) = w; }
    }
    __syncthreads();
    if (tid < 16) { float a = 0.f; for (int p = 0; p < 32; ++p) a += bias_s[tid * 32 + p]; bias_s[512 + tid] = a; }
    __syncthreads();
    const int fr = lane & 15, fq = lane >> 4;
#pragma unroll 1
    for (int grp = wave * 2; grp < wave * 2 + 2; ++grp) {
        const float* arow = NEWHX + (size_t)(row0 + grp * 16 + fr) * D + 4 * fq;
        f32x4 acc = (f32x4){0.f, 0.f, 0.f, 0.f};
#pragma unroll 4
        for (int s = 0; s < 64; ++s) { const f32x4 a = *(const f32x4*)(arow + 16 * s); const f32x4 w = *(const LAS f32x4*)(W2 + ((s * 4 + fq) * 16 + fr) * 4);
            acc = __builtin_amdgcn_mfma_f32_16x16x4f32(a.x, w.x, acc, 0, 0, 0); acc = __builtin_amdgcn_mfma_f32_16x16x4f32(a.y, w.y, acc, 0, 0, 0);
            acc = __builtin_amdgcn_mfma_f32_16x16x4f32(a.z, w.z, acc, 0, 0, 0); acc = __builtin_amdgcn_mfma_f32_16x16x4f32(a.w, w.w, acc, 0, 0, 0); }
        const float be = bias_s[512 + fr];
#pragma unroll
        for (int i = 0; i < 4; ++i) { const int r = grp * 16 + 4 * fq + i; float lg = acc[i] * rstd_s[r] + be;
            float mx = lg; mx = fmaxf(mx, __shfl_xor(mx, 1)); mx = fmaxf(mx, __shfl_xor(mx, 2)); mx = fmaxf(mx, __shfl_xor(mx, 4)); mx = fmaxf(mx, __shfl_xor(mx, 8));
            const float ex = __expf(lg - mx); float sm = ex; sm += __shfl_xor(sm, 1); sm += __shfl_xor(sm, 2); sm += __shfl_xor(sm, 4); sm += __shfl_xor(sm, 8);
            PROBS[(size_t)(row0 + r) * NE + fr] = ex / sm; }
    }
    __syncthreads();
}

__global__ void __launch_bounds__(NTHR) mega(Args args) {
    extern __shared__ __attribute__((aligned(16))) unsigned char lds_raw[];
    LAS unsigned char* lds = (LAS unsigned char*)lds_raw;
    const int tid = threadIdx.x, lane = tid & 63, wave = __builtin_amdgcn_readfirstlane(tid >> 6);
    const int G = gridDim.x, bx = blockIdx.x;
    const int vcu = (G % 8 == 0) ? (bx % 8) * (G / 8) + bx / 8 : bx;
    const int gw = vcu * NWAVES + wave, NGW = G * NWAVES;
    unsigned char* ws = args.ws; unsigned char* dout = (unsigned char*)args.out;
    const float* x = args.in[0]; const float* cvec = args.in[1]; const float* ctx = args.in[2]; const float* c_ctx = args.in[3];
    const float* lb_logits = args.in[4]; const float* w_mod = args.in[5]; const float* b_mod = args.in[6]; const float* norm1_g = args.in[7];
    const float* w_in = args.in[8]; const float* hgrn_g = args.in[9]; const float* w_a = args.in[10]; const float* w_pool = args.in[11];
    const float* pool_scale = args.in[12]; const float* w_b = args.in[13]; const float* w_out = args.in[14]; const float* norm2_g = args.in[15];
    const float* w_router = args.in[16]; const float* w_e_gate = args.in[17]; const float* w_e_up = args.in[18]; const float* w_e_down = args.in[19];
    const float* final_g = args.in[20];
    float* MOD = (float*)(ws + WS_MOD); float* MODP = (float*)(ws + WS_MODP); float* LB = (float*)(ws + WS_LB);
    int* IDX = (int*)(ws + WS_IDX); float* VALS = (float*)(ws + WS_VALS); float* PROBS = (float*)(ws + WS_PROBS); int* INV = (int*)(ws + WS_INV);
    bf16* WIN = (bf16*)(ws + WS_WIN); bf16* WA = (bf16*)(ws + WS_WA); bf16* WP = (bf16*)(ws + WS_WP); bf16* WOUT = (bf16*)(ws + WS_WOUT);
    bf16* QB = (bf16*)(ws + WS_Q); bf16* VB = (bf16*)(ws + WS_V); bf16* GF = (bf16*)(ws + WS_GF); bf16* GBK = (bf16*)(ws + WS_GB);
    bf16* OG = (bf16*)(ws + WS_OG); bf16* PB = (bf16*)(ws + WS_P); bf16* GA = (bf16*)(ws + WS_GA); bf16* GBT = (bf16*)(ws + WS_GBT);
    float* NEWHX = (float*)(ws + WS_NEWHX); bf16* AA = (bf16*)(ws + WS_AA); bf16* VX = (bf16*)(ws + WS_VX); bf16* RB = (bf16*)(ws + WS_R);
    bf16* HID = (bf16*)(ws + WS_HID); bf16* YB = (bf16*)(ws + WS_YB);
    bf16* UX = (bf16*)(dout + DO_UX); bf16* OF = (bf16*)(dout + DO_OF); bf16* OB = (bf16*)(dout + DO_OB); bf16* WGU = (bf16*)(dout + DO_WGU); bf16* WDN = (bf16*)(dout + DO_WDN);
    const int lo = args.ph_lo, hi = args.ph_hi;
#ifndef PHASE_MASK
#define PHASE_MASK 0xff
#endif
#ifndef REPEAT_MASK
#define REPEAT_MASK 0
#endif
#define IN(k) (((PHASE_MASK >> (k)) & 1) && lo <= (k) && (k) < hi)
#define REP(k) for (int rep_ = 0; rep_ < ((REPEAT_MASK >> (k)) & 1) + 1; ++rep_)
#define SEAM(k) do { if (IN(k) && IN((k) + 1)) { cg::this_grid().sync(); } } while (0)

    if (IN(0)) REP(0) {
        LAS float* scr = (LAS float*)(lds + wave * 16384);
        for (int it = gw; it < 96 * 16; it += NGW) {
            const int cb = it % 96, kp = it / 96, col = cb * 64 + lane, k0 = kp * 64;
            float sv[9];
#pragma unroll
            for (int r = 0; r < 9; ++r) { const float cv = (r < 8) ? cvec[r * D + k0 + lane] : c_ctx[k0 + lane]; sv[r] = siluf_(cv); }
            float acc[9];
#pragma unroll
            for (int r = 0; r < 9; ++r) acc[r] = 0.f;
#pragma unroll 16
            for (int kk = 0; kk < 64; ++kk) { const float w = w_mod[(size_t)(k0 + kk) * (6 * D) + col];
#pragma unroll
                for (int r = 0; r < 9; ++r) acc[r] += __shfl(sv[r], kk) * w; }
#pragma unroll
            for (int r = 0; r < 9; ++r) MODP[((size_t)kp * 9 + r) * (6 * D) + col] = acc[r];
        }
        for (int i = gw * 64 + lane; i < 2 * HD * NH; i += NGW * 64) { const int dir = i >> 10, d = i & 1023; const float l0 = lb_logits[dir * 2048 + d], l1 = lb_logits[dir * 2048 + 1024 + d]; LB[i] = 1.0f / (1.0f + __expf(l1 - l0)); }
        {
            constexpr int I_IN = (D / 64) * (NIN / 32), I_A = (D / 64) * (D / 32), I_OUT = I_A;
            for (int it = gw; it < I_IN + I_A + I_OUT; it += NGW) {
                int r = it;
                if (r < I_IN) { const int nblk = NIN / 32, kb = r / nblk, nb = r % nblk; transpose_item(w_in, D, NIN, WIN, 64 * kb, 32 * nb, 32 * nb, scr, lane); continue; } r -= I_IN;
                if (r < I_A) { const int nblk = D / 32, kb = r / nblk, nb = r % nblk; transpose_item(w_a, D, D, WA, 64 * kb, 32 * nb, 32 * nb, scr, lane); continue; } r -= I_A;
                { const int nblk = D / 32, kb = r / nblk, nb = r % nblk; transpose_item(w_out, D, D, WOUT, 64 * kb, 32 * nb, 32 * nb, scr, lane); }
            }
        }
        for (int it = gw; it < PW * 16; it += NGW) {
            const int k = it >> 4, nb = it & 15, n = nb * 64 + lane, j = k >> 7;
            const float* wp = w_pool + (size_t)k * 128; const float* ps = pool_scale + j * 128; const float* wb = w_b + (size_t)(j * 128) * D + n;
            float a = 0.f;
#pragma unroll 8
            for (int m = 0; m < 128; ++m) a += (wp[m] * ps[m]) * wb[(size_t)m * D];
            WP[(size_t)n * PW + k] = (bf16)f2bf(a);
        }
    }
    SEAM(0);

    if (IN(1)) REP(1) {
        LAS float* shs = (LAS float*)lds; LAS float* scs = shs + D;
        for (int slab = bx; slab < MT / 256; slab += G) {
            const int mrow = slab < M / 256 ? slab / 32 : 8;
            const bool writer = (slab < M / 256) ? (slab % 32 == 0) : (slab == M / 256);
            for (int c = tid; c < (writer ? 6 * D : 2 * D); c += NTHR) {
                float a = b_mod[c];
#pragma unroll
                for (int kp = 0; kp < 16; ++kp) a += MODP[((size_t)kp * 9 + mrow) * (6 * D) + c];
                if (c < D) shs[c] = a; else if (c < 2 * D) scs[c - D] = a;
                if (writer) MOD[mrow * (6 * D) + c] = a;
            }
            __syncthreads();
            for (int r = wave * 32; r < wave * 32 + 32; ++r) {
                const int row = slab * 256 + r;
                const float* src = (row < M) ? x + (size_t)row * D : ctx + (size_t)(row - M) * D;
                f32x4 v[4]; float ss = 0.f;
#pragma unroll
                for (int j = 0; j < 4; ++j) { v[j] = *(const f32x4*)(src + 4 * lane + 256 * j); ss += (v[j].x * v[j].x + v[j].y * v[j].y) + (v[j].z * v[j].z + v[j].w * v[j].w); }
                const float rstd = rsqrtf(wave_sum(ss) * (1.0f / D) + EPS);
#pragma unroll
                for (int j = 0; j < 4; ++j) { const int c = 4 * lane + 256 * j; const f32x4 g = *(const f32x4*)(norm1_g + c);
                    const f32x4 sc = *(const LAS f32x4*)(scs + c), sh = *(const LAS f32x4*)(shs + c);
                    const f32x4 o = (v[j] * rstd * g) * (sc + 1.0f) + sh;
                    v2u w; w.x = pk2(o.x, o.y); w.y = pk2(o.z, o.w); *(v2u*)(UX + (size_t)row * D + c) = w; }
            }
            __syncthreads();
        }
    }
    SEAM(1);

    if (IN(2)) REP(2) {
        pg8::Gemm g{UX, WIN, D, nullptr}; pg8::OrderIn S{G, bx};
        pg8::EpiIn E{QB, VB, GF, GBK, OG, PB, GA, GBT, LB};
        pg8::gemm_phase<pg8::EpiIn, pg8::OrderIn, true, true, false>(lds, g, S, E, tid);
    }
    SEAM(2);

    if (IN(3)) REP(3) {
        for (int unit = vcu; unit < NB * NH * 4; unit += G) p3_unit(lds, unit, QB, VB, GF, GBK, OF, OB, tid);
    }
    SEAM(3);

    if (IN(4)) REP(4) {
        for (int slab = bx; slab < M / 256; slab += G) {
            const int b = slab / 32;
            if (P4M & 1) p4_build_aa(slab, OF, OB, OG, hgrn_g, AA, tid);
            if (P4M & 2) p4_pool(lds, slab, PB, RB, tid);
            wg_fence();
            if (P4M & 4) { const bf16* wb_ = WA; asm volatile("" : "+s"(wb_)); pg8::Gemm g{AA, wb_, D, nullptr}; pg8::OrderRow S{slab, 4}; pg8::EpiGateA E{GA};
              pg8::gemm_phase<pg8::EpiGateA, pg8::OrderRow, true, true, false>(lds, g, S, E, tid); }
            wg_fence();
            if (P4M & 8) { const bf16* wb_ = WP; asm volatile("" : "+s"(wb_)); pg8::Gemm g{RB, wb_, PW, nullptr}; pg8::OrderRow S{slab, 4}; pg8::EpiGateB E{GA, GBT};
              pg8::gemm_phase<pg8::EpiGateB, pg8::OrderRow, true, true, false>(lds, g, S, E, tid); }
            wg_fence();
            if (P4M & 16) { const bf16* wb_ = WOUT; asm volatile("" : "+s"(wb_)); pg8::Gemm g{GBT, wb_, D, nullptr}; pg8::OrderRow S{slab, 4}; pg8::EpiResid E{x, NEWHX, MOD + b * (6 * D) + 2 * D};
              pg8::gemm_phase<pg8::EpiResid, pg8::OrderRow, true, true, false>(lds, g, S, E, tid); }
            wg_fence();
            if (P4M & 32) p4_rows(lds, slab, NEWHX, MOD + b * (6 * D), norm2_g, w_router, VX, PROBS, tid);
        }
    }
    SEAM(4);

    if (IN(5)) REP(5) {
        {
            LAS float* scr = (LAS float*)(lds + wave * 16384);
            constexpr int I_E = (D / 64) * (FF / 32);
            for (int it = gw; it < NE * 3 * I_E; it += NGW) {
                const int e = it / (3 * I_E), r = it % (3 * I_E), which = r / I_E, q = r % I_E, kb = q / (FF / 32), nb = q % (FF / 32), n0 = 32 * nb;
                if (which < 2) transpose_item((which ? w_e_up : w_e_gate) + (size_t)e * D * FF, D, FF, WGU + (size_t)e * 2 * FF * D, 64 * kb, n0, n0 + 128 * (n0 / 128) + 128 * which, scr, lane);
                else transpose_item(w_e_down + (size_t)e * FF * D, FF, D, WDN + (size_t)e * D * FF, 64 * kb, n0, n0, scr, lane);
            }
        }
        __syncthreads();
        {
            LAS unsigned* keys = (LAS unsigned*)lds;
            LAS unsigned* hist = keys + SEQ;
            LAS unsigned* sc = hist + 256;
            LAS unsigned* wsum = sc + 16;
            for (int be = bx; be < NB * NE; be += G) {
                const int b = be / NE, e = be % NE;
                for (int t = tid; t < SEQ; t += NTHR) keys[t] = __builtin_bit_cast(unsigned, PROBS[((size_t)b * SEQ + t) * NE + e]);
                unsigned prefix = 0, mask = 0, kk = CAP;
                for (int pass = 0; pass < 4; ++pass) {
                    const int shift = 24 - 8 * pass;
                    if (tid < 256) hist[tid] = 0;
                    __syncthreads();
                    for (int t = tid; t < SEQ; t += NTHR) { const unsigned k = keys[t]; if ((k & mask) == prefix) __hip_atomic_fetch_add(hist + ((k >> shift) & 255u), 1u, __ATOMIC_RELAXED, __HIP_MEMORY_SCOPE_WORKGROUP); }
                    __syncthreads();
                    if (tid == 0) { unsigned cum = 0; int dsel = 0; unsigned knew = kk;
                        for (int d = 255; d >= 0; --d) { const unsigned hc = hist[d]; if (cum + hc >= kk) { dsel = d; knew = kk - cum; break; } cum += hc; }
                        sc[0] = prefix | ((unsigned)dsel << shift); sc[1] = knew; }
                    __syncthreads();
                    prefix = sc[0]; kk = sc[1]; mask |= (255u << shift);
                    __syncthreads();
                }
                const unsigned thr = prefix, need = kk;
                unsigned cgt = 0, ceq = 0;
#pragma unroll
                for (int i = 0; i < 16; ++i) { const unsigned k = keys[tid * 16 + i]; cgt += (k > thr); ceq += (k == thr); }
                unsigned igt = cgt, ieq = ceq;
#pragma unroll
                for (int o = 1; o < 64; o <<= 1) { const unsigned a = __shfl_up(igt, o), c2 = __shfl_up(ieq, o); if (lane >= o) { igt += a; ieq += c2; } }
                if (lane == 63) { wsum[wave] = igt; wsum[8 + wave] = ieq; }
                __syncthreads();
                unsigned bgt = 0, beq = 0, totgt = 0;
#pragma unroll
                for (int w = 0; w < 8; ++w) { const unsigned a = wsum[w], c2 = wsum[8 + w]; if (w < wave) { bgt += a; beq += c2; } totgt += a; }
                unsigned pgt = bgt + igt - cgt, peq = beq + ieq - ceq;
#pragma unroll
                for (int i = 0; i < 16; ++i) { const int t = tid * 16 + i; const unsigned k = keys[t]; int slot = -1;
                    if (k > thr) { slot = (int)pgt; ++pgt; } else if (k == thr) { if (peq < need) slot = (int)(totgt + peq); ++peq; }
                    INV[((size_t)b * SEQ + t) * NE + e] = slot;
                    if (slot >= 0) { IDX[be * CAP + slot] = b * SEQ + t; VALS[be * CAP + slot] = __builtin_bit_cast(float, k); } }
                __syncthreads();
            }
        }
    }
    SEAM(5);

    if (IN(6)) REP(6) {
        for (int rnd = 0;; ++rnd) {
            int e, b, rt;
            if (G == 256) { if (rnd >= 2) break; const int xcd = bx & 7, loc = bx >> 3; e = 2 * xcd + rnd; b = loc >> 2; rt = loc & 3; }
            else { const int it = bx + rnd * G; if (it >= NB * NE * 4) break; e = it >> 5; b = (it >> 2) & 7; rt = it & 3; }
            const int be = b * NE + e; const size_t r0 = (size_t)be * CAP + rt * 256;
            { pg8::Gemm g{VX, WGU + (size_t)e * 2 * FF * D, D, IDX + r0}; pg8::OrderRow S{0, 8}; pg8::EpiHid E{HID + r0 * FF};
              pg8::gemm_phase<pg8::EpiHid, pg8::OrderRow, true, true, true>(lds, g, S, E, tid); }
            wg_fence();
            { pg8::Gemm g{HID + r0 * FF, WDN + (size_t)e * D * FF, FF, nullptr}; pg8::OrderRow S{0, 4}; pg8::EpiDown E{YB + r0 * D, VALS + r0};
              pg8::gemm_phase<pg8::EpiDown, pg8::OrderRow, true, true, false>(lds, g, S, E, tid); }
        }
    }
    SEAM(6);

    if (IN(7)) REP(7) {
        float* out = args.out;
        for (int row = gw; row < M; row += NGW) {
            const int b = row / SEQ; const float* g2 = MOD + b * (6 * D) + 5 * D;
            f32x4 a[4];
#pragma unroll
            for (int j = 0; j < 4; ++j) a[j] = (f32x4){0.f, 0.f, 0.f, 0.f};
            const int sl = (lane < NE) ? INV[(size_t)row * NE + lane] : -1;
            for (int e = 0; e < NE; ++e) { const int s = __shfl(sl, e);
                if (s >= 0) { const bf16* yr = YB + ((size_t)(b * NE + e) * CAP + s) * D + 4 * lane;
#pragma unroll
                    for (int j = 0; j < 4; ++j) { const v2u u = *(const v2u*)(yr + 256 * j); a[j].x += bflo(u.x); a[j].y += bfhi(u.x); a[j].z += bflo(u.y); a[j].w += bfhi(u.y); } } }
            f32x4 hv[4]; float ss = 0.f;
#pragma unroll
            for (int j = 0; j < 4; ++j) { const int c = 4 * lane + 256 * j; hv[j] = *(const f32x4*)(NEWHX + (size_t)row * D + c) + *(const f32x4*)(g2 + c) * a[j];
                ss += (hv[j].x * hv[j].x + hv[j].y * hv[j].y) + (hv[j].z * hv[j].z + hv[j].w * hv[j].w); }
            const float rstd = rsqrtf(wave_sum(ss) * (1.0f / D) + EPS);
#pragma unroll
            for (int j = 0; j < 4; ++j) { const int c = 4 * lane + 256 * j; *(f32x4*)(out + (size_t)row * D + c) = hv[j] * rstd * *(const f32x4*)(final_g + c); }
        }
    }
#undef IN
#undef SEAM
}

extern "C" void kernel_launch(void* const* d_in, const int* in_sizes, int n_in, void* d_out, int out_size, void* d_ws, size_t ws_size, hipStream_t stream) {
    static int grid = 0;
    if (grid == 0) {
        if (n_in != 21 || in_sizes[0] != M * D || in_sizes[8] != D * NIN || out_size != M * D || ws_size < WS_END) {
            fprintf(stderr, "kernel_launch: unexpected shapes: n_in %d in0 %d in8 %d out %d ws %zu; nothing launched\n", n_in, n_in > 0 ? in_sizes[0] : -1, n_in > 8 ? in_sizes[8] : -1, out_size, ws_size); grid = -1; return; }
        int dev = 0, cus = 0, per_cu = 0;
        if (hipGetDevice(&dev) != hipSuccess || hipDeviceGetAttribute(&cus, hipDeviceAttributeMultiprocessorCount, dev) != hipSuccess) { grid = -1; return; }
        if (hipFuncSetAttribute((const void*)mega, hipFuncAttributeMaxDynamicSharedMemorySize, LDS_BYTES) != hipSuccess) { fprintf(stderr, "kernel_launch: hipFuncSetAttribute failed\n"); grid = -1; return; }
        if (hipOccupancyMaxActiveBlocksPerMultiprocessor(&per_cu, (const void*)mega, NTHR, LDS_BYTES) != hipSuccess || per_cu < 1) { fprintf(stderr, "kernel_launch: occupancy query says %d\n", per_cu); per_cu = 1; }
        (void)hipGetLastError();
        grid = cus;
        fprintf(stderr, "kernel_launch: grid %d (occupancy query %d per CU)\n", grid, per_cu);
    }
    if (grid < 0) return;
    Args a{};
    for (int i = 0; i < 21; ++i) a.in[i] = (const float*)d_in[i];
    a.out = (float*)d_out; a.ws = (unsigned char*)d_ws;
#if MK_ONE_LAUNCH
    a.ph_lo = 0; a.ph_hi = NPHASE;
    void* kargs[] = {&a};
    hipError_t e = hipLaunchCooperativeKernel((const void*)mega, dim3(grid), dim3(NTHR), kargs, LDS_BYTES, stream);
    if (e != hipSuccess) fprintf(stderr, "kernel_launch: cooperative launch failed: %s\n", hipGetErrorString(e));
#else
    for (int p = 0; p < NPHASE; ++p) {
        a.ph_lo = p; a.ph_hi = p + 1;
        hipLaunchKernelGGL(mega, dim3(grid), dim3(NTHR), LDS_BYTES, stream, a);
    }
#endif
}
```

```cpp
#include <hip/hip_runtime.h>
#include <hip/hip_cooperative_groups.h>
#include <cstdio>
namespace cg = cooperative_groups;

#define GAS __attribute__((address_space(1)))
#define LAS __attribute__((address_space(3)))
typedef unsigned short bf16;
typedef unsigned v4u __attribute__((ext_vector_type(4)));
typedef unsigned v2u __attribute__((ext_vector_type(2)));
typedef float f32x4 __attribute__((ext_vector_type(4)));
typedef float f32x2 __attribute__((ext_vector_type(2)));
typedef short bf16x8 __attribute__((ext_vector_type(8)));

#ifndef P4M
#define P4M 63
#endif
#ifndef MK_ONE_LAUNCH
#define MK_ONE_LAUNCH 1
#endif

constexpr int NB = 8, SEQ = 8192, D = 1024, M = NB * SEQ, CTXL = 256, MC = NB * CTXL, MT = M + MC;
constexpr int NIN = 7680, NH = 8, HD = 128, NE = 16, CAP = 1024, FF = 1024, PW = 512;
constexpr int GRID_W = 64, GRID_H = SEQ / GRID_W;
constexpr float EPS = 1e-6f;
constexpr int NWAVES = 8, NTHR = 512;
constexpr int NPHASE = 8;

constexpr size_t MiB = 1u << 20;
constexpr size_t WS_CTL = 0, WS_MOD = 1 * MiB, WS_LB = 2 * MiB, WS_IDX = 3 * MiB, WS_VALS = 3 * MiB + 512 * 1024;
constexpr size_t WS_PROBS = 4 * MiB, WS_INV = 8 * MiB;
constexpr size_t WS_MODP = 4 * MiB;
constexpr size_t WS_WIN = 12 * MiB, WS_WA = 27 * MiB, WS_WP = 29 * MiB, WS_WOUT = 30 * MiB;
constexpr size_t WS_Q = 32 * MiB, WS_V = 160 * MiB, WS_GF = 292 * MiB, WS_GB = 424 * MiB, WS_OG = 556 * MiB, WS_P = 684 * MiB, WS_GA = 748 * MiB, WS_GBT = 876 * MiB, WS_END = 1004 * MiB;
constexpr size_t WS_NEWHX = WS_Q;
constexpr size_t WS_AA = WS_GF;
constexpr size_t WS_VX = WS_GF;
constexpr size_t WS_R = WS_GB;
constexpr size_t WS_HID = WS_GB;
constexpr size_t WS_YB = WS_GA;
constexpr size_t DO_UX = 0, DO_OF = 0, DO_OB = 128 * MiB, DO_WGU = 0, DO_WDN = 64 * MiB;

__device__ __forceinline__ unsigned f2bf(float f) { unsigned u = __builtin_bit_cast(unsigned, f); return (u + 0x7fffu + ((u >> 16) & 1u)) >> 16; }
__device__ __forceinline__ unsigned pk2(float lo, float hi) { return f2bf(lo) | (f2bf(hi) << 16); }
__device__ __forceinline__ float bflo(unsigned w) { return __builtin_bit_cast(float, w << 16); }
__device__ __forceinline__ float bfhi(unsigned w) { return __builtin_bit_cast(float, w & 0xffff0000u); }
__device__ __forceinline__ float bf2f(bf16 b) { return __builtin_bit_cast(float, (unsigned)b << 16); }
__device__ __forceinline__ unsigned pkh2(float lo, float hi) { const _Float16 a = (_Float16)lo, b = (_Float16)hi; return (unsigned)__builtin_bit_cast(unsigned short, a) | ((unsigned)__builtin_bit_cast(unsigned short, b) << 16); }
__device__ __forceinline__ float h2f(unsigned short h) { return (float)__builtin_bit_cast(_Float16, h); }
__device__ __forceinline__ float wave_sum(float v) {
#pragma unroll
    for (int o = 1; o < 64; o <<= 1) v += __shfl_xor(v, o);
    return v;
}
__device__ __forceinline__ float sigmoidf_(float x) { return __builtin_amdgcn_rcpf(1.0f + __builtin_amdgcn_exp2f(-1.44269504089f * x)); }
__device__ __forceinline__ float siluf_(float x) { return x * __builtin_amdgcn_rcpf(1.0f + __builtin_amdgcn_exp2f(-1.44269504089f * x)); }
#define LDS_WAIT() asm volatile("s_waitcnt lgkmcnt(0)" ::: "memory")
#define VM_WAIT() asm volatile("s_waitcnt vmcnt(0)" ::: "memory")
__device__ __forceinline__ void wg_fence() {
    asm volatile("s_waitcnt vmcnt(0) lgkmcnt(0)" ::: "memory");
    __syncthreads();
    if (threadIdx.x < 64) { __builtin_amdgcn_fence(__ATOMIC_ACQUIRE, "agent"); asm volatile("s_waitcnt vmcnt(0)" ::: "memory"); }
    __syncthreads();
}


#define XB_TMO      128
#define XB_XCNT(j)  (256  + 64 * (j))
#define XB_XSUB(j)  (1280 + 64 * (j))
#define XB_XGEN(j)  (2304 + 64 * (j))
#define XB_TOP      3328
#define XB_TOPGEN   3392
#define XCD_BAR_WORDS 3456
#define XB_SPIN_CAP (1u << 20)
__device__ __forceinline__ unsigned xb_ld(unsigned* p)              { return __hip_atomic_load(p, __ATOMIC_RELAXED, __HIP_MEMORY_SCOPE_AGENT); }
__device__ __forceinline__ unsigned xb_add(unsigned* p, unsigned v) { return __hip_atomic_fetch_add(p, v, __ATOMIC_RELAXED, __HIP_MEMORY_SCOPE_AGENT); }
__device__ __forceinline__ unsigned xb_xcc_id() { return (unsigned)__builtin_amdgcn_s_getreg((3 << 11) | 20) & 0xFu; }
#define XB_SPIN(cond, bar) do { unsigned _sp = 0; while (cond) { __builtin_amdgcn_s_sleep(1); \
    if ((++_sp & 255u) == 0u) { if (xb_ld(&(bar)[XB_TMO])) break; if (_sp > XB_SPIN_CAP) { atomicAdd(&(bar)[XB_TMO], 1u); break; } } } } while (0)
struct XcdBarrier { unsigned* bar; unsigned x; volatile LAS unsigned* st; };
__device__ __forceinline__ XcdBarrier xcd_barrier_post(unsigned* bar, volatile LAS unsigned* st) {
    XcdBarrier b; b.bar = bar; b.x = xb_xcc_id(); b.st = st;
    if (threadIdx.x == 0) (void)xb_add(&bar[XB_XCNT(b.x)], 1u);
    return b;
}
__device__ __forceinline__ void xcd_barrier_complete(unsigned* bar, unsigned x, unsigned& nloc, unsigned& nx) {
    const unsigned G = gridDim.x * gridDim.y * gridDim.z;
    unsigned sum, cnt, mine, sp = 0u;
    for (;;) {
        sum = 0u; cnt = 0u; mine = 0u;
#pragma unroll
        for (unsigned j = 0; j < 16; ++j) { const unsigned c = xb_ld(&bar[XB_XCNT(j)]); sum += c; cnt += (c > 0u) ? 1u : 0u; mine = (j == x) ? c : mine; }
        if (sum == G) break;
        __builtin_amdgcn_s_sleep(1);
        if ((++sp & 255u) == 0u) { if (xb_ld(&bar[XB_TMO])) break; if (sp > XB_SPIN_CAP) { atomicAdd(&bar[XB_TMO], 1u); break; } }
    }
    nloc = mine > 0u ? mine : 1u; nx = cnt > 0u ? cnt : 1u;
}
__device__ __forceinline__ void xcd_barrier(const XcdBarrier& b) {
    asm volatile("s_waitcnt vmcnt(0)" ::: "memory");
    __syncthreads();
    if (threadIdx.x == 0) {
        unsigned* bar = b.bar;
        __builtin_amdgcn_s_waitcnt(0);
        unsigned nloc = b.st[0], nx = b.st[1];
        if (nloc == 0u) { xcd_barrier_complete(bar, b.x, nloc, nx); b.st[0] = nloc; b.st[1] = nx; }
        const unsigned old = xb_add(&bar[XB_XSUB(b.x)], 1u);
        const unsigned gen = old / nloc;
        if (old + 1u == (gen + 1u) * nloc) {
            __builtin_amdgcn_fence(__ATOMIC_RELEASE, "agent");
            asm volatile("s_waitcnt vmcnt(0)" ::: "memory");
            const unsigned og = xb_add(&bar[XB_TOP], 1u);
            const unsigned tg = og / nx;
            if (og + 1u == (tg + 1u) * nx) xb_add(&bar[XB_TOPGEN], 1u);
            else XB_SPIN(xb_ld(&bar[XB_TOPGEN]) == tg, bar);
            __builtin_amdgcn_fence(__ATOMIC_ACQUIRE, "agent");
            xb_add(&bar[XB_XGEN(b.x)], 1u);
            asm volatile("s_waitcnt vmcnt(0)" ::: "memory");
        } else {
            XB_SPIN(xb_ld(&bar[XB_XGEN(b.x)]) == gen, bar);
            __builtin_amdgcn_fence(__ATOMIC_ACQUIRE, "agent");
            asm volatile("s_waitcnt vmcnt(0)" ::: "memory");
        }
    }
    __syncthreads();
}

namespace pg8 {
#define PG8_LAS __attribute__((address_space(3)))
typedef unsigned short bf16_t;
typedef unsigned u32x4 __attribute__((ext_vector_type(4)));
constexpr int BM = 256, BK = 64, HALF = 128, HTB = HALF * BK * 2, STAGE_BYTES = 8 * HTB, NXCD = 8, WGM = 8;
__host__ __device__ __forceinline__ int lds_byte(int r, int c) { const int st = (r >> 4) * 2 + (c >> 5), rr = r & 15, cc = c & 31, ob = rr * 64 + cc * 2; return st * 1024 + (ob ^ (((ob >> 9) & 1) << 5)); }
__host__ __device__ __forceinline__ void stage_rc(int b, int& R, int& C) { const int st = b / 1024, sb = b % 1024, swz = sb ^ (((sb >> 9) & 1) << 5); R = (st >> 1) * 16 + swz / 64; C = (st & 1) * 32 + (swz % 64) / 2; }
__host__ __device__ __forceinline__ int perm32(int rho) { const int n = rho >> 4, i = rho & 15; return 8 * (i >> 2) + 4 * n + (i & 3); }
struct Unit { int pm, pn; };
struct Gemm { const bf16_t* A; const bf16_t* Bt; int K; const int* gidx; };
__device__ __forceinline__ unsigned cvt_pk_bf16(float lo, float hi) { unsigned r; asm volatile("v_cvt_pk_bf16_f32 %0, %1, %2" : "=v"(r) : "v"(lo), "v"(hi)); return r; }

template <class Epi, class Sched, bool ALIGN_EPI, bool SP2, bool GATHER>
__device__ __forceinline__ void gemm_phase(PG8_LAS unsigned char* lds, const Gemm g, const Sched& S, const Epi& E, int tid_in) {
    asm volatile("" : "+v"(tid_in));
    const int tid = tid_in, wid = __builtin_amdgcn_readfirstlane(tid >> 6), lane = tid & 63, wr = wid >> 2, wc = wid & 3, fr = lane & 15, fq = lane >> 4;
    const int K = g.K, nt = K / BK;
    unsigned voffA[2], voffA1[2], voffB[2];
#pragma unroll
    for (int i = 0; i < 2; ++i) { int R, C; stage_rc(tid * 16 + i * 8192, R, C); const int Rb = Epi::PERM ? ((R & ~31) + perm32(R & 31)) : R;
        if (GATHER) { voffA[i] = (unsigned)(g.gidx[R] * K + C) * 2u; voffA1[i] = (unsigned)(g.gidx[HALF + R] * K + C) * 2u; }
        else { voffA[i] = (unsigned)(R * K + C) * 2u; voffA1[i] = voffA[i]; }
        voffB[i] = (unsigned)(Rb * K + C) * 2u; }
    const size_t kstep = (size_t)(BK * 2);
    const size_t hstep = (size_t)HALF * K * 2;
    const size_t hstepA = GATHER ? 0 : hstep;
    const size_t tstep = 2 * hstep;
    const unsigned ldsw = (unsigned)wid * 1024u;
    const int aoff = lds_byte(wr * 64 + fr, fq * 8), boff = lds_byte(wc * 32 + fr, fq * 8);
#define PG8_SA(b, h) (((b) * 2 + (h)) * HTB)
#define PG8_SB(b, h) ((4 + (b) * 2 + (h)) * HTB)
#define PG8_STAGE(bufoff, gbase, voff) do { _Pragma("unroll") for (int _i = 0; _i < 2; ++_i) \
        __builtin_amdgcn_global_load_lds((const unsigned*)((const char*)(gbase) + (voff)[_i]), (PG8_LAS unsigned*)(lds + (bufoff) + ldsw + _i * 8192), 16, 0, 0); } while (0)
#define PG8_LDA(dst, b, h) do { _Pragma("unroll") for (int m = 0; m < 4; ++m) _Pragma("unroll") for (int k = 0; k < 2; ++k) dst[m][k] = *(const PG8_LAS bf16x8*)(lds + PG8_SA(b, h) + aoff + m * 2048 + k * 1024); } while (0)
#define PG8_LDB(dst, b, h) do { _Pragma("unroll") for (int n = 0; n < 2; ++n) _Pragma("unroll") for (int k = 0; k < 2; ++k) dst[n][k] = *(const PG8_LAS bf16x8*)(lds + PG8_SB(b, h) + boff + n * 2048 + k * 1024); } while (0)
#define PG8_MMA(ai, bj, At, Bt) do { __builtin_amdgcn_s_setprio(1); _Pragma("unroll") for (int m = 0; m < 4; ++m) _Pragma("unroll") for (int n = 0; n < 2; ++n) _Pragma("unroll") for (int k = 0; k < 2; ++k) \
        acc[ai][bj][m][n] = __builtin_amdgcn_mfma_f32_16x16x32_bf16(Bt[n][k], At[m][k], acc[ai][bj][m][n], 0, 0, 0); __builtin_amdgcn_s_setprio(0); } while (0)
#define PG8_WAIT_V(n) asm volatile("s_waitcnt vmcnt(" #n ")" ::: "memory")
#define PG8_WAIT_L(n) asm volatile("s_waitcnt lgkmcnt(" #n ")" ::: "memory")
#define PG8_BAR __builtin_amdgcn_s_barrier()
#define PG8_SCHED __builtin_amdgcn_sched_barrier(0)
    Unit cur, nxt; int ui = 0;
    if (!S.next(0, cur)) return;
    f32x4 acc[2][2][4][2];
#pragma unroll
    for (int a = 0; a < 2; ++a)
#pragma unroll
        for (int b = 0; b < 2; ++b)
#pragma unroll
            for (int m = 0; m < 4; ++m)
#pragma unroll
                for (int n = 0; n < 2; ++n) acc[a][b][m][n] = (f32x4){0.f, 0.f, 0.f, 0.f};
    bf16x8 At[4][2], B0[2][2], B1[2][2];
    const char* cA = (const char*)g.A + (GATHER ? (size_t)0 : (size_t)cur.pm * tstep); const char* cB = (const char*)g.Bt + (size_t)cur.pn * tstep;
    if constexpr (SP2) {
        PG8_STAGE(PG8_SB(0, 0), cB, voffB); PG8_STAGE(PG8_SB(0, 1), cB + hstep, voffB); PG8_STAGE(PG8_SA(0, 0), cA, voffA); PG8_STAGE(PG8_SA(0, 1), cA + hstepA, voffA1);
        if (wr == 1) PG8_BAR;
        PG8_WAIT_V(2); PG8_BAR;
        PG8_STAGE(PG8_SB(1, 0), cB + kstep, voffB); PG8_STAGE(PG8_SA(1, 0), cA + kstep, voffA); PG8_STAGE(PG8_SB(1, 1), cB + hstep + kstep, voffB);
        PG8_WAIT_V(6); PG8_BAR;
    } else {
        PG8_STAGE(PG8_SB(0, 0), cB, voffB); PG8_STAGE(PG8_SA(0, 0), cA, voffA); PG8_STAGE(PG8_SB(0, 1), cB + hstep, voffB); PG8_STAGE(PG8_SA(0, 1), cA + hstepA, voffA1);
        if (wr == 1) PG8_BAR;
        PG8_WAIT_V(4); PG8_BAR;
        PG8_STAGE(PG8_SB(1, 0), cB + kstep, voffB); PG8_STAGE(PG8_SA(1, 0), cA + kstep, voffA); PG8_STAGE(PG8_SB(1, 1), cB + hstep + kstep, voffB);
        PG8_WAIT_V(6); PG8_BAR;
    }
    for (;;) {
        const bool has_next = S.next(ui + 1, nxt);
        const char* nA = has_next ? (const char*)g.A + (GATHER ? (size_t)0 : (size_t)nxt.pm * tstep) : cA; const char* nB = has_next ? (const char*)g.Bt + (size_t)nxt.pn * tstep : cB;
        for (int t = 0; t < nt; t += 2) {
            const bool last = (t == nt - 2);
            const char* a1 = cA + (size_t)(t + 1) * kstep;
            const char* a2 = last ? nA : cA + (size_t)(t + 2) * kstep; const char* b2 = last ? nB : cB + (size_t)(t + 2) * kstep;
            const char* a3 = a2 + kstep; const char* b3 = b2 + kstep;
            if constexpr (SP2) {
            PG8_LDB(B0, 0, 0); PG8_LDB(B1, 0, 1); PG8_SCHED; PG8_LDA(At, 0, 0); PG8_STAGE(PG8_SA(1, 1), a1 + hstepA, voffA1);
            PG8_WAIT_V(8); PG8_WAIT_L(0); PG8_BAR; PG8_MMA(0, 0, At, B0); PG8_MMA(0, 1, At, B1); PG8_BAR; PG8_SCHED;
            PG8_LDA(At, 0, 1); PG8_STAGE(PG8_SB(0, 0), b2, voffB); PG8_STAGE(PG8_SB(0, 1), b2 + hstep, voffB); PG8_STAGE(PG8_SA(0, 0), a2, voffA);
            PG8_WAIT_V(8); PG8_WAIT_L(0); PG8_BAR; PG8_MMA(1, 0, At, B0); PG8_MMA(1, 1, At, B1); PG8_BAR; PG8_SCHED;
            PG8_LDB(B0, 1, 0); PG8_LDB(B1, 1, 1); PG8_SCHED; PG8_LDA(At, 1, 0); PG8_STAGE(PG8_SA(0, 1), a2 + hstepA, voffA1);
            PG8_WAIT_V(8); PG8_WAIT_L(0); PG8_BAR; PG8_MMA(0, 0, At, B0); PG8_MMA(0, 1, At, B1); PG8_BAR; PG8_SCHED;
            PG8_LDA(At, 1, 1); PG8_STAGE(PG8_SB(1, 0), b3, voffB); PG8_STAGE(PG8_SB(1, 1), b3 + hstep, voffB); PG8_STAGE(PG8_SA(1, 0), a3, voffA);
            PG8_WAIT_V(8); PG8_WAIT_L(0); PG8_BAR; PG8_MMA(1, 0, At, B0); PG8_MMA(1, 1, At, B1); PG8_BAR; PG8_SCHED;
            } else {
            PG8_LDB(B0, 0, 0); PG8_SCHED; PG8_LDA(At, 0, 0); PG8_STAGE(PG8_SA(1, 1), a1 + hstepA, voffA1);
            PG8_WAIT_L(8); PG8_BAR; PG8_WAIT_L(0); PG8_MMA(0, 0, At, B0); PG8_BAR; PG8_SCHED;
            PG8_LDB(B1, 0, 1); PG8_STAGE(PG8_SB(0, 0), b2, voffB);
            PG8_BAR; PG8_WAIT_L(0); PG8_MMA(0, 1, At, B1); PG8_BAR;
            PG8_LDA(At, 0, 1); PG8_STAGE(PG8_SA(0, 0), a2, voffA);
            PG8_BAR; PG8_WAIT_L(0); PG8_MMA(1, 0, At, B0); PG8_BAR; PG8_SCHED;
            PG8_STAGE(PG8_SB(0, 1), b2 + hstep, voffB);
            PG8_WAIT_V(6); PG8_BAR; PG8_MMA(1, 1, At, B1); PG8_BAR;
            PG8_LDB(B0, 1, 0); PG8_SCHED; PG8_LDA(At, 1, 0); PG8_STAGE(PG8_SA(0, 1), a2 + hstepA, voffA1);
            PG8_WAIT_L(8); PG8_BAR; PG8_WAIT_L(0); PG8_MMA(0, 0, At, B0); PG8_BAR; PG8_SCHED;
            PG8_LDB(B1, 1, 1); PG8_STAGE(PG8_SB(1, 0), b3, voffB);
            PG8_BAR; PG8_WAIT_L(0); PG8_MMA(0, 1, At, B1); PG8_BAR;
            PG8_LDA(At, 1, 1); PG8_STAGE(PG8_SA(1, 0), a3, voffA);
            PG8_BAR; PG8_WAIT_L(0); PG8_MMA(1, 0, At, B0); PG8_BAR; PG8_SCHED;
            PG8_STAGE(PG8_SB(1, 1), b3 + hstep, voffB);
            PG8_WAIT_V(6); PG8_BAR; PG8_MMA(1, 1, At, B1); PG8_BAR;
            }
        }
        if constexpr (ALIGN_EPI) { if (wr == 0) PG8_BAR; }
        E(acc, cur, wr, wc, fr, fq);
        if (!has_next) break;
#pragma unroll
        for (int a = 0; a < 2; ++a)
#pragma unroll
            for (int b = 0; b < 2; ++b)
#pragma unroll
                for (int m = 0; m < 4; ++m)
#pragma unroll
                    for (int n = 0; n < 2; ++n) acc[a][b][m][n] = (f32x4){0.f, 0.f, 0.f, 0.f};
        cur = nxt; cA = nA; cB = nB; ++ui;
        if constexpr (ALIGN_EPI) { if (wr == 1) PG8_BAR; }
    }
    PG8_WAIT_V(0);
    if constexpr (!ALIGN_EPI) { if (wr == 0) PG8_BAR; }
    PG8_BAR;
#undef PG8_SA
#undef PG8_SB
#undef PG8_STAGE
#undef PG8_LDA
#undef PG8_LDB
#undef PG8_MMA
#undef PG8_WAIT_V
#undef PG8_WAIT_L
#undef PG8_BAR
#undef PG8_SCHED
}

struct OrderIn {
    int G, c;
    __device__ __forceinline__ bool next(int i, Unit& u) const {
        constexpr int nM = M / BM, nN = NIN / BM, nwg = nM * nN, nctx = (MC / BM) * 12;
        const long L = (long)i * G + c;
        if (L >= nwg + nctx) return false;
        if (L >= nwg) { const int j = (int)L - nwg; u.pm = nM + j / 12; u.pn = 4 + j % 12; return true; }
        int wgid = (int)L; { const int q = nwg / NXCD, r = nwg % NXCD, xcd = wgid % NXCD, off = wgid / NXCD; wgid = (xcd < r ? xcd * (q + 1) : r * (q + 1) + (xcd - r) * q) + off; }
        const int nig = WGM * nN, gid = wgid / nig, fm = gid * WGM, gsz = (nM - fm) < WGM ? (nM - fm) : WGM;
        u.pm = fm + ((wgid % nig) % gsz); u.pn = (wgid % nig) / gsz; return true;
    }
};
struct OrderRow {
    int pm, nN;
    __device__ __forceinline__ bool next(int i, Unit& u) const { if (i >= nN) return false; u.pm = pm; u.pn = i; return true; }
};

struct EpiIn {
    static constexpr bool PERM = true;
    bf16 *Q, *V, *GF, *GB, *OG, *P, *GA, *GBT; const float* lb;
    __device__ __forceinline__ void operator()(const f32x4 (&acc)[2][2][4][2], const Unit& u, int wr, int wc, int fr, int fq) const {
        const int pn = u.pn; int kind, colt, ldc = D; bf16* base; const float* lbp = lb;
        if (pn < 4)       { kind = 1; base = Q;   colt = pn * 256; }
        else if (pn < 8)  { kind = 0; base = V;   colt = (pn - 4) * 256; }
        else if (pn < 12) { kind = 3; base = GF;  colt = (pn - 8) * 256; }
        else if (pn < 16) { kind = 3; base = GB;  colt = (pn - 12) * 256; lbp = lb + 1024; }
        else if (pn < 20) { kind = 1; base = OG;  colt = (pn - 16) * 256; }
        else if (pn < 22) { kind = 0; base = P;   colt = (pn - 20) * 256; ldc = PW; }
        else if (pn < 26) { kind = 2; base = GA;  colt = (pn - 22) * 256; }
        else              { kind = 2; base = GBT; colt = (pn - 26) * 256; }
        const int row0 = u.pm * BM + wr * 64 + fr, col0 = colt + wc * 32 + 8 * fq;
        f32x4 l0[2], l1[2];
        if (kind == 3) {
#pragma unroll
            for (int bj = 0; bj < 2; ++bj) { l0[bj] = *(const f32x4*)(lbp + col0 + bj * HALF); l1[bj] = *(const f32x4*)(lbp + col0 + bj * HALF + 4); }
        }
#pragma unroll
        for (int ai = 0; ai < 2; ++ai)
#pragma unroll
            for (int m = 0; m < 4; ++m) { bf16* rowp = base + (size_t)(row0 + ai * HALF + m * 16) * ldc + col0;
#pragma unroll
                for (int bj = 0; bj < 2; ++bj) { f32x4 v0 = acc[ai][bj][m][0], v1 = acc[ai][bj][m][1]; u32x4 w;
                    if (kind == 3) {
#pragma unroll
                        for (int j = 0; j < 4; ++j) { v0[j] = __builtin_amdgcn_logf(l0[bj][j] + (1.0f - l0[bj][j]) * sigmoidf_(v0[j])); v1[j] = __builtin_amdgcn_logf(l1[bj][j] + (1.0f - l1[bj][j]) * sigmoidf_(v1[j])); }
                        w.x = pkh2(v0[0], v0[1]); w.y = pkh2(v0[2], v0[3]); w.z = pkh2(v1[0], v1[1]); w.w = pkh2(v1[2], v1[3]);
                    } else {
                        if (kind == 1) {
#pragma unroll
                            for (int j = 0; j < 4; ++j) { v0[j] = siluf_(v0[j]); v1[j] = siluf_(v1[j]); }
                        } else if (kind == 2) {
#pragma unroll
                            for (int j = 0; j < 4; ++j) { v0[j] = sigmoidf_(v0[j]); v1[j] = sigmoidf_(v1[j]); }
                        }
                        w.x = cvt_pk_bf16(v0[0], v0[1]); w.y = cvt_pk_bf16(v0[2], v0[3]); w.z = cvt_pk_bf16(v1[0], v1[1]); w.w = cvt_pk_bf16(v1[2], v1[3]);
                    }
                    *(u32x4*)(rowp + bj * HALF) = w; } }
    }
};
struct EpiGateA {
    static constexpr bool PERM = true;
    bf16* GA;
    __device__ __forceinline__ void operator()(const f32x4 (&acc)[2][2][4][2], const Unit& u, int wr, int wc, int fr, int fq) const {
        const int row0 = u.pm * BM + wr * 64 + fr, col0 = u.pn * BM + wc * 32 + 8 * fq;
#pragma unroll
        for (int ai = 0; ai < 2; ++ai)
#pragma unroll
            for (int m = 0; m < 4; ++m) { bf16* rowp = GA + (size_t)(row0 + ai * HALF + m * 16) * D + col0;
#pragma unroll
                for (int bj = 0; bj < 2; ++bj) { const f32x4 v0 = acc[ai][bj][m][0], v1 = acc[ai][bj][m][1]; const u32x4 gw = *(const u32x4*)(rowp + bj * HALF); u32x4 w;
                    w.x = cvt_pk_bf16(v0[0] * bflo(gw.x), v0[1] * bfhi(gw.x)); w.y = cvt_pk_bf16(v0[2] * bflo(gw.y), v0[3] * bfhi(gw.y));
                    w.z = cvt_pk_bf16(v1[0] * bflo(gw.z), v1[1] * bfhi(gw.z)); w.w = cvt_pk_bf16(v1[2] * bflo(gw.w), v1[3] * bfhi(gw.w));
                    *(u32x4*)(rowp + bj * HALF) = w; }
                if (m & 1) asm volatile("" ::: "memory"); }
    }
};
struct EpiGateB {
    static constexpr bool PERM = true;
    const bf16* T; bf16* GBT;
    __device__ __forceinline__ void operator()(const f32x4 (&acc)[2][2][4][2], const Unit& u, int wr, int wc, int fr, int fq) const {
        const int row0 = u.pm * BM + wr * 64 + fr, col0 = u.pn * BM + wc * 32 + 8 * fq;
#pragma unroll
        for (int ai = 0; ai < 2; ++ai)
#pragma unroll
            for (int m = 0; m < 4; ++m) { const size_t off = (size_t)(row0 + ai * HALF + m * 16) * D + col0;
#pragma unroll
                for (int bj = 0; bj < 2; ++bj) { const f32x4 v0 = acc[ai][bj][m][0], v1 = acc[ai][bj][m][1];
                    const u32x4 gw = *(const u32x4*)(GBT + off + bj * HALF), tw = *(const u32x4*)(T + off + bj * HALF); u32x4 w;
                    w.x = cvt_pk_bf16(bflo(tw.x) + v0[0] * bflo(gw.x), bfhi(tw.x) + v0[1] * bfhi(gw.x)); w.y = cvt_pk_bf16(bflo(tw.y) + v0[2] * bflo(gw.y), bfhi(tw.y) + v0[3] * bfhi(gw.y));
                    w.z = cvt_pk_bf16(bflo(tw.z) + v1[0] * bflo(gw.z), bfhi(tw.z) + v1[1] * bfhi(gw.z)); w.w = cvt_pk_bf16(bflo(tw.w) + v1[2] * bflo(gw.w), bfhi(tw.w) + v1[3] * bfhi(gw.w));
                    *(u32x4*)(GBT + off + bj * HALF) = w; }
                asm volatile("" ::: "memory"); }
    }
};
struct EpiResid {
    static constexpr bool PERM = false;
    const float* X; float* O; const float* g1;
    __device__ __forceinline__ void operator()(const f32x4 (&acc)[2][2][4][2], const Unit& u, int wr, int wc, int fr, int fq) const {
        const int row0 = u.pm * BM + wr * 64 + fr, col0 = u.pn * BM + wc * 32 + 4 * fq;
        f32x4 gv[2][2];
#pragma unroll
        for (int bj = 0; bj < 2; ++bj)
#pragma unroll
            for (int n = 0; n < 2; ++n) gv[bj][n] = *(const f32x4*)(g1 + col0 + bj * HALF + n * 16);
#pragma unroll
        for (int ai = 0; ai < 2; ++ai)
#pragma unroll
            for (int m = 0; m < 4; ++m) { const size_t off = (size_t)(row0 + ai * HALF + m * 16) * D + col0;
#pragma unroll
                for (int bj = 0; bj < 2; ++bj)
#pragma unroll
                    for (int n = 0; n < 2; ++n) { const f32x4 xv = *(const f32x4*)(X + off + bj * HALF + n * 16); *(f32x4*)(O + off + bj * HALF + n * 16) = xv + gv[bj][n] * acc[ai][bj][m][n]; }
                asm volatile("" ::: "memory"); }
    }
};
struct EpiHid {
    static constexpr bool PERM = true;
    bf16* H;
    __device__ __forceinline__ void operator()(const f32x4 (&acc)[2][2][4][2], const Unit& u, int wr, int wc, int fr, int fq) const {
        const int row0 = wr * 64 + fr, col0 = u.pn * HALF + wc * 32 + 8 * fq;
#pragma unroll
        for (int ai = 0; ai < 2; ++ai)
#pragma unroll
            for (int m = 0; m < 4; ++m) { bf16* rowp = H + (size_t)(row0 + ai * HALF + m * 16) * FF + col0;
                const f32x4 g0 = acc[ai][0][m][0], g1 = acc[ai][0][m][1], u0 = acc[ai][1][m][0], u1 = acc[ai][1][m][1]; u32x4 w;
                w.x = cvt_pk_bf16(siluf_(g0[0]) * u0[0], siluf_(g0[1]) * u0[1]); w.y = cvt_pk_bf16(siluf_(g0[2]) * u0[2], siluf_(g0[3]) * u0[3]);
                w.z = cvt_pk_bf16(siluf_(g1[0]) * u1[0], siluf_(g1[1]) * u1[1]); w.w = cvt_pk_bf16(siluf_(g1[2]) * u1[2], siluf_(g1[3]) * u1[3]);
                *(u32x4*)rowp = w; }
    }
};
struct EpiDown {
    static constexpr bool PERM = true;
    bf16* Y; const float* vals;
    __device__ __forceinline__ void operator()(const f32x4 (&acc)[2][2][4][2], const Unit& u, int wr, int wc, int fr, int fq) const {
        const int row0 = wr * 64 + fr, col0 = u.pn * BM + wc * 32 + 8 * fq;
#pragma unroll
        for (int ai = 0; ai < 2; ++ai)
#pragma unroll
            for (int m = 0; m < 4; ++m) { const int r = row0 + ai * HALF + m * 16; const float s = vals[r]; bf16* rowp = Y + (size_t)r * D + col0;
#pragma unroll
                for (int bj = 0; bj < 2; ++bj) { const f32x4 v0 = acc[ai][bj][m][0] * s, v1 = acc[ai][bj][m][1] * s; u32x4 w;
                    w.x = cvt_pk_bf16(v0[0], v0[1]); w.y = cvt_pk_bf16(v0[2], v0[3]); w.z = cvt_pk_bf16(v1[0], v1[1]); w.w = cvt_pk_bf16(v1[2], v1[3]);
                    *(u32x4*)(rowp + bj * HALF) = w; } }
    }
};
}

constexpr int RING_BYTES = 131072;
constexpr int LDS_BYTES = 147456;

struct Args {
    const float* in[21]; float* out; unsigned char* ws; int ph_lo, ph_hi;
};

__device__ __forceinline__ void transpose_item(const float* W, int K, int N, bf16* WT, int k0, int n0, int drow0, LAS float* scr, int lane) {
#pragma unroll 8
    for (int i = 0; i < 32; ++i) { const int kk = 2 * i + (lane >> 5); scr[kk * 33 + (lane & 31)] = W[(size_t)(k0 + kk) * N + n0 + (lane & 31)]; }
    LDS_WAIT(); asm volatile("" ::: "memory");
    const int c = lane & 7;
#pragma unroll
    for (int j = 0; j < 4; ++j) { const int n = (lane >> 3) + 8 * j; const LAS float* s = scr + (8 * c) * 33 + n;
        v4u o; o.x = pk2(s[0 * 33], s[1 * 33]); o.y = pk2(s[2 * 33], s[3 * 33]); o.z = pk2(s[4 * 33], s[5 * 33]); o.w = pk2(s[6 * 33], s[7 * 33]);
        *(v4u*)(WT + (size_t)(drow0 + n) * K + k0 + 8 * c) = o; }
    LDS_WAIT(); asm volatile("" ::: "memory");
}


typedef _Float16 half8 __attribute__((ext_vector_type(8)));
struct RawChunk { v4u q[2], g[2], v; };
constexpr int P3_QP = 272, P3_SP = 144;
constexpr int P3_QT = 0, P3_KT = 17408, P3_KTT = 34816, P3_VT = 53248, P3_AM = 62464, P3_SB = 71680, P3_GR = 89088, P3_QR = 106496;
constexpr int P3_NCH = (CTXL + SEQ) / 64;

__device__ __forceinline__ void p3_load(RawChunk& R, int c, int b, int h, int vh, int dir, int w, int lane, const bf16* Qp, const bf16* Vp, const bf16* Gp) {
    c = c < P3_NCH ? c : P3_NCH - 1;
    const int rstep = dir ? -1 : 1;
    const long rbase = (c < 4) ? (long)M + b * CTXL + (dir ? CTXL - 1 - 64 * c : 64 * c) : (long)b * SEQ + (dir ? SEQ - 1 - 64 * (c - 4) : 64 * (c - 4));
    const long qbase = (c < 4) ? (long)b * SEQ + (dir ? 63 : 0) : rbase;
#pragma unroll
    for (int i = 0; i < 2; ++i) { const int t = 8 * w + 4 * i + (lane >> 4);
        R.g[i] = *(const v4u*)(Gp + (rbase + rstep * t) * D + h * HD + 8 * (lane & 15));
        R.q[i] = *(const v4u*)(Qp + (qbase + rstep * t) * D + h * HD + 8 * (lane & 15)); }
    R.v = *(const v4u*)(Vp + (rbase + rstep * (8 * w + (lane >> 3))) * D + h * HD + vh * 64 + 8 * (lane & 7));
}

__device__ __forceinline__ void p3_chunk(LAS unsigned char* lds, const RawChunk& R, int c, f32x4 (&Sacc)[4], float (&bend_prev)[4], const half8& Bm0, const half8& Bm1, const half8& Bone,
                                         int b, int h, int vh, int dir, int w, int fr, int fq, int lane, bf16* Op) {
    const bool isx = c >= 4;
#pragma unroll
    for (int i = 0; i < 2; ++i) { const int t = 8 * w + 4 * i + (lane >> 4);
        *(LAS v4u*)(lds + P3_GR + t * P3_QP + 16 * (lane & 15)) = R.g[i];
        *(LAS v4u*)(lds + P3_QR + t * P3_QP + 16 * (lane & 15)) = R.q[i]; }
    {
        const unsigned vw[4] = {R.v.x, R.v.y, R.v.z, R.v.w}; const int s = 8 * w + (lane >> 3);
#pragma unroll
        for (int j = 0; j < 8; ++j) *(LAS unsigned short*)(lds + P3_VT + (8 * (lane & 7) + j) * P3_SP + s * 2) = (unsigned short)(vw[j >> 1] >> (16 * (j & 1)));
    }
    LDS_WAIT(); __syncthreads();
    half8 gA0, gA1;
#pragma unroll
    for (int j = 0; j < 8; ++j) { gA0[j] = __builtin_bit_cast(_Float16, *(const LAS unsigned short*)(lds + P3_GR + (8 * fq + j) * P3_QP + (16 * w + fr) * 2));
                                  gA1[j] = __builtin_bit_cast(_Float16, *(const LAS unsigned short*)(lds + P3_GR + (32 + 8 * fq + j) * P3_QP + (16 * w + fr) * 2)); }
    v2u g4[4], q4[4];
#pragma unroll
    for (int tt = 0; tt < 4; ++tt) { g4[tt] = *(const LAS v2u*)(lds + P3_GR + (16 * tt + fr) * P3_QP + (16 * w + 4 * fq) * 2); q4[tt] = *(const LAS v2u*)(lds + P3_QR + (16 * tt + fr) * P3_QP + (16 * w + 4 * fq) * 2); }
    f32x4 bacc[4]; const f32x4 z4 = (f32x4){0.f, 0.f, 0.f, 0.f};
    bacc[0] = __builtin_amdgcn_mfma_f32_16x16x32_f16(gA0, Bm0, z4, 0, 0, 0);
    bacc[1] = __builtin_amdgcn_mfma_f32_16x16x32_f16(gA0, Bm1, z4, 0, 0, 0);
    bacc[2] = __builtin_amdgcn_mfma_f32_16x16x32_f16(gA0, Bone, z4, 0, 0, 0); bacc[2] = __builtin_amdgcn_mfma_f32_16x16x32_f16(gA1, Bm0, bacc[2], 0, 0, 0);
    bacc[3] = __builtin_amdgcn_mfma_f32_16x16x32_f16(gA0, Bone, z4, 0, 0, 0); bacc[3] = __builtin_amdgcn_mfma_f32_16x16x32_f16(gA1, Bm1, bacc[3], 0, 0, 0);
    const int src15 = (lane & 48) | 15;
    float br[4], scale[4];
#pragma unroll
    for (int i = 0; i < 4; ++i) { br[i] = __shfl(bacc[1][i], src15); const float be = __shfl(bacc[3][i], src15); scale[i] = __builtin_amdgcn_exp2f(bend_prev[i] + br[i]); bend_prev[i] = be - br[i]; }
#pragma unroll
    for (int vt = 0; vt < 4; ++vt) {
#pragma unroll
        for (int i = 0; i < 4; ++i) Sacc[vt][i] *= scale[i];
        if (isx) { v2u o; o.x = pk2(Sacc[vt][0], Sacc[vt][1]); o.y = pk2(Sacc[vt][2], Sacc[vt][3]); *(LAS v2u*)(lds + P3_SB + (16 * vt + fr) * P3_QP + (16 * w + 4 * fq) * 2) = o; }
    }
#pragma unroll
    for (int tt = 0; tt < 4; ++tt) {
        const unsigned gw[2] = {g4[tt].x, g4[tt].y}, qw[2] = {q4[tt].x, q4[tt].y};
        float qt[4], kt[4];
#pragma unroll
        for (int i = 0; i < 4; ++i) {
            const float g = h2f((unsigned short)(gw[i >> 1] >> (16 * (i & 1)))), q = (i & 1) ? bfhi(qw[i >> 1]) : bflo(qw[i >> 1]);
            const float f = __builtin_amdgcn_exp2f(g), beta = bacc[tt][i] - br[i];
            qt[i] = q * __builtin_amdgcn_exp2f(beta); kt[i] = (1.0f - f) * __builtin_amdgcn_exp2f(-beta);
        }
        const int t = 16 * tt + fr;
        unsigned short kb[4];
#pragma unroll
        for (int i = 0; i < 4; ++i) kb[i] = (unsigned short)f2bf(kt[i]);
        if (isx) {
            v2u o; o.x = pk2(qt[0], qt[1]); o.y = pk2(qt[2], qt[3]); *(LAS v2u*)(lds + P3_QT + t * P3_QP + (16 * w + 4 * fq) * 2) = o;
            v2u k2; k2.x = (unsigned)kb[0] | ((unsigned)kb[1] << 16); k2.y = (unsigned)kb[2] | ((unsigned)kb[3] << 16); *(LAS v2u*)(lds + P3_KT + t * P3_QP + (16 * w + 4 * fq) * 2) = k2;
        }
#pragma unroll
        for (int i = 0; i < 4; ++i) *(LAS unsigned short*)(lds + P3_KTT + (16 * w + 4 * fq + i) * P3_SP + t * 2) = kb[i];
    }
    LDS_WAIT(); __syncthreads();
    if (isx) {
        const int tt = w >> 1;
        bf16x8 qf[4];
#pragma unroll
        for (int ks = 0; ks < 4; ++ks) qf[ks] = *(const LAS bf16x8*)(lds + P3_QT + (16 * tt + fr) * P3_QP + (32 * ks + 8 * fq) * 2);
#pragma unroll
        for (int k2 = 0; k2 < 2; ++k2) {
            const int st = 2 * (w & 1) + k2;
            f32x4 sc = (f32x4){0.f, 0.f, 0.f, 0.f};
            if (st <= tt) {
#pragma unroll
                for (int ks = 0; ks < 4; ++ks) { const bf16x8 kf = *(const LAS bf16x8*)(lds + P3_KT + (16 * st + fr) * P3_QP + (32 * ks + 8 * fq) * 2);
                    sc = __builtin_amdgcn_mfma_f32_16x16x32_bf16(kf, qf[ks], sc, 0, 0, 0); }
                const int tpos = 16 * tt + fr, s0 = 16 * st + 4 * fq;
#pragma unroll
                for (int i = 0; i < 4; ++i) if (s0 + i > tpos) sc[i] = 0.f;
            }
            v2u o; o.x = pk2(sc[0], sc[1]); o.y = pk2(sc[2], sc[3]);
            *(LAS v2u*)(lds + P3_AM + (16 * tt + fr) * P3_SP + (16 * st + 4 * fq) * 2) = o;
        }
    }
    f32x4 oacc[2]; oacc[0] = (f32x4){0.f, 0.f, 0.f, 0.f}; oacc[1] = oacc[0];
    const int vto = w & 3, tt0 = 2 * (w >> 2);
    if (isx) {
#pragma unroll
        for (int ks = 0; ks < 4; ++ks) { const bf16x8 sf = *(const LAS bf16x8*)(lds + P3_SB + (16 * vto + fr) * P3_QP + (32 * ks + 8 * fq) * 2);
#pragma unroll
            for (int k2 = 0; k2 < 2; ++k2) { const bf16x8 qf = *(const LAS bf16x8*)(lds + P3_QT + (16 * (tt0 + k2) + fr) * P3_QP + (32 * ks + 8 * fq) * 2);
                oacc[k2] = __builtin_amdgcn_mfma_f32_16x16x32_bf16(sf, qf, oacc[k2], 0, 0, 0); } }
    }
    {
        bf16x8 kf[2];
#pragma unroll
        for (int ks = 0; ks < 2; ++ks) kf[ks] = *(const LAS bf16x8*)(lds + P3_KTT + (16 * w + fr) * P3_SP + (32 * ks + 8 * fq) * 2);
#pragma unroll
        for (int vt = 0; vt < 4; ++vt)
#pragma unroll
            for (int ks = 0; ks < 2; ++ks) { const bf16x8 vf = *(const LAS bf16x8*)(lds + P3_VT + (16 * vt + fr) * P3_SP + (32 * ks + 8 * fq) * 2);
                Sacc[vt] = __builtin_amdgcn_mfma_f32_16x16x32_bf16(kf[ks], vf, Sacc[vt], 0, 0, 0); }
    }
    if (isx) {
        LDS_WAIT(); __syncthreads();
#pragma unroll
        for (int ks = 0; ks < 2; ++ks) { const bf16x8 vf = *(const LAS bf16x8*)(lds + P3_VT + (16 * vto + fr) * P3_SP + (32 * ks + 8 * fq) * 2);
#pragma unroll
            for (int k2 = 0; k2 < 2; ++k2) { const bf16x8 af = *(const LAS bf16x8*)(lds + P3_AM + (16 * (tt0 + k2) + fr) * P3_SP + (32 * ks + 8 * fq) * 2);
                oacc[k2] = __builtin_amdgcn_mfma_f32_16x16x32_bf16(vf, af, oacc[k2], 0, 0, 0); } }
        const long xb = (long)b * SEQ + (dir ? SEQ - 1 - 64 * (c - 4) : 64 * (c - 4)); const int rstep = dir ? -1 : 1;
#pragma unroll
        for (int k2 = 0; k2 < 2; ++k2) { const long row = xb + rstep * (16 * (tt0 + k2) + fr);
            v2u o; o.x = pk2(oacc[k2][0], oacc[k2][1]); o.y = pk2(oacc[k2][2], oacc[k2][3]);
            *(v2u*)(Op + row * D + h * HD + vh * 64 + 16 * vto + 4 * fq) = o; }
    }
    LDS_WAIT(); __syncthreads();
}

__device__ __forceinline__ void p3_unit(LAS unsigned char* lds, int unit, const bf16* QB, const bf16* VB, const bf16* GF, const bf16* GBK, bf16* OF, bf16* OB, int tid) {
    asm volatile("" : "+v"(tid));
    const int lane = tid & 63, w = __builtin_amdgcn_readfirstlane(tid >> 6), fr = lane & 15, fq = lane >> 4;
    const int vh = unit & 1, dir = (unit >> 1) & 1, h = (unit >> 2) & 7, b = unit >> 5;
    const bf16* Gp = dir ? GBK : GF; bf16* Op = dir ? OB : OF;
    half8 Bm0, Bm1, Bone;
#pragma unroll
    for (int j = 0; j < 8; ++j) { Bm0[j] = (8 * fq + j <= fr) ? (_Float16)1.0f : (_Float16)0.0f; Bm1[j] = (8 * fq + j <= 16 + fr) ? (_Float16)1.0f : (_Float16)0.0f; Bone[j] = (_Float16)1.0f; }
    f32x4 Sacc[4]; float bend_prev[4];
#pragma unroll
    for (int i = 0; i < 4; ++i) { Sacc[i] = (f32x4){0.f, 0.f, 0.f, 0.f}; bend_prev[i] = 0.f; }
    RawChunk RA, RB;
    p3_load(RA, 0, b, h, vh, dir, w, lane, QB, VB, Gp);
#pragma unroll 1
    for (int c = 0; c < P3_NCH; c += 2) {
        p3_load(RB, c + 1, b, h, vh, dir, w, lane, QB, VB, Gp);
        p3_chunk(lds, RA, c, Sacc, bend_prev, Bm0, Bm1, Bone, b, h, vh, dir, w, fr, fq, lane, Op);
        p3_load(RA, c + 2, b, h, vh, dir, w, lane, QB, VB, Gp);
        p3_chunk(lds, RB, c + 1, Sacc, bend_prev, Bm0, Bm1, Bone, b, h, vh, dir, w, fr, fq, lane, Op);
    }
}

__device__ __forceinline__ void p4_build_aa(int slab, const bf16* OF, const bf16* OB, const bf16* OG, const float* hgrn_g, bf16* AA, int tid) {
    asm volatile("" : "+v"(tid));
    const int lane = tid & 63, wave = __builtin_amdgcn_readfirstlane(tid >> 6), row0 = slab * 256;
    float hg[16];
#pragma unroll
    for (int i = 0; i < 4; ++i) { const f32x4 t = *(const f32x4*)(hgrn_g + 16 * (lane & 7) + 4 * i); hg[4 * i] = t.x; hg[4 * i + 1] = t.y; hg[4 * i + 2] = t.z; hg[4 * i + 3] = t.w; }
    for (int r = wave * 32; r < wave * 32 + 32; ++r) {
        const size_t off = (size_t)(row0 + r) * D + 16 * lane;
        const v4u f0 = *(const v4u*)(OF + off), f1 = *(const v4u*)(OF + off + 8), b0 = *(const v4u*)(OB + off), b1 = *(const v4u*)(OB + off + 8);
        const v4u g0 = *(const v4u*)(OG + off), g1 = *(const v4u*)(OG + off + 8);
        float o[16], gg[16];
        const unsigned fw[8] = {f0.x, f0.y, f0.z, f0.w, f1.x, f1.y, f1.z, f1.w}, bw[8] = {b0.x, b0.y, b0.z, b0.w, b1.x, b1.y, b1.z, b1.w}, gw8[8] = {g0.x, g0.y, g0.z, g0.w, g1.x, g1.y, g1.z, g1.w};
        float ss = 0.f;
#pragma unroll
        for (int i = 0; i < 8; ++i) { o[2 * i] = bflo(fw[i]) + bflo(bw[i]); o[2 * i + 1] = bfhi(fw[i]) + bfhi(bw[i]); gg[2 * i] = bflo(gw8[i]); gg[2 * i + 1] = bfhi(gw8[i]); ss += o[2 * i] * o[2 * i] + o[2 * i + 1] * o[2 * i + 1]; }
        ss += __shfl_xor(ss, 1); ss += __shfl_xor(ss, 2); ss += __shfl_xor(ss, 4);
        const float rstd = rsqrtf(ss * (1.0f / HD) + EPS);
        unsigned w[8];
#pragma unroll
        for (int i = 0; i < 8; ++i) w[i] = pk2((o[2 * i] * rstd * hg[2 * i]) * gg[2 * i], (o[2 * i + 1] * rstd * hg[2 * i + 1]) * gg[2 * i + 1]);
        *(v4u*)(AA + off) = (v4u){w[0], w[1], w[2], w[3]}; *(v4u*)(AA + off + 8) = (v4u){w[4], w[5], w[6], w[7]};
    }
}
__device__ __forceinline__ void p4_pool(LAS unsigned char* lds, int slab, const bf16* PB, bf16* RB, int tid) {
    asm volatile("" : "+v"(tid));
    LAS float* T = (LAS float*)lds; constexpr int TP = 68;
    const int b = slab / 32, row0 = slab * 256, gr0 = 4 * (slab % 32);
#pragma unroll 1
    for (int jh = 0; jh < 8; ++jh) {
        const int j = jh >> 1, hh = jh & 1, w = 2 << j, chb = j * 128 + hh * 64;
        { const int q = tid & 1, cc = (tid >> 1) & 63, r = tid >> 7; const int R = gr0 + r;
          int R0 = R - w / 2; R0 = R0 < 0 ? 0 : R0; int R1 = R + w / 2 - 1; R1 = (R1 > GRID_H - 1 ? GRID_H - 1 : R1) + 1;
          float a[32];
#pragma unroll
          for (int i = 0; i < 32; ++i) a[i] = 0.f;
#pragma unroll 1
          for (int rr = R0; rr < R1; ++rr) { const bf16* src = PB + ((size_t)b * SEQ + rr * GRID_W + cc) * PW + chb + q * 32;
#pragma unroll
              for (int k = 0; k < 4; ++k) { const v4u u = *(const v4u*)(src + 8 * k); a[8 * k + 0] += bflo(u.x); a[8 * k + 1] += bfhi(u.x); a[8 * k + 2] += bflo(u.y); a[8 * k + 3] += bfhi(u.y);
                  a[8 * k + 4] += bflo(u.z); a[8 * k + 5] += bfhi(u.z); a[8 * k + 6] += bflo(u.w); a[8 * k + 7] += bfhi(u.w); } }
          LAS float* dst = T + (r * 64 + cc) * TP + q * 32;
#pragma unroll
          for (int k = 0; k < 8; ++k) *(LAS f32x4*)(dst + 4 * k) = (f32x4){a[4 * k], a[4 * k + 1], a[4 * k + 2], a[4 * k + 3]}; }
        __syncthreads();
        { const int q = tid & 1, tl = tid >> 1, r = tl >> 6, cc = tl & 63; const int R = gr0 + r;
          int R0 = R - w / 2; R0 = R0 < 0 ? 0 : R0; int R1 = R + w / 2 - 1; R1 = (R1 > GRID_H - 1 ? GRID_H - 1 : R1) + 1;
          int C0 = cc - w / 2; C0 = C0 < 0 ? 0 : C0; int C1 = cc + w / 2 - 1; C1 = (C1 > GRID_W - 1 ? GRID_W - 1 : C1) + 1;
          const float inv = 1.0f / (float)((R1 - R0) * (C1 - C0));
          float s[32];
#pragma unroll
          for (int i = 0; i < 32; ++i) s[i] = 0.f;
#pragma unroll 1
          for (int c2 = C0; c2 < C1; ++c2) { const LAS float* src = T + (r * 64 + c2) * TP + q * 32;
#pragma unroll
              for (int k = 0; k < 8; ++k) { const f32x4 t4 = *(const LAS f32x4*)(src + 4 * k); s[4 * k] += t4.x; s[4 * k + 1] += t4.y; s[4 * k + 2] += t4.z; s[4 * k + 3] += t4.w; } }
          const size_t po = (size_t)(row0 + tl) * PW + chb + q * 32;
#pragma unroll
          for (int k = 0; k < 4; ++k) { const v4u u = *(const v4u*)(PB + po + 8 * k); v4u o;
              o.x = pk2(s[8 * k + 0] * inv - bflo(u.x), s[8 * k + 1] * inv - bfhi(u.x)); o.y = pk2(s[8 * k + 2] * inv - bflo(u.y), s[8 * k + 3] * inv - bfhi(u.y));
              o.z = pk2(s[8 * k + 4] * inv - bflo(u.z), s[8 * k + 5] * inv - bfhi(u.z)); o.w = pk2(s[8 * k + 6] * inv - bflo(u.w), s[8 * k + 7] * inv - bfhi(u.w));
              *(v4u*)(RB + po + 8 * k) = o; } }
        __syncthreads();
    }
}
__device__ __forceinline__ void p4_rows(LAS unsigned char* lds, int slab, const float* NEWHX, const float* modb, const float* norm2_g, const float* w_router, bf16* VX, float* PROBS, int tid) {
    asm volatile("" : "+v"(tid));
    const int lane = tid & 63, wave = __builtin_amdgcn_readfirstlane(tid >> 6), row0 = slab * 256;
    LAS float* W2 = (LAS float*)lds;
    LAS float* rstd_s = W2 + D * NE;
    LAS float* bias_s = rstd_s + 256;
    const float* sh2 = modb + 3 * D; const float* sc2 = modb + 4 * D;
    for (int e4 = tid; e4 < D * NE; e4 += NTHR) { const int c = e4 >> 4, e = e4 & 15;
        W2[(((c >> 4) * 4 + ((c >> 2) & 3)) * 16 + e) * 4 + (c & 3)] = norm2_g[c] * (1.0f + sc2[c]) * w_router[e4]; }
    { const int e = tid & 15, part = tid >> 4; float a = 0.f;
      for (int c = part * 32; c < part * 32 + 32; ++c) a += sh2[c] * w_router[c * NE + e];
      bias_s[e * 32 + part] = a; }
#pragma unroll 1
    for (int r = wave * 32; r < wave * 32 + 32; ++r) {
        const int row = row0 + r; const float* src = NEWHX + (size_t)row * D;
        f32x4 v[4]; float ss = 0.f;
#pragma unroll
        for (int j = 0; j < 4; ++j) { v[j] = *(const f32x4*)(src + 4 * lane + 256 * j); ss += (v[j].x * v[j].x + v[j].y * v[j].y) + (v[j].z * v[j].z + v[j].w * v[j].w); }
        const float rstd = rsqrtf(wave_sum(ss) * (1.0f / D) + EPS);
        if (lane == 0) rstd_s[r] = rstd;
#pragma unroll
        for (int j = 0; j < 4; ++j) { const int c = 4 * lane + 256 * j; const f32x4 g = *(const f32x4*)(norm2_g + c), sc = *(const f32x4*)(sc2 + c), sh = *(const f32x4*)(sh2 + c);
            const f32x4 o = (v[j] * rstd * g) * (sc + 1.0f) + sh;
            v2u w; w.x = pk2(o.x, o.y); w.y = pk2(o.z, o.w); *(v2u*)(VX + (size_t)row * D + c) = w; }
    }
    __syncthreads();
    if (tid < 16) { float a = 0.f; for (int p = 0; p < 32; ++p) a += bias_s[tid * 32 + p]; bias_s[512 + tid] = a; }
    __syncthreads();
    const int fr = lane & 15, fq = lane >> 4;
#pragma unroll 1
    for (int grp = wave * 2; grp < wave * 2 + 2; ++grp) {
        const float* arow = NEWHX + (size_t)(row0 + grp * 16 + fr) * D + 4 * fq;
        f32x4 acc = (f32x4){0.f, 0.f, 0.f, 0.f};
#pragma unroll 4
        for (int s = 0; s < 64; ++s) { const f32x4 a = *(const f32x4*)(arow + 16 * s); const f32x4 w = *(const LAS f32x4*)(W2 + ((s * 4 + fq) * 16 + fr) * 4);
            acc = __builtin_amdgcn_mfma_f32_16x16x4f32(a.x, w.x, acc, 0, 0, 0); acc = __builtin_amdgcn_mfma_f32_16x16x4f32(a.y, w.y, acc, 0, 0, 0);
            acc = __builtin_amdgcn_mfma_f32_16x16x4f32(a.z, w.z, acc, 0, 0, 0); acc = __builtin_amdgcn_mfma_f32_16x16x4f32(a.w, w.w, acc, 0, 0, 0); }
        const float be = bias_s[512 + fr];
#pragma unroll
        for (int i = 0; i < 4; ++i) { const int r = grp * 16 + 4 * fq + i; float lg = acc[i] * rstd_s[r] + be;
            float mx = lg; mx = fmaxf(mx, __shfl_xor(mx, 1)); mx = fmaxf(mx, __shfl_xor(mx, 2)); mx = fmaxf(mx, __shfl_xor(mx, 4)); mx = fmaxf(mx, __shfl_xor(mx, 8));
            const float ex = __expf(lg - mx); float sm = ex; sm += __shfl_xor(sm, 1); sm += __shfl_xor(sm, 2); sm += __shfl_xor(sm, 4); sm += __shfl_xor(sm, 8);
            PROBS[(size_t)(row0 + r) * NE + fr] = ex / sm; }
    }
    __syncthreads();
}

__global__ void __launch_bounds__(NTHR) mega(Args args) {
    extern __shared__ __attribute__((aligned(16))) unsigned char lds_raw[];
    LAS unsigned char* lds = (LAS unsigned char*)lds_raw;
    const int tid = threadIdx.x, lane = tid & 63, wave = __builtin_amdgcn_readfirstlane(tid >> 6);
    const int G = gridDim.x, bx = blockIdx.x;
    const int vcu = (G % 8 == 0) ? (bx % 8) * (G / 8) + bx / 8 : bx;
    const int gw = vcu * NWAVES + wave, NGW = G * NWAVES;
    unsigned char* ws = args.ws; unsigned char* dout = (unsigned char*)args.out;
    const float* x = args.in[0]; const float* cvec = args.in[1]; const float* ctx = args.in[2]; const float* c_ctx = args.in[3];
    const float* lb_logits = args.in[4]; const float* w_mod = args.in[5]; const float* b_mod = args.in[6]; const float* norm1_g = args.in[7];
    const float* w_in = args.in[8]; const float* hgrn_g = args.in[9]; const float* w_a = args.in[10]; const float* w_pool = args.in[11];
    const float* pool_scale = args.in[12]; const float* w_b = args.in[13]; const float* w_out = args.in[14]; const float* norm2_g = args.in[15];
    const float* w_router = args.in[16]; const float* w_e_gate = args.in[17]; const float* w_e_up = args.in[18]; const float* w_e_down = args.in[19];
    const float* final_g = args.in[20];
    float* MOD = (float*)(ws + WS_MOD); float* MODP = (float*)(ws + WS_MODP); float* LB = (float*)(ws + WS_LB);
    int* IDX = (int*)(ws + WS_IDX); float* VALS = (float*)(ws + WS_VALS); float* PROBS = (float*)(ws + WS_PROBS); int* INV = (int*)(ws + WS_INV);
    bf16* WIN = (bf16*)(ws + WS_WIN); bf16* WA = (bf16*)(ws + WS_WA); bf16* WP = (bf16*)(ws + WS_WP); bf16* WOUT = (bf16*)(ws + WS_WOUT);
    bf16* QB = (bf16*)(ws + WS_Q); bf16* VB = (bf16*)(ws + WS_V); bf16* GF = (bf16*)(ws + WS_GF); bf16* GBK = (bf16*)(ws + WS_GB);
    bf16* OG = (bf16*)(ws + WS_OG); bf16* PB = (bf16*)(ws + WS_P); bf16* GA = (bf16*)(ws + WS_GA); bf16* GBT = (bf16*)(ws + WS_GBT);
    float* NEWHX = (float*)(ws + WS_NEWHX); bf16* AA = (bf16*)(ws + WS_AA); bf16* VX = (bf16*)(ws + WS_VX); bf16* RB = (bf16*)(ws + WS_R);
    bf16* HID = (bf16*)(ws + WS_HID); bf16* YB = (bf16*)(ws + WS_YB);
    bf16* UX = (bf16*)(dout + DO_UX); bf16* OF = (bf16*)(dout + DO_OF); bf16* OB = (bf16*)(dout + DO_OB); bf16* WGU = (bf16*)(dout + DO_WGU); bf16* WDN = (bf16*)(dout + DO_WDN);
    const int lo = args.ph_lo, hi = args.ph_hi;
#ifndef PHASE_MASK
#define PHASE_MASK 0xff
#endif
#ifndef REPEAT_MASK
#define REPEAT_MASK 0
#endif
#define IN(k) (((PHASE_MASK >> (k)) & 1) && lo <= (k) && (k) < hi)
#define REP(k) for (int rep_ = 0; rep_ < ((REPEAT_MASK >> (k)) & 1) + 1; ++rep_)
    { volatile LAS unsigned* misc = (volatile LAS unsigned*)(lds + RING_BYTES); if (tid < 16) misc[tid] = 0u; }
    __syncthreads();
    XcdBarrier gbar = xcd_barrier_post((unsigned*)(ws + WS_CTL) + 4096, (volatile LAS unsigned*)(lds + RING_BYTES) + 8);
#define SEAM(k) do { if (IN(k) && IN((k) + 1)) { xcd_barrier(gbar); } } while (0)

    if (IN(0)) REP(0) {
        LAS float* scr = (LAS float*)(lds + wave * 16384);
        for (int it = gw; it < 96 * 16; it += NGW) {
            const int cb = it % 96, kp = it / 96, col = cb * 64 + lane, k0 = kp * 64;
            float sv[9];
#pragma unroll
            for (int r = 0; r < 9; ++r) { const float cv = (r < 8) ? cvec[r * D + k0 + lane] : c_ctx[k0 + lane]; sv[r] = siluf_(cv); }
            float acc[9];
#pragma unroll
            for (int r = 0; r < 9; ++r) acc[r] = 0.f;
#pragma unroll 16
            for (int kk = 0; kk < 64; ++kk) { const float w = w_mod[(size_t)(k0 + kk) * (6 * D) + col];
#pragma unroll
                for (int r = 0; r < 9; ++r) acc[r] += __shfl(sv[r], kk) * w; }
#pragma unroll
            for (int r = 0; r < 9; ++r) MODP[((size_t)kp * 9 + r) * (6 * D) + col] = acc[r];
        }
        for (int i = gw * 64 + lane; i < 2 * HD * NH; i += NGW * 64) { const int dir = i >> 10, d = i & 1023; const float l0 = lb_logits[dir * 2048 + d], l1 = lb_logits[dir * 2048 + 1024 + d]; LB[i] = 1.0f / (1.0f + __expf(l1 - l0)); }
        {
            constexpr int I_IN = (D / 64) * (NIN / 32), I_A = (D / 64) * (D / 32), I_OUT = I_A;
            for (int it = gw; it < I_IN + I_A + I_OUT; it += NGW) {
                int r = it;
                if (r < I_IN) { const int nblk = NIN / 32, kb = r / nblk, nb = r % nblk; transpose_item(w_in, D, NIN, WIN, 64 * kb, 32 * nb, 32 * nb, scr, lane); continue; } r -= I_IN;
                if (r < I_A) { const int nblk = D / 32, kb = r / nblk, nb = r % nblk; transpose_item(w_a, D, D, WA, 64 * kb, 32 * nb, 32 * nb, scr, lane); continue; } r -= I_A;
                { const int nblk = D / 32, kb = r / nblk, nb = r % nblk; transpose_item(w_out, D, D, WOUT, 64 * kb, 32 * nb, 32 * nb, scr, lane); }
            }
        }
        for (int it = gw; it < PW * 16; it += NGW) {
            const int k = it >> 4, nb = it & 15, n = nb * 64 + lane, j = k >> 7;
            const float* wp = w_pool + (size_t)k * 128; const float* ps = pool_scale + j * 128; const float* wb = w_b + (size_t)(j * 128) * D + n;
            float a = 0.f;
#pragma unroll 8
            for (int m = 0; m < 128; ++m) a += (wp[m] * ps[m]) * wb[(size_t)m * D];
            WP[(size_t)n * PW + k] = (bf16)f2bf(a);
        }
    }
    SEAM(0);

    if (IN(1)) REP(1) {
        LAS float* shs = (LAS float*)lds; LAS float* scs = shs + D;
        for (int slab = bx; slab < MT / 256; slab += G) {
            const int mrow = slab < M / 256 ? slab / 32 : 8;
            const bool writer = (slab < M / 256) ? (slab % 32 == 0) : (slab == M / 256);
            for (int c = tid; c < (writer ? 6 * D : 2 * D); c += NTHR) {
                float a = b_mod[c];
#pragma unroll
                for (int kp = 0; kp < 16; ++kp) a += MODP[((size_t)kp * 9 + mrow) * (6 * D) + c];
                if (c < D) shs[c] = a; else if (c < 2 * D) scs[c - D] = a;
                if (writer) MOD[mrow * (6 * D) + c] = a;
            }
            __syncthreads();
            for (int r = wave * 32; r < wave * 32 + 32; ++r) {
                const int row = slab * 256 + r;
                const float* src = (row < M) ? x + (size_t)row * D : ctx + (size_t)(row - M) * D;
                f32x4 v[4]; float ss = 0.f;
#pragma unroll
                for (int j = 0; j < 4; ++j) { v[j] = *(const f32x4*)(src + 4 * lane + 256 * j); ss += (v[j].x * v[j].x + v[j].y * v[j].y) + (v[j].z * v[j].z + v[j].w * v[j].w); }
                const float rstd = rsqrtf(wave_sum(ss) * (1.0f / D) + EPS);
#pragma unroll
                for (int j = 0; j < 4; ++j) { const int c = 4 * lane + 256 * j; const f32x4 g = *(const f32x4*)(norm1_g + c);
                    const f32x4 sc = *(const LAS f32x4*)(scs + c), sh = *(const LAS f32x4*)(shs + c);
                    const f32x4 o = (v[j] * rstd * g) * (sc + 1.0f) + sh;
                    v2u w; w.x = pk2(o.x, o.y); w.y = pk2(o.z, o.w); *(v2u*)(UX + (size_t)row * D + c) = w; }
            }
            __syncthreads();
        }
    }
    SEAM(1);

    if (IN(2)) REP(2) {
        pg8::Gemm g{UX, WIN, D, nullptr}; pg8::OrderIn S{G, bx};
        pg8::EpiIn E{QB, VB, GF, GBK, OG, PB, GA, GBT, LB};
        pg8::gemm_phase<pg8::EpiIn, pg8::OrderIn, true, true, false>(lds, g, S, E, tid);
    }
    SEAM(2);

    if (IN(3)) REP(3) {
        for (int unit = vcu; unit < NB * NH * 4; unit += G) p3_unit(lds, unit, QB, VB, GF, GBK, OF, OB, tid);
    }
    SEAM(3);

    if (IN(4)) REP(4) {
        for (int slab = bx; slab < M / 256; slab += G) {
            const int b = slab / 32;
            if (P4M & 1) p4_build_aa(slab, OF, OB, OG, hgrn_g, AA, tid);
            if (P4M & 2) p4_pool(lds, slab, PB, RB, tid);
            wg_fence();
            if (P4M & 4) { const bf16* wb_ = WA; asm volatile("" : "+s"(wb_)); pg8::Gemm g{AA, wb_, D, nullptr}; pg8::OrderRow S{slab, 4}; pg8::EpiGateA E{GA};
              pg8::gemm_phase<pg8::EpiGateA, pg8::OrderRow, true, true, false>(lds, g, S, E, tid); }
            wg_fence();
            if (P4M & 8) { const bf16* wb_ = WP; asm volatile("" : "+s"(wb_)); pg8::Gemm g{RB, wb_, PW, nullptr}; pg8::OrderRow S{slab, 4}; pg8::EpiGateB E{GA, GBT};
              pg8::gemm_phase<pg8::EpiGateB, pg8::OrderRow, true, true, false>(lds, g, S, E, tid); }
            wg_fence();
            if (P4M & 16) { const bf16* wb_ = WOUT; asm volatile("" : "+s"(wb_)); pg8::Gemm g{GBT, wb_, D, nullptr}; pg8::OrderRow S{slab, 4}; pg8::EpiResid E{x, NEWHX, MOD + b * (6 * D) + 2 * D};
              pg8::gemm_phase<pg8::EpiResid, pg8::OrderRow, true, true, false>(lds, g, S, E, tid); }
            wg_fence();
            if (P4M & 32) p4_rows(lds, slab, NEWHX, MOD + b * (6 * D), norm2_g, w_router, VX, PROBS, tid);
        }
    }
    SEAM(4);

    if (IN(5)) REP(5) {
        {
            LAS float* scr = (LAS float*)(lds + wave * 16384);
            constexpr int I_E = (D / 64) * (FF / 32);
            for (int it = gw; it < NE * 3 * I_E; it += NGW) {
                const int e = it / (3 * I_E), r = it % (3 * I_E), which = r / I_E, q = r % I_E, kb = q / (FF / 32), nb = q % (FF / 32), n0 = 32 * nb;
                if (which < 2) transpose_item((which ? w_e_up : w_e_gate) + (size_t)e * D * FF, D, FF, WGU + (size_t)e * 2 * FF * D, 64 * kb, n0, n0 + 128 * (n0 / 128) + 128 * which, scr, lane);
                else transpose_item(w_e_down + (size_t)e * FF * D, FF, D, WDN + (size_t)e * D * FF, 64 * kb, n0, n0, scr, lane);
            }
        }
        __syncthreads();
        {
            LAS unsigned* keys = (LAS unsigned*)lds;
            LAS unsigned* hist = keys + SEQ;
            LAS unsigned* sc = hist + 256;
            LAS unsigned* wsum = sc + 16;
            for (int be = bx; be < NB * NE; be += G) {
                const int b = be / NE, e = be % NE;
                for (int t = tid; t < SEQ; t += NTHR) keys[t] = __builtin_bit_cast(unsigned, PROBS[((size_t)b * SEQ + t) * NE + e]);
                unsigned prefix = 0, mask = 0, kk = CAP;
                for (int pass = 0; pass < 4; ++pass) {
                    const int shift = 24 - 8 * pass;
                    if (tid < 256) hist[tid] = 0;
                    __syncthreads();
                    for (int t = tid; t < SEQ; t += NTHR) { const unsigned k = keys[t]; if ((k & mask) == prefix) __hip_atomic_fetch_add(hist + ((k >> shift) & 255u), 1u, __ATOMIC_RELAXED, __HIP_MEMORY_SCOPE_WORKGROUP); }
                    __syncthreads();
                    if (tid == 0) { unsigned cum = 0; int dsel = 0; unsigned knew = kk;
                        for (int d = 255; d >= 0; --d) { const unsigned hc = hist[d]; if (cum + hc >= kk) { dsel = d; knew = kk - cum; break; } cum += hc; }
                        sc[0] = prefix | ((unsigned)dsel << shift); sc[1] = knew; }
                    __syncthreads();
                    prefix = sc[0]; kk = sc[1]; mask |= (255u << shift);
                    __syncthreads();
                }
                const unsigned thr = prefix, need = kk;
                unsigned cgt = 0, ceq = 0;
#pragma unroll
                for (int i = 0; i < 16; ++i) { const unsigned k = keys[tid * 16 + i]; cgt += (k > thr); ceq += (k == thr); }
                unsigned igt = cgt, ieq = ceq;
#pragma unroll
                for (int o = 1; o < 64; o <<= 1) { const unsigned a = __shfl_up(igt, o), c2 = __shfl_up(ieq, o); if (lane >= o) { igt += a; ieq += c2; } }
                if (lane == 63) { wsum[wave] = igt; wsum[8 + wave] = ieq; }
                __syncthreads();
                unsigned bgt = 0, beq = 0, totgt = 0;
#pragma unroll
                for (int w = 0; w < 8; ++w) { const unsigned a = wsum[w], c2 = wsum[8 + w]; if (w < wave) { bgt += a; beq += c2; } totgt += a; }
                unsigned pgt = bgt + igt - cgt, peq = beq + ieq - ceq;
#pragma unroll
                for (int i = 0; i < 16; ++i) { const int t = tid * 16 + i; const unsigned k = keys[t]; int slot = -1;
                    if (k > thr) { slot = (int)pgt; ++pgt; } else if (k == thr) { if (peq < need) slot = (int)(totgt + peq); ++peq; }
                    INV[((size_t)b * SEQ + t) * NE + e] = slot;
                    if (slot >= 0) { IDX[be * CAP + slot] = b * SEQ + t; VALS[be * CAP + slot] = __builtin_bit_cast(float, k); } }
                __syncthreads();
            }
        }
    }
    SEAM(5);

    if (IN(6)) REP(6) {
        for (int rnd = 0;; ++rnd) {
            int e, b, rt;
            if (G == 256) { if (rnd >= 2) break; const int xcd = bx & 7, loc = bx >> 3; e = 2 * xcd + rnd; b = loc >> 2; rt = loc & 3; }
            else { const int it = bx + rnd * G; if (it >= NB * NE * 4) break; e = it >> 5; b = (it >> 2) & 7; rt = it & 3; }
            const int be = b * NE + e; const size_t r0 = (size_t)be * CAP + rt * 256;
            { pg8::Gemm g{VX, WGU + (size_t)e * 2 * FF * D, D, IDX + r0}; pg8::OrderRow S{0, 8}; pg8::EpiHid E{HID + r0 * FF};
              pg8::gemm_phase<pg8::EpiHid, pg8::OrderRow, true, true, true>(lds, g, S, E, tid); }
            wg_fence();
            { pg8::Gemm g{HID + r0 * FF, WDN + (size_t)e * D * FF, FF, nullptr}; pg8::OrderRow S{0, 4}; pg8::EpiDown E{YB + r0 * D, VALS + r0};
              pg8::gemm_phase<pg8::EpiDown, pg8::OrderRow, true, true, false>(lds, g, S, E, tid); }
        }
    }
    SEAM(6);

    if (IN(7)) REP(7) {
        float* out = args.out;
        for (int row = gw; row < M; row += NGW) {
            const int b = row / SEQ; const float* g2 = MOD + b * (6 * D) + 5 * D;
            f32x4 a[4];
#pragma unroll
            for (int j = 0; j < 4; ++j) a[j] = (f32x4){0.f, 0.f, 0.f, 0.f};
            const int sl = (lane < NE) ? INV[(size_t)row * NE + lane] : -1;
            for (int e = 0; e < NE; ++e) { const int s = __shfl(sl, e);
                if (s >= 0) { const bf16* yr = YB + ((size_t)(b * NE + e) * CAP + s) * D + 4 * lane;
#pragma unroll
                    for (int j = 0; j < 4; ++j) { const v2u u = *(const v2u*)(yr + 256 * j); a[j].x += bflo(u.x); a[j].y += bfhi(u.x); a[j].z += bflo(u.y); a[j].w += bfhi(u.y); } } }
            f32x4 hv[4]; float ss = 0.f;
#pragma unroll
            for (int j = 0; j < 4; ++j) { const int c = 4 * lane + 256 * j; hv[j] = *(const f32x4*)(NEWHX + (size_t)row * D + c) + *(const f32x4*)(g2 + c) * a[j];
                ss += (hv[j].x * hv[j].x + hv[j].y * hv[j].y) + (hv[j].z * hv[j].z + hv[j].w * hv[j].w); }
            const float rstd = rsqrtf(wave_sum(ss) * (1.0f / D) + EPS);
#pragma unroll
            for (int j = 0; j < 4; ++j) { const int c = 4 * lane + 256 * j; *(f32x4*)(out + (size_t)row * D + c) = hv[j] * rstd * *(const f32x4*)(final_g + c); }
        }
    }
#undef IN
#undef SEAM
}

extern "C" void kernel_launch(void* const* d_in, const int* in_sizes, int n_in, void* d_out, int out_size, void* d_ws, size_t ws_size, hipStream_t stream) {
    static int grid = 0;
    if (grid == 0) {
        if (n_in != 21 || in_sizes[0] != M * D || in_sizes[8] != D * NIN || out_size != M * D || ws_size < WS_END) {
            fprintf(stderr, "kernel_launch: unexpected shapes: n_in %d in0 %d in8 %d out %d ws %zu; nothing launched\n", n_in, n_in > 0 ? in_sizes[0] : -1, n_in > 8 ? in_sizes[8] : -1, out_size, ws_size); grid = -1; return; }
        int dev = 0, cus = 0, per_cu = 0;
        if (hipGetDevice(&dev) != hipSuccess || hipDeviceGetAttribute(&cus, hipDeviceAttributeMultiprocessorCount, dev) != hipSuccess) { grid = -1; return; }
        if (hipFuncSetAttribute((const void*)mega, hipFuncAttributeMaxDynamicSharedMemorySize, LDS_BYTES) != hipSuccess) { fprintf(stderr, "kernel_launch: hipFuncSetAttribute failed\n"); grid = -1; return; }
        if (hipOccupancyMaxActiveBlocksPerMultiprocessor(&per_cu, (const void*)mega, NTHR, LDS_BYTES) != hipSuccess || per_cu < 1) { fprintf(stderr, "kernel_launch: occupancy query says %d\n", per_cu); per_cu = 1; }
        (void)hipGetLastError();
        grid = cus;
        fprintf(stderr, "kernel_launch: grid %d (occupancy query %d per CU)\n", grid, per_cu);
    }
    if (grid < 0) return;
    if (hipMemsetAsync((char*)d_ws + WS_CTL, 0, 65536, stream) != hipSuccess) { fprintf(stderr, "kernel_launch: memset failed\n"); return; }
    Args a{};
    for (int i = 0; i < 21; ++i) a.in[i] = (const float*)d_in[i];
    a.out = (float*)d_out; a.ws = (unsigned char*)d_ws;
#if MK_ONE_LAUNCH
    a.ph_lo = 0; a.ph_hi = NPHASE;
    hipLaunchKernelGGL(mega, dim3(grid), dim3(NTHR), LDS_BYTES, stream, a);
    { const hipError_t e = hipPeekAtLastError(); if (e != hipSuccess) fprintf(stderr, "kernel_launch: launch failed: %s\n", hipGetErrorString(e)); }
#else
    for (int p = 0; p < NPHASE; ++p) {
        a.ph_lo = p; a.ph_hi = p + 1;
        hipLaunchKernelGGL(mega, dim3(grid), dim3(NTHR), LDS_BYTES, stream, a);
    }
#endif
}
```

```cpp
#include <hip/hip_runtime.h>
#include <hip/hip_cooperative_groups.h>
#include <cstdio>
namespace cg = cooperative_groups;

#define GAS __attribute__((address_space(1)))
#define LAS __attribute__((address_space(3)))
typedef unsigned short bf16;
typedef unsigned v4u __attribute__((ext_vector_type(4)));
typedef unsigned v2u __attribute__((ext_vector_type(2)));
typedef float f32x4 __attribute__((ext_vector_type(4)));
typedef float f32x2 __attribute__((ext_vector_type(2)));
typedef short bf16x8 __attribute__((ext_vector_type(8)));

#ifndef P4M
#define P4M 63
#endif
#ifndef EPI_TWICE
#define EPI_TWICE 0
#endif
#ifndef P3REP_A
#define P3REP_A 1
#endif
#ifndef P3REP_B
#define P3REP_B 1
#endif
#ifndef MK_ONE_LAUNCH
#define MK_ONE_LAUNCH 1
#endif

constexpr int NB = 8, SEQ = 8192, D = 1024, M = NB * SEQ, CTXL = 256, MC = NB * CTXL, MT = M + MC;
constexpr int NIN = 7680, NH = 8, HD = 128, NE = 16, CAP = 1024, FF = 1024, PW = 512;
constexpr int GRID_W = 64, GRID_H = SEQ / GRID_W;
constexpr float EPS = 1e-6f;
constexpr int NWAVES = 8, NTHR = 512;
constexpr int NPHASE = 8;

constexpr size_t MiB = 1u << 20;
constexpr size_t WS_CTL = 0, WS_MOD = 1 * MiB, WS_LB = 2 * MiB, WS_IDX = 3 * MiB, WS_VALS = 3 * MiB + 512 * 1024;
constexpr size_t WS_PROBS = 4 * MiB, WS_INV = 8 * MiB;
constexpr size_t WS_MODP = 4 * MiB;
constexpr size_t WS_WIN = 12 * MiB, WS_WA = 27 * MiB, WS_WP = 29 * MiB, WS_WOUT = 30 * MiB;
constexpr size_t WS_Q = 32 * MiB, WS_V = 160 * MiB, WS_GF = 292 * MiB, WS_GB = 424 * MiB, WS_OG = 556 * MiB, WS_P = 684 * MiB, WS_GA = 748 * MiB, WS_GBT = 876 * MiB, WS_END = 1004 * MiB;
constexpr size_t WS_NEWHX = WS_Q;
constexpr size_t WS_AA = WS_GF;
constexpr size_t WS_VX = WS_GF;
constexpr size_t WS_R = WS_GB;
constexpr size_t WS_HID = WS_GB;
constexpr size_t WS_YB = WS_GA;
constexpr size_t DO_UX = 0, DO_OF = 0, DO_OB = 128 * MiB, DO_WGU = 0, DO_WDN = 64 * MiB;

__device__ __forceinline__ unsigned f2bf(float f) { unsigned u = __builtin_bit_cast(unsigned, f); return (u + 0x7fffu + ((u >> 16) & 1u)) >> 16; }
typedef __bf16 bf16x2_t __attribute__((ext_vector_type(2)));
__device__ __forceinline__ unsigned pk2(float lo, float hi) { const f32x2 v = {lo, hi}; const bf16x2_t b = __builtin_convertvector(v, bf16x2_t); return __builtin_bit_cast(unsigned, b); }
__device__ __forceinline__ float bflo(unsigned w) { return __builtin_bit_cast(float, w << 16); }
__device__ __forceinline__ float bfhi(unsigned w) { return __builtin_bit_cast(float, w & 0xffff0000u); }
__device__ __forceinline__ float bf2f(bf16 b) { return __builtin_bit_cast(float, (unsigned)b << 16); }
__device__ __forceinline__ unsigned pkh2(float lo, float hi) { const _Float16 a = (_Float16)lo, b = (_Float16)hi; return (unsigned)__builtin_bit_cast(unsigned short, a) | ((unsigned)__builtin_bit_cast(unsigned short, b) << 16); }
__device__ __forceinline__ float h2f(unsigned short h) { return (float)__builtin_bit_cast(_Float16, h); }
__device__ __forceinline__ float wave_sum(float v) {
#pragma unroll
    for (int o = 1; o < 64; o <<= 1) v += __shfl_xor(v, o);
    return v;
}
__device__ __forceinline__ float sigmoidf_(float x) { return __builtin_amdgcn_rcpf(1.0f + __builtin_amdgcn_exp2f(-1.44269504089f * x)); }
__device__ __forceinline__ float siluf_(float x) { return x * __builtin_amdgcn_rcpf(1.0f + __builtin_amdgcn_exp2f(-1.44269504089f * x)); }
#define LDS_WAIT() asm volatile("s_waitcnt lgkmcnt(0)" ::: "memory")
#define VM_WAIT() asm volatile("s_waitcnt vmcnt(0)" ::: "memory")
__device__ __forceinline__ void wg_fence() {
    asm volatile("s_waitcnt vmcnt(0) lgkmcnt(0)" ::: "memory");
    __syncthreads();
    if (threadIdx.x < 64) { __builtin_amdgcn_fence(__ATOMIC_ACQUIRE, "agent"); asm volatile("s_waitcnt vmcnt(0)" ::: "memory"); }
    __syncthreads();
}


#define XB_TMO      128
#define XB_XCNT(j)  (256  + 64 * (j))
#define XB_XSUB(j)  (1280 + 64 * (j))
#define XB_XGEN(j)  (2304 + 64 * (j))
#define XB_TOP      3328
#define XB_TOPGEN   3392
#define XCD_BAR_WORDS 3456
#define XB_SPIN_CAP (1u << 20)
__device__ __forceinline__ unsigned xb_ld(unsigned* p)              { return __hip_atomic_load(p, __ATOMIC_RELAXED, __HIP_MEMORY_SCOPE_AGENT); }
__device__ __forceinline__ unsigned xb_add(unsigned* p, unsigned v) { return __hip_atomic_fetch_add(p, v, __ATOMIC_RELAXED, __HIP_MEMORY_SCOPE_AGENT); }
__device__ __forceinline__ unsigned xb_xcc_id() { return (unsigned)__builtin_amdgcn_s_getreg((3 << 11) | 20) & 0xFu; }
#define XB_SPIN(cond, bar) do { unsigned _sp = 0; while (cond) { __builtin_amdgcn_s_sleep(1); \
    if ((++_sp & 255u) == 0u) { if (xb_ld(&(bar)[XB_TMO])) break; if (_sp > XB_SPIN_CAP) { atomicAdd(&(bar)[XB_TMO], 1u); break; } } } } while (0)
struct XcdBarrier { unsigned* bar; unsigned x; volatile LAS unsigned* st; };
__device__ __forceinline__ XcdBarrier xcd_barrier_post(unsigned* bar, volatile LAS unsigned* st) {
    XcdBarrier b; b.bar = bar; b.x = xb_xcc_id(); b.st = st;
    if (threadIdx.x == 0) (void)xb_add(&bar[XB_XCNT(b.x)], 1u);
    return b;
}
__device__ __forceinline__ void xcd_barrier_complete(unsigned* bar, unsigned x, unsigned& nloc, unsigned& nx) {
    const unsigned G = gridDim.x * gridDim.y * gridDim.z;
    unsigned sum, cnt, mine, sp = 0u;
    for (;;) {
        sum = 0u; cnt = 0u; mine = 0u;
#pragma unroll
        for (unsigned j = 0; j < 16; ++j) { const unsigned c = xb_ld(&bar[XB_XCNT(j)]); sum += c; cnt += (c > 0u) ? 1u : 0u; mine = (j == x) ? c : mine; }
        if (sum == G) break;
        __builtin_amdgcn_s_sleep(1);
        if ((++sp & 255u) == 0u) { if (xb_ld(&bar[XB_TMO])) break; if (sp > XB_SPIN_CAP) { atomicAdd(&bar[XB_TMO], 1u); break; } }
    }
    nloc = mine > 0u ? mine : 1u; nx = cnt > 0u ? cnt : 1u;
}
__device__ __forceinline__ void xcd_barrier(const XcdBarrier& b) {
    asm volatile("s_waitcnt vmcnt(0)" ::: "memory");
    __syncthreads();
    if (threadIdx.x == 0) {
        unsigned* bar = b.bar;
        __builtin_amdgcn_s_waitcnt(0);
        unsigned nloc = b.st[0], nx = b.st[1];
        if (nloc == 0u) { xcd_barrier_complete(bar, b.x, nloc, nx); b.st[0] = nloc; b.st[1] = nx; }
        const unsigned old = xb_add(&bar[XB_XSUB(b.x)], 1u);
        const unsigned gen = old / nloc;
        if (old + 1u == (gen + 1u) * nloc) {
            __builtin_amdgcn_fence(__ATOMIC_RELEASE, "agent");
            asm volatile("s_waitcnt vmcnt(0)" ::: "memory");
            const unsigned og = xb_add(&bar[XB_TOP], 1u);
            const unsigned tg = og / nx;
            if (og + 1u == (tg + 1u) * nx) xb_add(&bar[XB_TOPGEN], 1u);
            else XB_SPIN(xb_ld(&bar[XB_TOPGEN]) == tg, bar);
            __builtin_amdgcn_fence(__ATOMIC_ACQUIRE, "agent");
            xb_add(&bar[XB_XGEN(b.x)], 1u);
            asm volatile("s_waitcnt vmcnt(0)" ::: "memory");
        } else {
            XB_SPIN(xb_ld(&bar[XB_XGEN(b.x)]) == gen, bar);
            __builtin_amdgcn_fence(__ATOMIC_ACQUIRE, "agent");
            asm volatile("s_waitcnt vmcnt(0)" ::: "memory");
        }
    }
    __syncthreads();
}

namespace pg8 {
#define PG8_LAS __attribute__((address_space(3)))
typedef unsigned short bf16_t;
typedef unsigned u32x4 __attribute__((ext_vector_type(4)));
constexpr int BM = 256, BK = 64, HALF = 128, HTB = HALF * BK * 2, STAGE_BYTES = 8 * HTB, NXCD = 8, WGM = 8;
__host__ __device__ __forceinline__ int lds_byte(int r, int c) { const int st = (r >> 4) * 2 + (c >> 5), rr = r & 15, cc = c & 31, ob = rr * 64 + cc * 2; return st * 1024 + (ob ^ (((ob >> 9) & 1) << 5)); }
__host__ __device__ __forceinline__ void stage_rc(int b, int& R, int& C) { const int st = b / 1024, sb = b % 1024, swz = sb ^ (((sb >> 9) & 1) << 5); R = (st >> 1) * 16 + swz / 64; C = (st & 1) * 32 + (swz % 64) / 2; }
__host__ __device__ __forceinline__ int perm32(int rho) { const int n = rho >> 4, i = rho & 15; return 8 * (i >> 2) + 4 * n + (i & 3); }
struct Unit { int pm, pn; };
struct Gemm { const bf16_t* A; const bf16_t* Bt; int K; const int* gidx; };
__device__ __forceinline__ unsigned cvt_pk_bf16(float lo, float hi) { unsigned r; asm volatile("v_cvt_pk_bf16_f32 %0, %1, %2" : "=v"(r) : "v"(lo), "v"(hi)); return r; }

template <class Epi, class Sched, bool ALIGN_EPI, bool SP2, bool GATHER>
__device__ __forceinline__ void gemm_phase(PG8_LAS unsigned char* lds, const Gemm g, const Sched& S, const Epi& E, int tid_in) {
    asm volatile("" : "+v"(tid_in));
    const int tid = tid_in, wid = __builtin_amdgcn_readfirstlane(tid >> 6), lane = tid & 63, wr = wid >> 2, wc = wid & 3, fr = lane & 15, fq = lane >> 4;
    const int K = g.K, nt = K / BK;
    unsigned voffA[2], voffA1[2], voffB[2];
#pragma unroll
    for (int i = 0; i < 2; ++i) { int R, C; stage_rc(tid * 16 + i * 8192, R, C); const int Rb = Epi::PERM ? ((R & ~31) + perm32(R & 31)) : R;
        if (GATHER) { voffA[i] = (unsigned)(g.gidx[R] * K + C) * 2u; voffA1[i] = (unsigned)(g.gidx[HALF + R] * K + C) * 2u; }
        else { voffA[i] = (unsigned)(R * K + C) * 2u; voffA1[i] = voffA[i]; }
        voffB[i] = (unsigned)(Rb * K + C) * 2u; }
    const size_t kstep = (size_t)(BK * 2);
    const size_t hstep = (size_t)HALF * K * 2;
    const size_t hstepA = GATHER ? 0 : hstep;
    const size_t tstep = 2 * hstep;
    const unsigned ldsw = (unsigned)wid * 1024u;
    const int aoff = lds_byte(wr * 64 + fr, fq * 8), boff = lds_byte(wc * 32 + fr, fq * 8);
#define PG8_SA(b, h) (((b) * 2 + (h)) * HTB)
#define PG8_SB(b, h) ((4 + (b) * 2 + (h)) * HTB)
#define PG8_STAGE(bufoff, gbase, voff) do { _Pragma("unroll") for (int _i = 0; _i < 2; ++_i) \
        __builtin_amdgcn_global_load_lds((const unsigned*)((const char*)(gbase) + (voff)[_i]), (PG8_LAS unsigned*)(lds + (bufoff) + ldsw + _i * 8192), 16, 0, 0); } while (0)
#define PG8_LDA(dst, b, h) do { _Pragma("unroll") for (int m = 0; m < 4; ++m) _Pragma("unroll") for (int k = 0; k < 2; ++k) dst[m][k] = *(const PG8_LAS bf16x8*)(lds + PG8_SA(b, h) + aoff + m * 2048 + k * 1024); } while (0)
#define PG8_LDB(dst, b, h) do { _Pragma("unroll") for (int n = 0; n < 2; ++n) _Pragma("unroll") for (int k = 0; k < 2; ++k) dst[n][k] = *(const PG8_LAS bf16x8*)(lds + PG8_SB(b, h) + boff + n * 2048 + k * 1024); } while (0)
#define PG8_MMA(ai, bj, At, Bt) do { __builtin_amdgcn_s_setprio(1); _Pragma("unroll") for (int m = 0; m < 4; ++m) _Pragma("unroll") for (int n = 0; n < 2; ++n) _Pragma("unroll") for (int k = 0; k < 2; ++k) \
        acc[ai][bj][m][n] = __builtin_amdgcn_mfma_f32_16x16x32_bf16(Bt[n][k], At[m][k], acc[ai][bj][m][n], 0, 0, 0); __builtin_amdgcn_s_setprio(0); } while (0)
#define PG8_WAIT_V(n) asm volatile("s_waitcnt vmcnt(" #n ")" ::: "memory")
#define PG8_WAIT_L(n) asm volatile("s_waitcnt lgkmcnt(" #n ")" ::: "memory")
#define PG8_BAR __builtin_amdgcn_s_barrier()
#define PG8_SCHED __builtin_amdgcn_sched_barrier(0)
    Unit cur, nxt; int ui = 0;
    if (!S.next(0, cur)) return;
    f32x4 acc[2][2][4][2];
#pragma unroll
    for (int a = 0; a < 2; ++a)
#pragma unroll
        for (int b = 0; b < 2; ++b)
#pragma unroll
            for (int m = 0; m < 4; ++m)
#pragma unroll
                for (int n = 0; n < 2; ++n) acc[a][b][m][n] = (f32x4){0.f, 0.f, 0.f, 0.f};
    bf16x8 At[4][2], B0[2][2], B1[2][2];
    const char* cA = (const char*)g.A + (GATHER ? (size_t)0 : (size_t)cur.pm * tstep); const char* cB = (const char*)g.Bt + (size_t)cur.pn * tstep;
    if constexpr (SP2) {
        PG8_STAGE(PG8_SB(0, 0), cB, voffB); PG8_STAGE(PG8_SB(0, 1), cB + hstep, voffB); PG8_STAGE(PG8_SA(0, 0), cA, voffA); PG8_STAGE(PG8_SA(0, 1), cA + hstepA, voffA1);
        if (wr == 1) PG8_BAR;
        PG8_WAIT_V(2); PG8_BAR;
        PG8_STAGE(PG8_SB(1, 0), cB + kstep, voffB); PG8_STAGE(PG8_SA(1, 0), cA + kstep, voffA); PG8_STAGE(PG8_SB(1, 1), cB + hstep + kstep, voffB);
        PG8_WAIT_V(6); PG8_BAR;
    } else {
        PG8_STAGE(PG8_SB(0, 0), cB, voffB); PG8_STAGE(PG8_SA(0, 0), cA, voffA); PG8_STAGE(PG8_SB(0, 1), cB + hstep, voffB); PG8_STAGE(PG8_SA(0, 1), cA + hstepA, voffA1);
        if (wr == 1) PG8_BAR;
        PG8_WAIT_V(4); PG8_BAR;
        PG8_STAGE(PG8_SB(1, 0), cB + kstep, voffB); PG8_STAGE(PG8_SA(1, 0), cA + kstep, voffA); PG8_STAGE(PG8_SB(1, 1), cB + hstep + kstep, voffB);
        PG8_WAIT_V(6); PG8_BAR;
    }
    for (;;) {
        const bool has_next = S.next(ui + 1, nxt);
        const char* nA = has_next ? (const char*)g.A + (GATHER ? (size_t)0 : (size_t)nxt.pm * tstep) : cA; const char* nB = has_next ? (const char*)g.Bt + (size_t)nxt.pn * tstep : cB;
        for (int t = 0; t < nt; t += 2) {
            const bool last = (t == nt - 2);
            const char* a1 = cA + (size_t)(t + 1) * kstep;
            const char* a2 = last ? nA : cA + (size_t)(t + 2) * kstep; const char* b2 = last ? nB : cB + (size_t)(t + 2) * kstep;
            const char* a3 = a2 + kstep; const char* b3 = b2 + kstep;
            if constexpr (SP2) {
            PG8_LDB(B0, 0, 0); PG8_LDB(B1, 0, 1); PG8_SCHED; PG8_LDA(At, 0, 0); PG8_STAGE(PG8_SA(1, 1), a1 + hstepA, voffA1);
            PG8_WAIT_V(8); PG8_WAIT_L(0); PG8_BAR; PG8_MMA(0, 0, At, B0); PG8_MMA(0, 1, At, B1); PG8_BAR; PG8_SCHED;
            PG8_LDA(At, 0, 1); PG8_STAGE(PG8_SB(0, 0), b2, voffB); PG8_STAGE(PG8_SB(0, 1), b2 + hstep, voffB); PG8_STAGE(PG8_SA(0, 0), a2, voffA);
            PG8_WAIT_V(8); PG8_WAIT_L(0); PG8_BAR; PG8_MMA(1, 0, At, B0); PG8_MMA(1, 1, At, B1); PG8_BAR; PG8_SCHED;
            PG8_LDB(B0, 1, 0); PG8_LDB(B1, 1, 1); PG8_SCHED; PG8_LDA(At, 1, 0); PG8_STAGE(PG8_SA(0, 1), a2 + hstepA, voffA1);
            PG8_WAIT_V(8); PG8_WAIT_L(0); PG8_BAR; PG8_MMA(0, 0, At, B0); PG8_MMA(0, 1, At, B1); PG8_BAR; PG8_SCHED;
            PG8_LDA(At, 1, 1); PG8_STAGE(PG8_SB(1, 0), b3, voffB); PG8_STAGE(PG8_SB(1, 1), b3 + hstep, voffB); PG8_STAGE(PG8_SA(1, 0), a3, voffA);
            PG8_WAIT_V(8); PG8_WAIT_L(0); PG8_BAR; PG8_MMA(1, 0, At, B0); PG8_MMA(1, 1, At, B1); PG8_BAR; PG8_SCHED;
            } else {
            PG8_LDB(B0, 0, 0); PG8_SCHED; PG8_LDA(At, 0, 0); PG8_STAGE(PG8_SA(1, 1), a1 + hstepA, voffA1);
            PG8_WAIT_L(8); PG8_BAR; PG8_WAIT_L(0); PG8_MMA(0, 0, At, B0); PG8_BAR; PG8_SCHED;
            PG8_LDB(B1, 0, 1); PG8_STAGE(PG8_SB(0, 0), b2, voffB);
            PG8_BAR; PG8_WAIT_L(0); PG8_MMA(0, 1, At, B1); PG8_BAR;
            PG8_LDA(At, 0, 1); PG8_STAGE(PG8_SA(0, 0), a2, voffA);
            PG8_BAR; PG8_WAIT_L(0); PG8_MMA(1, 0, At, B0); PG8_BAR; PG8_SCHED;
            PG8_STAGE(PG8_SB(0, 1), b2 + hstep, voffB);
            PG8_WAIT_V(6); PG8_BAR; PG8_MMA(1, 1, At, B1); PG8_BAR;
            PG8_LDB(B0, 1, 0); PG8_SCHED; PG8_LDA(At, 1, 0); PG8_STAGE(PG8_SA(0, 1), a2 + hstepA, voffA1);
            PG8_WAIT_L(8); PG8_BAR; PG8_WAIT_L(0); PG8_MMA(0, 0, At, B0); PG8_BAR; PG8_SCHED;
            PG8_LDB(B1, 1, 1); PG8_STAGE(PG8_SB(1, 0), b3, voffB);
            PG8_BAR; PG8_WAIT_L(0); PG8_MMA(0, 1, At, B1); PG8_BAR;
            PG8_LDA(At, 1, 1); PG8_STAGE(PG8_SA(1, 0), a3, voffA);
            PG8_BAR; PG8_WAIT_L(0); PG8_MMA(1, 0, At, B0); PG8_BAR; PG8_SCHED;
            PG8_STAGE(PG8_SB(1, 1), b3 + hstep, voffB);
            PG8_WAIT_V(6); PG8_BAR; PG8_MMA(1, 1, At, B1); PG8_BAR;
            }
        }
        if constexpr (ALIGN_EPI) { if (wr == 0) PG8_BAR; }
        E(acc, cur, wr, wc, fr, fq);
        if constexpr (Epi::PROBE_TWICE) { if (EPI_TWICE) { asm volatile("" ::: "memory"); E(acc, cur, wr, wc, fr, fq); } }
        if (!has_next) break;
#pragma unroll
        for (int a = 0; a < 2; ++a)
#pragma unroll
            for (int b = 0; b < 2; ++b)
#pragma unroll
                for (int m = 0; m < 4; ++m)
#pragma unroll
                    for (int n = 0; n < 2; ++n) acc[a][b][m][n] = (f32x4){0.f, 0.f, 0.f, 0.f};
        cur = nxt; cA = nA; cB = nB; ++ui;
        if constexpr (ALIGN_EPI) { if (wr == 1) PG8_BAR; }
    }
    PG8_WAIT_V(0);
    if constexpr (!ALIGN_EPI) { if (wr == 0) PG8_BAR; }
    PG8_BAR;
#undef PG8_SA
#undef PG8_SB
#undef PG8_STAGE
#undef PG8_LDA
#undef PG8_LDB
#undef PG8_MMA
#undef PG8_WAIT_V
#undef PG8_WAIT_L
#undef PG8_BAR
#undef PG8_SCHED
}

struct OrderIn {
    int G, c;
    __device__ __forceinline__ bool next(int i, Unit& u) const {
        constexpr int nM = M / BM, nN = NIN / BM, nwg = nM * nN, nctx = (MC / BM) * 12;
        const long L = (long)i * G + c;
        if (L >= nwg + nctx) return false;
        if (L >= nwg) { const int j = (int)L - nwg; u.pm = nM + j / 12; u.pn = 4 + j % 12; return true; }
        int wgid = (int)L; { const int q = nwg / NXCD, r = nwg % NXCD, xcd = wgid % NXCD, off = wgid / NXCD; wgid = (xcd < r ? xcd * (q + 1) : r * (q + 1) + (xcd - r) * q) + off; }
        const int nig = WGM * nN, gid = wgid / nig, fm = gid * WGM, gsz = (nM - fm) < WGM ? (nM - fm) : WGM;
        u.pm = fm + ((wgid % nig) % gsz); u.pn = (wgid % nig) / gsz; return true;
    }
};
struct OrderRow {
    int pm, nN;
    __device__ __forceinline__ bool next(int i, Unit& u) const { if (i >= nN) return false; u.pm = pm; u.pn = i; return true; }
};

struct EpiIn {
    static constexpr bool PROBE_TWICE = true;
    static constexpr bool PERM = true;
    bf16 *Q, *V, *GF, *GB, *OG, *P, *GA, *GBT; const float* lb;
    __device__ __forceinline__ void operator()(const f32x4 (&acc)[2][2][4][2], const Unit& u, int wr, int wc, int fr, int fq) const {
        const int pn = u.pn; int kind, colt, ldc = D; bf16* base; const float* lbp = lb;
        if (pn < 4)       { kind = 1; base = Q;   colt = pn * 256; }
        else if (pn < 8)  { kind = 0; base = V;   colt = (pn - 4) * 256; }
        else if (pn < 12) { kind = 3; base = GF;  colt = (pn - 8) * 256; }
        else if (pn < 16) { kind = 3; base = GB;  colt = (pn - 12) * 256; lbp = lb + 1024; }
        else if (pn < 20) { kind = 1; base = OG;  colt = (pn - 16) * 256; }
        else if (pn < 22) { kind = 0; base = P;   colt = (pn - 20) * 256; ldc = PW; }
        else if (pn < 26) { kind = 2; base = GA;  colt = (pn - 22) * 256; }
        else              { kind = 2; base = GBT; colt = (pn - 26) * 256; }
        const int row0 = u.pm * BM + wr * 64 + fr, col0 = colt + wc * 32 + 8 * fq;
        f32x4 l0[2], l1[2];
        if (kind == 3) {
#pragma unroll
            for (int bj = 0; bj < 2; ++bj) { l0[bj] = *(const f32x4*)(lbp + col0 + bj * HALF); l1[bj] = *(const f32x4*)(lbp + col0 + bj * HALF + 4); }
        }
#pragma unroll
        for (int ai = 0; ai < 2; ++ai)
#pragma unroll
            for (int m = 0; m < 4; ++m) { bf16* rowp = base + (size_t)(row0 + ai * HALF + m * 16) * ldc + col0;
#pragma unroll
                for (int bj = 0; bj < 2; ++bj) { f32x4 v0 = acc[ai][bj][m][0], v1 = acc[ai][bj][m][1]; u32x4 w;
                    if (kind == 3) {
#pragma unroll
                        for (int j = 0; j < 4; ++j) { v0[j] = __builtin_amdgcn_logf(l0[bj][j] + (1.0f - l0[bj][j]) * sigmoidf_(v0[j])); v1[j] = __builtin_amdgcn_logf(l1[bj][j] + (1.0f - l1[bj][j]) * sigmoidf_(v1[j])); }
                        w.x = pkh2(v0[0], v0[1]); w.y = pkh2(v0[2], v0[3]); w.z = pkh2(v1[0], v1[1]); w.w = pkh2(v1[2], v1[3]);
                    } else {
                        if (kind == 1) {
#pragma unroll
                            for (int j = 0; j < 4; ++j) { v0[j] = siluf_(v0[j]); v1[j] = siluf_(v1[j]); }
                        } else if (kind == 2) {
#pragma unroll
                            for (int j = 0; j < 4; ++j) { v0[j] = sigmoidf_(v0[j]); v1[j] = sigmoidf_(v1[j]); }
                        }
                        w.x = cvt_pk_bf16(v0[0], v0[1]); w.y = cvt_pk_bf16(v0[2], v0[3]); w.z = cvt_pk_bf16(v1[0], v1[1]); w.w = cvt_pk_bf16(v1[2], v1[3]);
                    }
                    *(u32x4*)(rowp + bj * HALF) = w; } }
    }
};
struct EpiGateA {
    static constexpr bool PROBE_TWICE = false;
    static constexpr bool PERM = true;
    bf16* GA;
    __device__ __forceinline__ void operator()(const f32x4 (&acc)[2][2][4][2], const Unit& u, int wr, int wc, int fr, int fq) const {
        const int row0 = u.pm * BM + wr * 64 + fr, col0 = u.pn * BM + wc * 32 + 8 * fq;
#pragma unroll
        for (int ai = 0; ai < 2; ++ai)
#pragma unroll
            for (int m = 0; m < 4; ++m) { bf16* rowp = GA + (size_t)(row0 + ai * HALF + m * 16) * D + col0;
#pragma unroll
                for (int bj = 0; bj < 2; ++bj) { const f32x4 v0 = acc[ai][bj][m][0], v1 = acc[ai][bj][m][1]; const u32x4 gw = *(const u32x4*)(rowp + bj * HALF); u32x4 w;
                    w.x = cvt_pk_bf16(v0[0] * bflo(gw.x), v0[1] * bfhi(gw.x)); w.y = cvt_pk_bf16(v0[2] * bflo(gw.y), v0[3] * bfhi(gw.y));
                    w.z = cvt_pk_bf16(v1[0] * bflo(gw.z), v1[1] * bfhi(gw.z)); w.w = cvt_pk_bf16(v1[2] * bflo(gw.w), v1[3] * bfhi(gw.w));
                    *(u32x4*)(rowp + bj * HALF) = w; }
                if (m & 1) asm volatile("" ::: "memory"); }
    }
};
struct EpiGateB {
    static constexpr bool PROBE_TWICE = false;
    static constexpr bool PERM = true;
    const bf16* T; bf16* GBT;
    __device__ __forceinline__ void operator()(const f32x4 (&acc)[2][2][4][2], const Unit& u, int wr, int wc, int fr, int fq) const {
        const int row0 = u.pm * BM + wr * 64 + fr, col0 = u.pn * BM + wc * 32 + 8 * fq;
#pragma unroll
        for (int ai = 0; ai < 2; ++ai)
#pragma unroll
            for (int m = 0; m < 4; ++m) { const size_t off = (size_t)(row0 + ai * HALF + m * 16) * D + col0;
#pragma unroll
                for (int bj = 0; bj < 2; ++bj) { const f32x4 v0 = acc[ai][bj][m][0], v1 = acc[ai][bj][m][1];
                    const u32x4 gw = *(const u32x4*)(GBT + off + bj * HALF), tw = *(const u32x4*)(T + off + bj * HALF); u32x4 w;
                    w.x = cvt_pk_bf16(bflo(tw.x) + v0[0] * bflo(gw.x), bfhi(tw.x) + v0[1] * bfhi(gw.x)); w.y = cvt_pk_bf16(bflo(tw.y) + v0[2] * bflo(gw.y), bfhi(tw.y) + v0[3] * bfhi(gw.y));
                    w.z = cvt_pk_bf16(bflo(tw.z) + v1[0] * bflo(gw.z), bfhi(tw.z) + v1[1] * bfhi(gw.z)); w.w = cvt_pk_bf16(bflo(tw.w) + v1[2] * bflo(gw.w), bfhi(tw.w) + v1[3] * bfhi(gw.w));
                    *(u32x4*)(GBT + off + bj * HALF) = w; }
                asm volatile("" ::: "memory"); }
    }
};
struct EpiResid {
    static constexpr bool PROBE_TWICE = false;
    static constexpr bool PERM = false;
    const float* X; float* O; const float* g1;
    __device__ __forceinline__ void operator()(const f32x4 (&acc)[2][2][4][2], const Unit& u, int wr, int wc, int fr, int fq) const {
        const int row0 = u.pm * BM + wr * 64 + fr, col0 = u.pn * BM + wc * 32 + 4 * fq;
        f32x4 gv[2][2];
#pragma unroll
        for (int bj = 0; bj < 2; ++bj)
#pragma unroll
            for (int n = 0; n < 2; ++n) gv[bj][n] = *(const f32x4*)(g1 + col0 + bj * HALF + n * 16);
#pragma unroll
        for (int ai = 0; ai < 2; ++ai)
#pragma unroll
            for (int m = 0; m < 4; ++m) { const size_t off = (size_t)(row0 + ai * HALF + m * 16) * D + col0;
#pragma unroll
                for (int bj = 0; bj < 2; ++bj)
#pragma unroll
                    for (int n = 0; n < 2; ++n) { const f32x4 xv = *(const f32x4*)(X + off + bj * HALF + n * 16); *(f32x4*)(O + off + bj * HALF + n * 16) = xv + gv[bj][n] * acc[ai][bj][m][n]; }
                asm volatile("" ::: "memory"); }
    }
};
struct EpiHid {
    static constexpr bool PROBE_TWICE = false;
    static constexpr bool PERM = true;
    bf16* H;
    __device__ __forceinline__ void operator()(const f32x4 (&acc)[2][2][4][2], const Unit& u, int wr, int wc, int fr, int fq) const {
        const int row0 = wr * 64 + fr, col0 = u.pn * HALF + wc * 32 + 8 * fq;
#pragma unroll
        for (int ai = 0; ai < 2; ++ai)
#pragma unroll
            for (int m = 0; m < 4; ++m) { bf16* rowp = H + (size_t)(row0 + ai * HALF + m * 16) * FF + col0;
                const f32x4 g0 = acc[ai][0][m][0], g1 = acc[ai][0][m][1], u0 = acc[ai][1][m][0], u1 = acc[ai][1][m][1]; u32x4 w;
                w.x = cvt_pk_bf16(siluf_(g0[0]) * u0[0], siluf_(g0[1]) * u0[1]); w.y = cvt_pk_bf16(siluf_(g0[2]) * u0[2], siluf_(g0[3]) * u0[3]);
                w.z = cvt_pk_bf16(siluf_(g1[0]) * u1[0], siluf_(g1[1]) * u1[1]); w.w = cvt_pk_bf16(siluf_(g1[2]) * u1[2], siluf_(g1[3]) * u1[3]);
                *(u32x4*)rowp = w; }
    }
};
struct EpiDown {
    static constexpr bool PROBE_TWICE = false;
    static constexpr bool PERM = true;
    bf16* Y; const float* vals;
    __device__ __forceinline__ void operator()(const f32x4 (&acc)[2][2][4][2], const Unit& u, int wr, int wc, int fr, int fq) const {
        const int row0 = wr * 64 + fr, col0 = u.pn * BM + wc * 32 + 8 * fq;
#pragma unroll
        for (int ai = 0; ai < 2; ++ai)
#pragma unroll
            for (int m = 0; m < 4; ++m) { const int r = row0 + ai * HALF + m * 16; const float s = vals[r]; bf16* rowp = Y + (size_t)r * D + col0;
#pragma unroll
                for (int bj = 0; bj < 2; ++bj) { const f32x4 v0 = acc[ai][bj][m][0] * s, v1 = acc[ai][bj][m][1] * s; u32x4 w;
                    w.x = cvt_pk_bf16(v0[0], v0[1]); w.y = cvt_pk_bf16(v0[2], v0[3]); w.z = cvt_pk_bf16(v1[0], v1[1]); w.w = cvt_pk_bf16(v1[2], v1[3]);
                    *(u32x4*)(rowp + bj * HALF) = w; } }
    }
};
}

constexpr int RING_BYTES = 131072;
constexpr int LDS_BYTES = 147456;

struct Args {
    const float* in[21]; float* out; unsigned char* ws; int ph_lo, ph_hi;
};

__device__ __forceinline__ void transpose_item(const float* W, int K, int N, bf16* WT, int k0, int n0, int drow0, LAS float* scr, int lane) {
    f32x4 v[8];
#pragma unroll
    for (int i = 0; i < 8; ++i) v[i] = *(const f32x4*)(W + (size_t)(k0 + 8 * i + (lane >> 3)) * N + n0 + 4 * (lane & 7));
#pragma unroll
    for (int i = 0; i < 8; ++i) { LAS float* d = scr + (8 * i + (lane >> 3)) * 33 + 4 * (lane & 7); d[0] = v[i].x; d[1] = v[i].y; d[2] = v[i].z; d[3] = v[i].w; }
    LDS_WAIT(); asm volatile("" ::: "memory");
    const int c = lane & 7;
#pragma unroll
    for (int j = 0; j < 4; ++j) { const int n = (lane >> 3) + 8 * j; const LAS float* s = scr + (8 * c) * 33 + n;
        v4u o; o.x = pk2(s[0 * 33], s[1 * 33]); o.y = pk2(s[2 * 33], s[3 * 33]); o.z = pk2(s[4 * 33], s[5 * 33]); o.w = pk2(s[6 * 33], s[7 * 33]);
        *(v4u*)(WT + (size_t)(drow0 + n) * K + k0 + 8 * c) = o; }
    LDS_WAIT(); asm volatile("" ::: "memory");
}

typedef _Float16 half8 __attribute__((ext_vector_type(8)));
struct RawChunk { v4u q[2], g[2], v; };
constexpr int P3_QP = 272, P3_SP = 144;
constexpr int P3_QT = 0, P3_KT = 17408, P3_KTT = 34816, P3_VT = 53248, P3_AM = 62464, P3_SB = 71680, P3_GR = 89088, P3_QR = 106496;
constexpr int P3_NCH = (CTXL + SEQ) / 64;

__device__ __forceinline__ void p3_load(RawChunk& R, int c, int b, int h, int vh, int dir, int w, int lane, const bf16* Qp, const bf16* Vp, const bf16* Gp) {
    c = c < P3_NCH ? c : P3_NCH - 1;
    const int rstep = dir ? -1 : 1;
    const long rbase = (c < 4) ? (long)M + b * CTXL + (dir ? CTXL - 1 - 64 * c : 64 * c) : (long)b * SEQ + (dir ? SEQ - 1 - 64 * (c - 4) : 64 * (c - 4));
    const long qbase = (c < 4) ? (long)b * SEQ + (dir ? 63 : 0) : rbase;
#pragma unroll
    for (int i = 0; i < 2; ++i) { const int t = 8 * w + 4 * i + (lane >> 4);
        R.g[i] = *(const v4u*)(Gp + (rbase + rstep * t) * D + h * HD + 8 * (lane & 15));
        R.q[i] = *(const v4u*)(Qp + (qbase + rstep * t) * D + h * HD + 8 * (lane & 15)); }
    R.v = *(const v4u*)(Vp + (rbase + rstep * (8 * w + (lane >> 3))) * D + h * HD + vh * 64 + 8 * (lane & 7));
}

__device__ __forceinline__ void p3_chunk(LAS unsigned char* lds, const RawChunk& R, int c, f32x4 (&Sacc)[4], float (&bend_prev)[4], const half8& Bm0, const half8& Bm1, const half8& Bone,
                                         int b, int h, int vh, int dir, int w, int fr, int fq, int lane, bf16* Op) {
    const bool isx = c >= 4;
    f32x4 S0_[4]; float bp0_[4];
#pragma unroll
    for (int i = 0; i < 4; ++i) { S0_[i] = Sacc[i]; bp0_[i] = bend_prev[i]; }
#pragma unroll 1
    for (int rpa_ = 0; rpa_ < P3REP_A; ++rpa_) {
    if (P3REP_A > 1) {
#pragma unroll
        for (int i = 0; i < 4; ++i) { Sacc[i] = S0_[i]; bend_prev[i] = bp0_[i]; } }
#pragma unroll
    for (int i = 0; i < 2; ++i) { const int t = 8 * w + 4 * i + (lane >> 4);
        *(LAS v4u*)(lds + P3_GR + t * P3_QP + 16 * (lane & 15)) = R.g[i];
        *(LAS v4u*)(lds + P3_QR + t * P3_QP + 16 * (lane & 15)) = R.q[i]; }
    {
        const unsigned vw[4] = {R.v.x, R.v.y, R.v.z, R.v.w}; const int s = 8 * w + (lane >> 3);
#pragma unroll
        for (int j = 0; j < 8; ++j) *(LAS unsigned short*)(lds + P3_VT + (8 * (lane & 7) + j) * P3_SP + s * 2) = (unsigned short)(vw[j >> 1] >> (16 * (j & 1)));
    }
    LDS_WAIT(); __syncthreads();
    half8 gA0, gA1;
#pragma unroll
    for (int j = 0; j < 8; ++j) { gA0[j] = __builtin_bit_cast(_Float16, *(const LAS unsigned short*)(lds + P3_GR + (8 * fq + j) * P3_QP + (16 * w + fr) * 2));
                                  gA1[j] = __builtin_bit_cast(_Float16, *(const LAS unsigned short*)(lds + P3_GR + (32 + 8 * fq + j) * P3_QP + (16 * w + fr) * 2)); }
    v2u g4[4], q4[4];
#pragma unroll
    for (int tt = 0; tt < 4; ++tt) { g4[tt] = *(const LAS v2u*)(lds + P3_GR + (16 * tt + fr) * P3_QP + (16 * w + 4 * fq) * 2); q4[tt] = *(const LAS v2u*)(lds + P3_QR + (16 * tt + fr) * P3_QP + (16 * w + 4 * fq) * 2); }
    f32x4 bacc[4]; const f32x4 z4 = (f32x4){0.f, 0.f, 0.f, 0.f};
    bacc[0] = __builtin_amdgcn_mfma_f32_16x16x32_f16(gA0, Bm0, z4, 0, 0, 0);
    bacc[1] = __builtin_amdgcn_mfma_f32_16x16x32_f16(gA0, Bm1, z4, 0, 0, 0);
    bacc[2] = __builtin_amdgcn_mfma_f32_16x16x32_f16(gA0, Bone, z4, 0, 0, 0); bacc[2] = __builtin_amdgcn_mfma_f32_16x16x32_f16(gA1, Bm0, bacc[2], 0, 0, 0);
    bacc[3] = __builtin_amdgcn_mfma_f32_16x16x32_f16(gA0, Bone, z4, 0, 0, 0); bacc[3] = __builtin_amdgcn_mfma_f32_16x16x32_f16(gA1, Bm1, bacc[3], 0, 0, 0);
    const int src15 = (lane & 48) | 15;
    float br[4], scale[4];
#pragma unroll
    for (int i = 0; i < 4; ++i) { br[i] = __shfl(bacc[1][i], src15); const float be = __shfl(bacc[3][i], src15); scale[i] = __builtin_amdgcn_exp2f(bend_prev[i] + br[i]); bend_prev[i] = be - br[i]; }
#pragma unroll
    for (int vt = 0; vt < 4; ++vt) {
#pragma unroll
        for (int i = 0; i < 4; ++i) Sacc[vt][i] *= scale[i];
        if (isx) { v2u o; o.x = pk2(Sacc[vt][0], Sacc[vt][1]); o.y = pk2(Sacc[vt][2], Sacc[vt][3]); *(LAS v2u*)(lds + P3_SB + (16 * vt + fr) * P3_QP + (16 * w + 4 * fq) * 2) = o; }
    }
#pragma unroll
    for (int tt = 0; tt < 4; ++tt) {
        const unsigned gw[2] = {g4[tt].x, g4[tt].y}, qw[2] = {q4[tt].x, q4[tt].y};
        float qt[4], kt[4];
#pragma unroll
        for (int i = 0; i < 4; ++i) {
            const float g = h2f((unsigned short)(gw[i >> 1] >> (16 * (i & 1)))), q = (i & 1) ? bfhi(qw[i >> 1]) : bflo(qw[i >> 1]);
            const float f = __builtin_amdgcn_exp2f(g), beta = bacc[tt][i] - br[i];
            qt[i] = q * __builtin_amdgcn_exp2f(beta); kt[i] = (1.0f - f) * __builtin_amdgcn_exp2f(-beta);
        }
        const int t = 16 * tt + fr;
        const unsigned k01 = pk2(kt[0], kt[1]), k23 = pk2(kt[2], kt[3]);
        const unsigned short kb[4] = {(unsigned short)k01, (unsigned short)(k01 >> 16), (unsigned short)k23, (unsigned short)(k23 >> 16)};
        if (isx) {
            v2u o; o.x = pk2(qt[0], qt[1]); o.y = pk2(qt[2], qt[3]); *(LAS v2u*)(lds + P3_QT + t * P3_QP + (16 * w + 4 * fq) * 2) = o;
            v2u k2; k2.x = k01; k2.y = k23; *(LAS v2u*)(lds + P3_KT + t * P3_QP + (16 * w + 4 * fq) * 2) = k2;
        }
#pragma unroll
        for (int i = 0; i < 4; ++i) *(LAS unsigned short*)(lds + P3_KTT + (16 * w + 4 * fq + i) * P3_SP + t * 2) = kb[i];
    }
    LDS_WAIT(); __syncthreads();
    }
#pragma unroll
    for (int i = 0; i < 4; ++i) S0_[i] = Sacc[i];
#pragma unroll 1
    for (int rpb_ = 0; rpb_ < P3REP_B; ++rpb_) {
    if (P3REP_B > 1) {
#pragma unroll
        for (int i = 0; i < 4; ++i) Sacc[i] = S0_[i]; }
    if (isx) {
        const int tt = w >> 1;
        bf16x8 qf[4];
#pragma unroll
        for (int ks = 0; ks < 4; ++ks) qf[ks] = *(const LAS bf16x8*)(lds + P3_QT + (16 * tt + fr) * P3_QP + (32 * ks + 8 * fq) * 2);
#pragma unroll
        for (int k2 = 0; k2 < 2; ++k2) {
            const int st = 2 * (w & 1) + k2;
            f32x4 sc = (f32x4){0.f, 0.f, 0.f, 0.f};
            if (st <= tt) {
#pragma unroll
                for (int ks = 0; ks < 4; ++ks) { const bf16x8 kf = *(const LAS bf16x8*)(lds + P3_KT + (16 * st + fr) * P3_QP + (32 * ks + 8 * fq) * 2);
                    sc = __builtin_amdgcn_mfma_f32_16x16x32_bf16(kf, qf[ks], sc, 0, 0, 0); }
                const int tpos = 16 * tt + fr, s0 = 16 * st + 4 * fq;
#pragma unroll
                for (int i = 0; i < 4; ++i) if (s0 + i > tpos) sc[i] = 0.f;
            }
            v2u o; o.x = pk2(sc[0], sc[1]); o.y = pk2(sc[2], sc[3]);
            *(LAS v2u*)(lds + P3_AM + (16 * tt + fr) * P3_SP + (16 * st + 4 * fq) * 2) = o;
        }
    }
    f32x4 oacc[2]; oacc[0] = (f32x4){0.f, 0.f, 0.f, 0.f}; oacc[1] = oacc[0];
    const int vto = w & 3, tt0 = 2 * (w >> 2);
    if (isx) {
#pragma unroll
        for (int ks = 0; ks < 4; ++ks) { const bf16x8 sf = *(const LAS bf16x8*)(lds + P3_SB + (16 * vto + fr) * P3_QP + (32 * ks + 8 * fq) * 2);
#pragma unroll
            for (int k2 = 0; k2 < 2; ++k2) { const bf16x8 qf = *(const LAS bf16x8*)(lds + P3_QT + (16 * (tt0 + k2) + fr) * P3_QP + (32 * ks + 8 * fq) * 2);
                oacc[k2] = __builtin_amdgcn_mfma_f32_16x16x32_bf16(sf, qf, oacc[k2], 0, 0, 0); } }
    }
    {
        bf16x8 kf[2];
#pragma unroll
        for (int ks = 0; ks < 2; ++ks) kf[ks] = *(const LAS bf16x8*)(lds + P3_KTT + (16 * w + fr) * P3_SP + (32 * ks + 8 * fq) * 2);
#pragma unroll
        for (int vt = 0; vt < 4; ++vt)
#pragma unroll
            for (int ks = 0; ks < 2; ++ks) { const bf16x8 vf = *(const LAS bf16x8*)(lds + P3_VT + (16 * vt + fr) * P3_SP + (32 * ks + 8 * fq) * 2);
                Sacc[vt] = __builtin_amdgcn_mfma_f32_16x16x32_bf16(kf[ks], vf, Sacc[vt], 0, 0, 0); }
    }
    if (isx) {
        LDS_WAIT(); __syncthreads();
#pragma unroll
        for (int ks = 0; ks < 2; ++ks) { const bf16x8 vf = *(const LAS bf16x8*)(lds + P3_VT + (16 * vto + fr) * P3_SP + (32 * ks + 8 * fq) * 2);
#pragma unroll
            for (int k2 = 0; k2 < 2; ++k2) { const bf16x8 af = *(const LAS bf16x8*)(lds + P3_AM + (16 * (tt0 + k2) + fr) * P3_SP + (32 * ks + 8 * fq) * 2);
                oacc[k2] = __builtin_amdgcn_mfma_f32_16x16x32_bf16(vf, af, oacc[k2], 0, 0, 0); } }
        const long xb = (long)b * SEQ + (dir ? SEQ - 1 - 64 * (c - 4) : 64 * (c - 4)); const int rstep = dir ? -1 : 1;
#pragma unroll
        for (int k2 = 0; k2 < 2; ++k2) { const long row = xb + rstep * (16 * (tt0 + k2) + fr);
            v2u o; o.x = pk2(oacc[k2][0], oacc[k2][1]); o.y = pk2(oacc[k2][2], oacc[k2][3]);
            *(v2u*)(Op + row * D + h * HD + vh * 64 + 16 * vto + 4 * fq) = o; }
    }
    LDS_WAIT(); __syncthreads();
    }
}

__device__ __forceinline__ void p3_unit(LAS unsigned char* lds, int unit, const bf16* QB, const bf16* VB, const bf16* GF, const bf16* GBK, bf16* OF, bf16* OB, int tid) {
    asm volatile("" : "+v"(tid));
    const int lane = tid & 63, w = __builtin_amdgcn_readfirstlane(tid >> 6), fr = lane & 15, fq = lane >> 4;
    const int vh = unit & 1, dir = (unit >> 1) & 1, h = (unit >> 2) & 7, b = unit >> 5;
    const bf16* Gp = dir ? GBK : GF; bf16* Op = dir ? OB : OF;
    half8 Bm0, Bm1, Bone;
#pragma unroll
    for (int j = 0; j < 8; ++j) { Bm0[j] = (8 * fq + j <= fr) ? (_Float16)1.0f : (_Float16)0.0f; Bm1[j] = (8 * fq + j <= 16 + fr) ? (_Float16)1.0f : (_Float16)0.0f; Bone[j] = (_Float16)1.0f; }
    f32x4 Sacc[4]; float bend_prev[4];
#pragma unroll
    for (int i = 0; i < 4; ++i) { Sacc[i] = (f32x4){0.f, 0.f, 0.f, 0.f}; bend_prev[i] = 0.f; }
    RawChunk RA, RB;
    p3_load(RA, 0, b, h, vh, dir, w, lane, QB, VB, Gp);
#pragma unroll 1
    for (int c = 0; c < P3_NCH; c += 2) {
        p3_load(RB, c + 1, b, h, vh, dir, w, lane, QB, VB, Gp);
        p3_chunk(lds, RA, c, Sacc, bend_prev, Bm0, Bm1, Bone, b, h, vh, dir, w, fr, fq, lane, Op);
        p3_load(RA, c + 2, b, h, vh, dir, w, lane, QB, VB, Gp);
        p3_chunk(lds, RB, c + 1, Sacc, bend_prev, Bm0, Bm1, Bone, b, h, vh, dir, w, fr, fq, lane, Op);
    }
}

__device__ __forceinline__ void p4_build_aa(int slab, const bf16* OF, const bf16* OB, const bf16* OG, const float* hgrn_g, bf16* AA, int tid) {
    asm volatile("" : "+v"(tid));
    const int lane = tid & 63, wave = __builtin_amdgcn_readfirstlane(tid >> 6), row0 = slab * 256;
    float hg[16];
#pragma unroll
    for (int i = 0; i < 4; ++i) { const f32x4 t = *(const f32x4*)(hgrn_g + 16 * (lane & 7) + 4 * i); hg[4 * i] = t.x; hg[4 * i + 1] = t.y; hg[4 * i + 2] = t.z; hg[4 * i + 3] = t.w; }
    for (int r = wave * 32; r < wave * 32 + 32; ++r) {
        const size_t off = (size_t)(row0 + r) * D + 16 * lane;
        const v4u f0 = *(const v4u*)(OF + off), f1 = *(const v4u*)(OF + off + 8), b0 = *(const v4u*)(OB + off), b1 = *(const v4u*)(OB + off + 8);
        const v4u g0 = *(const v4u*)(OG + off), g1 = *(const v4u*)(OG + off + 8);
        float o[16], gg[16];
        const unsigned fw[8] = {f0.x, f0.y, f0.z, f0.w, f1.x, f1.y, f1.z, f1.w}, bw[8] = {b0.x, b0.y, b0.z, b0.w, b1.x, b1.y, b1.z, b1.w}, gw8[8] = {g0.x, g0.y, g0.z, g0.w, g1.x, g1.y, g1.z, g1.w};
        float ss = 0.f;
#pragma unroll
        for (int i = 0; i < 8; ++i) { o[2 * i] = bflo(fw[i]) + bflo(bw[i]); o[2 * i + 1] = bfhi(fw[i]) + bfhi(bw[i]); gg[2 * i] = bflo(gw8[i]); gg[2 * i + 1] = bfhi(gw8[i]); ss += o[2 * i] * o[2 * i] + o[2 * i + 1] * o[2 * i + 1]; }
        ss += __shfl_xor(ss, 1); ss += __shfl_xor(ss, 2); ss += __shfl_xor(ss, 4);
        const float rstd = rsqrtf(ss * (1.0f / HD) + EPS);
        unsigned w[8];
#pragma unroll
        for (int i = 0; i < 8; ++i) w[i] = pk2((o[2 * i] * rstd * hg[2 * i]) * gg[2 * i], (o[2 * i + 1] * rstd * hg[2 * i + 1]) * gg[2 * i + 1]);
        *(v4u*)(AA + off) = (v4u){w[0], w[1], w[2], w[3]}; *(v4u*)(AA + off + 8) = (v4u){w[4], w[5], w[6], w[7]};
    }
}
__device__ __forceinline__ void p4_pool(LAS unsigned char* lds, int slab, const bf16* PB, bf16* RB, int tid) {
    asm volatile("" : "+v"(tid));
    LAS float* T = (LAS float*)lds; constexpr int TP = 68;
    const int b = slab / 32, row0 = slab * 256, gr0 = 4 * (slab % 32);
#pragma unroll 1
    for (int jh = 0; jh < 8; ++jh) {
        const int j = jh >> 1, hh = jh & 1, w = 2 << j, chb = j * 128 + hh * 64;
        { const int q = tid & 1, cc = (tid >> 1) & 63, r = tid >> 7; const int R = gr0 + r;
          int R0 = R - w / 2; R0 = R0 < 0 ? 0 : R0; int R1 = R + w / 2 - 1; R1 = (R1 > GRID_H - 1 ? GRID_H - 1 : R1) + 1;
          float a[32];
#pragma unroll
          for (int i = 0; i < 32; ++i) a[i] = 0.f;
#pragma unroll 1
          for (int rr = R0; rr < R1; ++rr) { const bf16* src = PB + ((size_t)b * SEQ + rr * GRID_W + cc) * PW + chb + q * 32;
#pragma unroll
              for (int k = 0; k < 4; ++k) { const v4u u = *(const v4u*)(src + 8 * k); a[8 * k + 0] += bflo(u.x); a[8 * k + 1] += bfhi(u.x); a[8 * k + 2] += bflo(u.y); a[8 * k + 3] += bfhi(u.y);
                  a[8 * k + 4] += bflo(u.z); a[8 * k + 5] += bfhi(u.z); a[8 * k + 6] += bflo(u.w); a[8 * k + 7] += bfhi(u.w); } }
          LAS float* dst = T + (r * 64 + cc) * TP + q * 32;
#pragma unroll
          for (int k = 0; k < 8; ++k) *(LAS f32x4*)(dst + 4 * k) = (f32x4){a[4 * k], a[4 * k + 1], a[4 * k + 2], a[4 * k + 3]}; }
        __syncthreads();
        { const int q = tid & 1, tl = tid >> 1, r = tl >> 6, cc = tl & 63; const int R = gr0 + r;
          int R0 = R - w / 2; R0 = R0 < 0 ? 0 : R0; int R1 = R + w / 2 - 1; R1 = (R1 > GRID_H - 1 ? GRID_H - 1 : R1) + 1;
          int C0 = cc - w / 2; C0 = C0 < 0 ? 0 : C0; int C1 = cc + w / 2 - 1; C1 = (C1 > GRID_W - 1 ? GRID_W - 1 : C1) + 1;
          const float inv = 1.0f / (float)((R1 - R0) * (C1 - C0));
          float s[32];
#pragma unroll
          for (int i = 0; i < 32; ++i) s[i] = 0.f;
#pragma unroll 1
          for (int c2 = C0; c2 < C1; ++c2) { const LAS float* src = T + (r * 64 + c2) * TP + q * 32;
#pragma unroll
              for (int k = 0; k < 8; ++k) { const f32x4 t4 = *(const LAS f32x4*)(src + 4 * k); s[4 * k] += t4.x; s[4 * k + 1] += t4.y; s[4 * k + 2] += t4.z; s[4 * k + 3] += t4.w; } }
          const size_t po = (size_t)(row0 + tl) * PW + chb + q * 32;
#pragma unroll
          for (int k = 0; k < 4; ++k) { const v4u u = *(const v4u*)(PB + po + 8 * k); v4u o;
              o.x = pk2(s[8 * k + 0] * inv - bflo(u.x), s[8 * k + 1] * inv - bfhi(u.x)); o.y = pk2(s[8 * k + 2] * inv - bflo(u.y), s[8 * k + 3] * inv - bfhi(u.y));
              o.z = pk2(s[8 * k + 4] * inv - bflo(u.z), s[8 * k + 5] * inv - bfhi(u.z)); o.w = pk2(s[8 * k + 6] * inv - bflo(u.w), s[8 * k + 7] * inv - bfhi(u.w));
              *(v4u*)(RB + po + 8 * k) = o; } }
        __syncthreads();
    }
}
__device__ __forceinline__ void p4_rows(LAS unsigned char* lds, int slab, const float* NEWHX, const float* modb, const float* norm2_g, const float* w_router, bf16* VX, float* PROBS, int tid) {
    asm volatile("" : "+v"(tid));
    const int lane = tid & 63, wave = __builtin_amdgcn_readfirstlane(tid >> 6), row0 = slab * 256;
    LAS float* W2 = (LAS float*)lds;
    LAS float* rstd_s = W2 + D * NE;
    LAS float* bias_s = rstd_s + 256;
    const float* sh2 = modb + 3 * D; const float* sc2 = modb + 4 * D;
    for (int e4 = tid; e4 < D * NE; e4 += NTHR) { const int c = e4 >> 4, e = e4 & 15;
        W2[(((c >> 4) * 4 + ((c >> 2) & 3)) * 16 + e) * 4 + (c & 3)] = norm2_g[c] * (1.0f + sc2[c]) * w_router[e4]; }
    { const int e = tid & 15, part = tid >> 4; float a = 0.f;
      for (int c = part * 32; c < part * 32 + 32; ++c) a += sh2[c] * w_router[c * NE + e];
      bias_s[e * 32 + part] = a; }
#pragma unroll 1
    for (int r = wave * 32; r < wave * 32 + 32; ++r) {
        const int row = row0 + r; const float* src = NEWHX + (size_t)row * D;
        f32x4 v[4]; float ss = 0.f;
#pragma unroll
        for (int j = 0; j < 4; ++j) { v[j] = *(const f32x4*)(src + 4 * lane + 256 * j); ss += (v[j].x * v[j].x + v[j].y * v[j].y) + (v[j].z * v[j].z + v[j].w * v[j].w); }
        const float rstd = rsqrtf(wave_sum(ss) * (1.0f / D) + EPS);
        if (lane == 0) rstd_s[r] = rstd;
#pragma unroll
        for (int j = 0; j < 4; ++j) { const int c = 4 * lane + 256 * j; const f32x4 g = *(const f32x4*)(norm2_g + c), sc = *(const f32x4*)(sc2 + c), sh = *(const f32x4*)(sh2 + c);
            const f32x4 o = (v[j] * rstd * g) * (sc + 1.0f) + sh;
            v2u w; w.x = pk2(o.x, o.y); w.y = pk2(o.z, o.w); *(v2u*)(VX + (size_t)row * D + c) = w; }
    }
    __syncthreads();
    if (tid < 16) { float a = 0.f; for (int p = 0; p < 32; ++p) a += bias_s[tid * 32 + p]; bias_s[512 + tid] = a; }
    __syncthreads();
    const int fr = lane & 15, fq = lane >> 4;
#pragma unroll 1
    for (int grp = wave * 2; grp < wave * 2 + 2; ++grp) {
        const float* arow = NEWHX + (size_t)(row0 + grp * 16 + fr) * D + 4 * fq;
        f32x4 acc = (f32x4){0.f, 0.f, 0.f, 0.f};
#pragma unroll 4
        for (int s = 0; s < 64; ++s) { const f32x4 a = *(const f32x4*)(arow + 16 * s); const f32x4 w = *(const LAS f32x4*)(W2 + ((s * 4 + fq) * 16 + fr) * 4);
            acc = __builtin_amdgcn_mfma_f32_16x16x4f32(a.x, w.x, acc, 0, 0, 0); acc = __builtin_amdgcn_mfma_f32_16x16x4f32(a.y, w.y, acc, 0, 0, 0);
            acc = __builtin_amdgcn_mfma_f32_16x16x4f32(a.z, w.z, acc, 0, 0, 0); acc = __builtin_amdgcn_mfma_f32_16x16x4f32(a.w, w.w, acc, 0, 0, 0); }
        const float be = bias_s[512 + fr];
#pragma unroll
        for (int i = 0; i < 4; ++i) { const int r = grp * 16 + 4 * fq + i; float lg = acc[i] * rstd_s[r] + be;
            float mx = lg; mx = fmaxf(mx, __shfl_xor(mx, 1)); mx = fmaxf(mx, __shfl_xor(mx, 2)); mx = fmaxf(mx, __shfl_xor(mx, 4)); mx = fmaxf(mx, __shfl_xor(mx, 8));
            const float ex = __expf(lg - mx); float sm = ex; sm += __shfl_xor(sm, 1); sm += __shfl_xor(sm, 2); sm += __shfl_xor(sm, 4); sm += __shfl_xor(sm, 8);
            PROBS[(size_t)(row0 + r) * NE + fr] = ex / sm; }
    }
    __syncthreads();
}

__global__ void __launch_bounds__(NTHR) mega(Args args) {
    extern __shared__ __attribute__((aligned(16))) unsigned char lds_raw[];
    LAS unsigned char* lds = (LAS unsigned char*)lds_raw;
    const int tid = threadIdx.x, lane = tid & 63, wave = __builtin_amdgcn_readfirstlane(tid >> 6);
    const int G = gridDim.x, bx = blockIdx.x;
    const int vcu = (G % 8 == 0) ? (bx % 8) * (G / 8) + bx / 8 : bx;
    const int gw = vcu * NWAVES + wave, NGW = G * NWAVES;
    unsigned char* ws = args.ws; unsigned char* dout = (unsigned char*)args.out;
    const float* x = args.in[0]; const float* cvec = args.in[1]; const float* ctx = args.in[2]; const float* c_ctx = args.in[3];
    const float* lb_logits = args.in[4]; const float* w_mod = args.in[5]; const float* b_mod = args.in[6]; const float* norm1_g = args.in[7];
    const float* w_in = args.in[8]; const float* hgrn_g = args.in[9]; const float* w_a = args.in[10]; const float* w_pool = args.in[11];
    const float* pool_scale = args.in[12]; const float* w_b = args.in[13]; const float* w_out = args.in[14]; const float* norm2_g = args.in[15];
    const float* w_router = args.in[16]; const float* w_e_gate = args.in[17]; const float* w_e_up = args.in[18]; const float* w_e_down = args.in[19];
    const float* final_g = args.in[20];
    float* MOD = (float*)(ws + WS_MOD); float* MODP = (float*)(ws + WS_MODP); float* LB = (float*)(ws + WS_LB);
    int* IDX = (int*)(ws + WS_IDX); float* VALS = (float*)(ws + WS_VALS); float* PROBS = (float*)(ws + WS_PROBS); int* INV = (int*)(ws + WS_INV);
    bf16* WIN = (bf16*)(ws + WS_WIN); bf16* WA = (bf16*)(ws + WS_WA); bf16* WP = (bf16*)(ws + WS_WP); bf16* WOUT = (bf16*)(ws + WS_WOUT);
    bf16* QB = (bf16*)(ws + WS_Q); bf16* VB = (bf16*)(ws + WS_V); bf16* GF = (bf16*)(ws + WS_GF); bf16* GBK = (bf16*)(ws + WS_GB);
    bf16* OG = (bf16*)(ws + WS_OG); bf16* PB = (bf16*)(ws + WS_P); bf16* GA = (bf16*)(ws + WS_GA); bf16* GBT = (bf16*)(ws + WS_GBT);
    float* NEWHX = (float*)(ws + WS_NEWHX); bf16* AA = (bf16*)(ws + WS_AA); bf16* VX = (bf16*)(ws + WS_VX); bf16* RB = (bf16*)(ws + WS_R);
    bf16* HID = (bf16*)(ws + WS_HID); bf16* YB = (bf16*)(ws + WS_YB);
    bf16* UX = (bf16*)(dout + DO_UX); bf16* OF = (bf16*)(dout + DO_OF); bf16* OB = (bf16*)(dout + DO_OB); bf16* WGU = (bf16*)(dout + DO_WGU); bf16* WDN = (bf16*)(dout + DO_WDN);
    const int lo = args.ph_lo, hi = args.ph_hi;
#ifndef PHASE_MASK
#define PHASE_MASK 0xff
#endif
#ifndef REPEAT_MASK
#define REPEAT_MASK 0
#endif
#define IN(k) (((PHASE_MASK >> (k)) & 1) && lo <= (k) && (k) < hi)
#define REP(k) for (int rep_ = 0; rep_ < ((REPEAT_MASK >> (k)) & 1) + 1; ++rep_)
    { volatile LAS unsigned* misc = (volatile LAS unsigned*)(lds + RING_BYTES); if (tid < 16) misc[tid] = 0u; }
    __syncthreads();
    XcdBarrier gbar = xcd_barrier_post((unsigned*)(ws + WS_CTL) + 4096, (volatile LAS unsigned*)(lds + RING_BYTES) + 8);
#define SEAM(k) do { if (IN(k) && IN((k) + 1)) { xcd_barrier(gbar); } } while (0)

    if (IN(0)) REP(0) {
        LAS float* scr = (LAS float*)(lds + wave * 16384);
        for (int it = gw; it < 96 * 16; it += NGW) {
            const int cb = it % 96, kp = it / 96, col = cb * 64 + lane, k0 = kp * 64;
            float sv[9];
#pragma unroll
            for (int r = 0; r < 9; ++r) { const float cv = (r < 8) ? cvec[r * D + k0 + lane] : c_ctx[k0 + lane]; sv[r] = siluf_(cv); }
            float acc[9];
#pragma unroll
            for (int r = 0; r < 9; ++r) acc[r] = 0.f;
#pragma unroll 16
            for (int kk = 0; kk < 64; ++kk) { const float w = w_mod[(size_t)(k0 + kk) * (6 * D) + col];
#pragma unroll
                for (int r = 0; r < 9; ++r) acc[r] += __shfl(sv[r], kk) * w; }
#pragma unroll
            for (int r = 0; r < 9; ++r) MODP[((size_t)kp * 9 + r) * (6 * D) + col] = acc[r];
        }
        for (int i = gw * 64 + lane; i < 2 * HD * NH; i += NGW * 64) { const int dir = i >> 10, d = i & 1023; const float l0 = lb_logits[dir * 2048 + d], l1 = lb_logits[dir * 2048 + 1024 + d]; LB[i] = 1.0f / (1.0f + __expf(l1 - l0)); }
        {
            constexpr int I_IN = (D / 64) * (NIN / 32), I_A = (D / 64) * (D / 32), I_OUT = I_A;
            for (int it = gw; it < I_IN + I_A + I_OUT; it += NGW) {
                int r = it;
                if (r < I_IN) { const int nblk = NIN / 32, kb = r / nblk, nb = r % nblk; transpose_item(w_in, D, NIN, WIN, 64 * kb, 32 * nb, 32 * nb, scr, lane); continue; } r -= I_IN;
                if (r < I_A) { const int nblk = D / 32, kb = r / nblk, nb = r % nblk; transpose_item(w_a, D, D, WA, 64 * kb, 32 * nb, 32 * nb, scr, lane); continue; } r -= I_A;
                { const int nblk = D / 32, kb = r / nblk, nb = r % nblk; transpose_item(w_out, D, D, WOUT, 64 * kb, 32 * nb, 32 * nb, scr, lane); }
            }
        }
        for (int it = gw; it < PW * 16; it += NGW) {
            const int k = it >> 4, nb = it & 15, n = nb * 64 + lane, j = k >> 7;
            const float* wp = w_pool + (size_t)k * 128; const float* ps = pool_scale + j * 128; const float* wb = w_b + (size_t)(j * 128) * D + n;
            float a = 0.f;
#pragma unroll 8
            for (int m = 0; m < 128; ++m) a += (wp[m] * ps[m]) * wb[(size_t)m * D];
            WP[(size_t)n * PW + k] = (bf16)f2bf(a);
        }
    }
    SEAM(0);

    if (IN(1)) REP(1) {
        LAS float* shs = (LAS float*)lds; LAS float* scs = shs + D;
        for (int slab = bx; slab < MT / 256; slab += G) {
            const int mrow = slab < M / 256 ? slab / 32 : 8;
            const bool writer = (slab < M / 256) ? (slab % 32 == 0) : (slab == M / 256);
            for (int c = tid; c < (writer ? 6 * D : 2 * D); c += NTHR) {
                float a = b_mod[c];
#pragma unroll
                for (int kp = 0; kp < 16; ++kp) a += MODP[((size_t)kp * 9 + mrow) * (6 * D) + c];
                if (c < D) shs[c] = a; else if (c < 2 * D) scs[c - D] = a;
                if (writer) MOD[mrow * (6 * D) + c] = a;
            }
            __syncthreads();
            for (int r = wave * 32; r < wave * 32 + 32; ++r) {
                const int row = slab * 256 + r;
                const float* src = (row < M) ? x + (size_t)row * D : ctx + (size_t)(row - M) * D;
                f32x4 v[4]; float ss = 0.f;
#pragma unroll
                for (int j = 0; j < 4; ++j) { v[j] = *(const f32x4*)(src + 4 * lane + 256 * j); ss += (v[j].x * v[j].x + v[j].y * v[j].y) + (v[j].z * v[j].z + v[j].w * v[j].w); }
                const float rstd = rsqrtf(wave_sum(ss) * (1.0f / D) + EPS);
#pragma unroll
                for (int j = 0; j < 4; ++j) { const int c = 4 * lane + 256 * j; const f32x4 g = *(const f32x4*)(norm1_g + c);
                    const f32x4 sc = *(const LAS f32x4*)(scs + c), sh = *(const LAS f32x4*)(shs + c);
                    const f32x4 o = (v[j] * rstd * g) * (sc + 1.0f) + sh;
                    v2u w; w.x = pk2(o.x, o.y); w.y = pk2(o.z, o.w); *(v2u*)(UX + (size_t)row * D + c) = w; }
            }
            __syncthreads();
        }
    }
    SEAM(1);

    if (IN(2)) REP(2) {
        pg8::Gemm g{UX, WIN, D, nullptr}; pg8::OrderIn S{G, bx};
        pg8::EpiIn E{QB, VB, GF, GBK, OG, PB, GA, GBT, LB};
        pg8::gemm_phase<pg8::EpiIn, pg8::OrderIn, true, true, false>(lds, g, S, E, tid);
    }
    SEAM(2);

    if (IN(3)) REP(3) {
        for (int unit = vcu; unit < NB * NH * 4; unit += G) p3_unit(lds, unit, QB, VB, GF, GBK, OF, OB, tid);
    }
    SEAM(3);

    if (IN(4)) REP(4) {
        for (int slab = bx; slab < M / 256; slab += G) {
            const int b = slab / 32;
            if (P4M & 1) p4_build_aa(slab, OF, OB, OG, hgrn_g, AA, tid);
            if (P4M & 2) p4_pool(lds, slab, PB, RB, tid);
            wg_fence();
            if (P4M & 4) { const bf16* wb_ = WA; asm volatile("" : "+s"(wb_)); pg8::Gemm g{AA, wb_, D, nullptr}; pg8::OrderRow S{slab, 4}; pg8::EpiGateA E{GA};
              pg8::gemm_phase<pg8::EpiGateA, pg8::OrderRow, true, true, false>(lds, g, S, E, tid); }
            wg_fence();
            if (P4M & 8) { const bf16* wb_ = WP; asm volatile("" : "+s"(wb_)); pg8::Gemm g{RB, wb_, PW, nullptr}; pg8::OrderRow S{slab, 4}; pg8::EpiGateB E{GA, GBT};
              pg8::gemm_phase<pg8::EpiGateB, pg8::OrderRow, true, true, false>(lds, g, S, E, tid); }
            wg_fence();
            if (P4M & 16) { const bf16* wb_ = WOUT; asm volatile("" : "+s"(wb_)); pg8::Gemm g{GBT, wb_, D, nullptr}; pg8::OrderRow S{slab, 4}; pg8::EpiResid E{x, NEWHX, MOD + b * (6 * D) + 2 * D};
              pg8::gemm_phase<pg8::EpiResid, pg8::OrderRow, true, true, false>(lds, g, S, E, tid); }
            wg_fence();
            if (P4M & 32) p4_rows(lds, slab, NEWHX, MOD + b * (6 * D), norm2_g, w_router, VX, PROBS, tid);
        }
    }
    SEAM(4);

    if (IN(5)) REP(5) {
        {
            LAS float* scr = (LAS float*)(lds + wave * 16384);
            constexpr int I_E = (D / 64) * (FF / 32);
            for (int it = gw; it < NE * 3 * I_E; it += NGW) {
                const int e = it / (3 * I_E), r = it % (3 * I_E), which = r / I_E, q = r % I_E, kb = q / (FF / 32), nb = q % (FF / 32), n0 = 32 * nb;
                if (which < 2) transpose_item((which ? w_e_up : w_e_gate) + (size_t)e * D * FF, D, FF, WGU + (size_t)e * 2 * FF * D, 64 * kb, n0, n0 + 128 * (n0 / 128) + 128 * which, scr, lane);
                else transpose_item(w_e_down + (size_t)e * FF * D, FF, D, WDN + (size_t)e * D * FF, 64 * kb, n0, n0, scr, lane);
            }
        }
        __syncthreads();
        {
            LAS unsigned* keys = (LAS unsigned*)lds;
            LAS unsigned* hist = keys + SEQ;
            LAS unsigned* sc = hist + 256;
            LAS unsigned* wsum = sc + 16;
            for (int be = bx; be < NB * NE; be += G) {
                const int b = be / NE, e = be % NE;
                for (int t = tid; t < SEQ; t += NTHR) keys[t] = __builtin_bit_cast(unsigned, PROBS[((size_t)b * SEQ + t) * NE + e]);
                unsigned prefix = 0, mask = 0, kk = CAP;
                for (int pass = 0; pass < 4; ++pass) {
                    const int shift = 24 - 8 * pass;
                    if (tid < 256) hist[tid] = 0;
                    __syncthreads();
                    for (int t = tid; t < SEQ; t += NTHR) { const unsigned k = keys[t]; if ((k & mask) == prefix) __hip_atomic_fetch_add(hist + ((k >> shift) & 255u), 1u, __ATOMIC_RELAXED, __HIP_MEMORY_SCOPE_WORKGROUP); }
                    __syncthreads();
                    if (tid == 0) { unsigned cum = 0; int dsel = 0; unsigned knew = kk;
                        for (int d = 255; d >= 0; --d) { const unsigned hc = hist[d]; if (cum + hc >= kk) { dsel = d; knew = kk - cum; break; } cum += hc; }
                        sc[0] = prefix | ((unsigned)dsel << shift); sc[1] = knew; }
                    __syncthreads();
                    prefix = sc[0]; kk = sc[1]; mask |= (255u << shift);
                    __syncthreads();
                }
                const unsigned thr = prefix, need = kk;
                unsigned cgt = 0, ceq = 0;
#pragma unroll
                for (int i = 0; i < 16; ++i) { const unsigned k = keys[tid * 16 + i]; cgt += (k > thr); ceq += (k == thr); }
                unsigned igt = cgt, ieq = ceq;
#pragma unroll
                for (int o = 1; o < 64; o <<= 1) { const unsigned a = __shfl_up(igt, o), c2 = __shfl_up(ieq, o); if (lane >= o) { igt += a; ieq += c2; } }
                if (lane == 63) { wsum[wave] = igt; wsum[8 + wave] = ieq; }
                __syncthreads();
                unsigned bgt = 0, beq = 0, totgt = 0;
#pragma unroll
                for (int w = 0; w < 8; ++w) { const unsigned a = wsum[w], c2 = wsum[8 + w]; if (w < wave) { bgt += a; beq += c2; } totgt += a; }
                unsigned pgt = bgt + igt - cgt, peq = beq + ieq - ceq;
#pragma unroll
                for (int i = 0; i < 16; ++i) { const int t = tid * 16 + i; const unsigned k = keys[t]; int slot = -1;
                    if (k > thr) { slot = (int)pgt; ++pgt; } else if (k == thr) { if (peq < need) slot = (int)(totgt + peq); ++peq; }
                    INV[((size_t)b * SEQ + t) * NE + e] = slot;
                    if (slot >= 0) { IDX[be * CAP + slot] = b * SEQ + t; VALS[be * CAP + slot] = __builtin_bit_cast(float, k); } }
                __syncthreads();
            }
        }
    }
    SEAM(5);

    if (IN(6)) REP(6) {
        for (int rnd = 0;; ++rnd) {
            int e, b, rt;
            if (G == 256) { if (rnd >= 2) break; const int xcd = bx & 7, loc = bx >> 3; e = 2 * xcd + rnd; b = loc >> 2; rt = loc & 3; }
            else { const int it = bx + rnd * G; if (it >= NB * NE * 4) break; e = it >> 5; b = (it >> 2) & 7; rt = it & 3; }
            const int be = b * NE + e; const size_t r0 = (size_t)be * CAP + rt * 256;
            { pg8::Gemm g{VX, WGU + (size_t)e * 2 * FF * D, D, IDX + r0}; pg8::OrderRow S{0, 8}; pg8::EpiHid E{HID + r0 * FF};
              pg8::gemm_phase<pg8::EpiHid, pg8::OrderRow, true, true, true>(lds, g, S, E, tid); }
            wg_fence();
            { pg8::Gemm g{HID + r0 * FF, WDN + (size_t)e * D * FF, FF, nullptr}; pg8::OrderRow S{0, 4}; pg8::EpiDown E{YB + r0 * D, VALS + r0};
              pg8::gemm_phase<pg8::EpiDown, pg8::OrderRow, true, true, false>(lds, g, S, E, tid); }
        }
    }
    SEAM(6);

    if (IN(7)) REP(7) {
        float* out = args.out;
        for (int row = gw; row < M; row += NGW) {
            const int b = row / SEQ; const float* g2 = MOD + b * (6 * D) + 5 * D;
            f32x4 a[4];
#pragma unroll
            for (int j = 0; j < 4; ++j) a[j] = (f32x4){0.f, 0.f, 0.f, 0.f};
            const int sl = (lane < NE) ? INV[(size_t)row * NE + lane] : -1;
            for (int e = 0; e < NE; ++e) { const int s = __shfl(sl, e);
                if (s >= 0) { const bf16* yr = YB + ((size_t)(b * NE + e) * CAP + s) * D + 4 * lane;
#pragma unroll
                    for (int j = 0; j < 4; ++j) { const v2u u = *(const v2u*)(yr + 256 * j); a[j].x += bflo(u.x); a[j].y += bfhi(u.x); a[j].z += bflo(u.y); a[j].w += bfhi(u.y); } } }
            f32x4 hv[4]; float ss = 0.f;
#pragma unroll
            for (int j = 0; j < 4; ++j) { const int c = 4 * lane + 256 * j; hv[j] = *(const f32x4*)(NEWHX + (size_t)row * D + c) + *(const f32x4*)(g2 + c) * a[j];
                ss += (hv[j].x * hv[j].x + hv[j].y * hv[j].y) + (hv[j].z * hv[j].z + hv[j].w * hv[j].w); }
            const float rstd = rsqrtf(wave_sum(ss) * (1.0f / D) + EPS);
#pragma unroll
            for (int j = 0; j < 4; ++j) { const int c = 4 * lane + 256 * j; *(f32x4*)(out + (size_t)row * D + c) = hv[j] * rstd * *(const f32x4*)(final_g + c); }
        }
    }
#undef IN
#undef SEAM
}

extern "C" void kernel_launch(void* const* d_in, const int* in_sizes, int n_in, void* d_out, int out_size, void* d_ws, size_t ws_size, hipStream_t stream) {
    static int grid = 0;
    if (grid == 0) {
        if (n_in != 21 || in_sizes[0] != M * D || in_sizes[8] != D * NIN || out_size != M * D || ws_size < WS_END) {
            fprintf(stderr, "kernel_launch: unexpected shapes: n_in %d in0 %d in8 %d out %d ws %zu; nothing launched\n", n_in, n_in > 0 ? in_sizes[0] : -1, n_in > 8 ? in_sizes[8] : -1, out_size, ws_size); grid = -1; return; }
        int dev = 0, cus = 0, per_cu = 0;
        if (hipGetDevice(&dev) != hipSuccess || hipDeviceGetAttribute(&cus, hipDeviceAttributeMultiprocessorCount, dev) != hipSuccess) { grid = -1; return; }
        if (hipFuncSetAttribute((const void*)mega, hipFuncAttributeMaxDynamicSharedMemorySize, LDS_BYTES) != hipSuccess) { fprintf(stderr, "kernel_launch: hipFuncSetAttribute failed\n"); grid = -1; return; }
        if (hipOccupancyMaxActiveBlocksPerMultiprocessor(&per_cu, (const void*)mega, NTHR, LDS_BYTES) != hipSuccess || per_cu < 1) { fprintf(stderr, "kernel_launch: occupancy query says %d\n", per_cu); per_cu = 1; }
        (void)hipGetLastError();
        grid = cus;
        fprintf(stderr, "kernel_launch: grid %d (occupancy query %d per CU)\n", grid, per_cu);
    }
    if (grid < 0) return;
    if (hipMemsetAsync((char*)d_ws + WS_CTL, 0, 65536, stream) != hipSuccess) { fprintf(stderr, "kernel_launch: memset failed\n"); return; }
    Args a{};
    for (int i = 0; i < 21; ++i) a.in[i] = (const float*)d_in[i];
    a.out = (float*)d_out; a.ws = (unsigned char*)d_ws;
#if MK_ONE_LAUNCH
    a.ph_lo = 0; a.ph_hi = NPHASE;
    hipLaunchKernelGGL(mega, dim3(grid), dim3(NTHR), LDS_BYTES, stream, a);
    { const hipError_t e = hipPeekAtLastError(); if (e != hipSuccess) fprintf(stderr, "kernel_launch: launch failed: %s\n", hipGetErrorString(e)); }
#else
    for (int p = 0; p < NPHASE; ++p) {
        a.ph_lo = p; a.ph_hi = p + 1;
        hipLaunchKernelGGL(mega, dim3(grid), dim3(NTHR), LDS_BYTES, stream, a);
    }
#endif
}
```
